# Optimizing an MI355X kernel written in HIP

```python
import math
import jax, jax.numpy as jnp
from jax import lax
import numpy as np

D_MODEL = 1024
BATCH = 16
SEQ = 2048
DEPTH = 2
DEC_BATCH = 8
DEC_SEQ = 16
PAST_LEN = 1024

CHUNK = 64
MIX_WIDTH = 2 * D_MODEL
GROUP_WIDTH = MIX_WIDTH // 4
EPS = 1e-6
NEG_INIT = -1e30

M_HEADS = 4
M_HD = GROUP_WIDTH // M_HEADS
M_QK = M_HD // 2
R_HEADS = 4
R_HD = GROUP_WIDTH // R_HEADS
R_QK = R_HD // 2
ROPE_BASE = 10000.0
S_HD = 64
S_HEADS = GROUP_WIDTH // S_HD
S_GROUPS = 2
S_STATE = 128
CONV_W = 4
S_CONV_DIM = GROUP_WIDTH + 2 * S_GROUPS * S_STATE
H_HEADS = 4
H_HD = GROUP_WIDTH // H_HEADS
H_KD = 128
H_KW = H_HEADS * H_KD
H_BLOCK = 16

IN_SIZES = (
    M_HEADS * M_QK, M_HEADS * M_QK, GROUP_WIDTH, GROUP_WIDTH, GROUP_WIDTH, 2 * M_HEADS,
    R_HEADS * R_QK, R_HEADS * R_QK, GROUP_WIDTH, GROUP_WIDTH,
    GROUP_WIDTH, S_CONV_DIM, S_HEADS,
    H_KW, H_KW, GROUP_WIDTH, GROUP_WIDTH,
)
IN_COLS = sum(IN_SIZES)

kernel_name = "hybrid_stream_encoder_step"


def rmsnorm(x, w):
    xf = x.astype(jnp.float32)
    y = xf * lax.rsqrt(jnp.mean(xf * xf, axis=-1, keepdims=True) + EPS)
    return (y * w.astype(jnp.float32)).astype(x.dtype)


def head_rms(h):
    return h * lax.rsqrt(jnp.mean(h * h, axis=-1, keepdims=True) + EPS)


def head_layernorm(h):
    c = h - jnp.mean(h, axis=-1, keepdims=True)
    return c * lax.rsqrt(jnp.mean(c * c, axis=-1, keepdims=True) + EPS)


def block_len(t, l):
    return l if t % l == 0 else t


def to_blocks(a, l):
    b, t = a.shape[:2]
    a = a.reshape((b, t // l, l) + a.shape[2:])
    return jnp.moveaxis(a, (1, 0, 3, 2), (0, 1, 2, 3))


def from_blocks(a):
    nc, b, h, l = a.shape[:4]
    a = jnp.moveaxis(a, (0, 1, 2, 3), (1, 0, 3, 2))
    return a.reshape((b, nc * l, h) + a.shape[4:])


def causal_tril(l):
    return jnp.tril(jnp.ones((l, l), dtype=bool))


def rotary(x, pos):
    half = x.shape[-1] // 2
    freqs = ROPE_BASE ** (-jnp.arange(half, dtype=jnp.float32) / half)
    ang = pos.astype(jnp.float32)[:, None] * freqs[None, :]
    cos = jnp.cos(ang)[None, :, None, :]
    sin = jnp.sin(ang)[None, :, None, :]
    x1, x2 = x[..., :half], x[..., half:]
    return jnp.concatenate([x1 * cos - x2 * sin, x1 * sin + x2 * cos], axis=-1)


def causal_dwconv(u, buf, w, b):
    up = jnp.concatenate([buf.astype(u.dtype), u], axis=1)
    y = lax.conv_general_dilated(up, w.astype(u.dtype)[:, None, :], window_strides=(1,), padding="VALID",
                                 dimension_numbers=("NWC", "WIO", "NWC"), feature_group_count=u.shape[-1])
    return jax.nn.silu(y + b.astype(u.dtype)), up[:, -(CONV_W - 1):]


def mlstm_block(carry, xs):
    c_prev, n_prev, m_prev = carry
    q, k, v, ig, lf = xs
    l = q.shape[2]
    b = jnp.cumsum(lf, axis=-1)
    d = jnp.where(causal_tril(l), b[..., :, None] - b[..., None, :] + ig[..., None, :], -jnp.inf)
    inter = b + m_prev[..., None]
    m_t = jnp.maximum(inter, jnp.max(d, axis=-1))
    s = jnp.einsum("bhlk,bhsk->bhls", q, k) * jnp.exp(d - m_t[..., None])
    wi = jnp.exp(inter - m_t)
    num = jnp.einsum("bhls,bhsv->bhlv", s, v) + wi[..., None] * jnp.einsum("bhlk,bhkv->bhlv", q, c_prev)
    den = jnp.sum(s, axis=-1) + wi * jnp.einsum("bhlk,bhk->bhl", q, n_prev)
    h = num / jnp.maximum(jnp.abs(den), jnp.exp(-m_t))[..., None]
    g = b[..., -1:] - b + ig
    m_new = jnp.maximum(b[..., -1] + m_prev, jnp.max(g, axis=-1))
    wk = jnp.exp(g - m_new[..., None])
    wc = jnp.exp(b[..., -1] + m_prev - m_new)
    c_new = wc[..., None, None] * c_prev + jnp.einsum("bhs,bhsk,bhsv->bhkv", wk, k, v)
    n_new = wc[..., None] * n_prev + jnp.einsum("bhs,bhsk->bhk", wk, k)
    return (c_new, n_new, m_new), h


def retention_block(s_prev, xs):
    q, k, v = xs
    l = q.shape[2]
    lg = jnp.log1p(-(2.0 ** (-5.0 - jnp.arange(R_HEADS, dtype=jnp.float32))))
    idx = jnp.arange(l, dtype=jnp.float32)
    dec = jnp.exp(jnp.where(causal_tril(l), (idx[:, None] - idx[None, :])[None] * lg[:, None, None], -jnp.inf))
    s = jnp.einsum("bhlk,bhsk->bhls", q, k) * dec
    o = (jnp.einsum("bhls,bhsv->bhlv", s, v)
         + jnp.exp((idx[None] + 1.0) * lg[:, None])[..., None] * jnp.einsum("bhlk,bhkv->bhlv", q, s_prev))
    kw = k * jnp.exp((l - 1.0 - idx)[None] * lg[:, None])[..., None]
    s_new = jnp.exp(l * lg)[:, None, None] * s_prev + jnp.einsum("bhsk,bhsv->bhkv", kw, v)
    return s_new, o


def ssd_block(h_prev, xs):
    cq, bk, xv, la = xs
    bsz, g, l, n = cq.shape
    hg = S_HEADS // S_GROUPS
    b = jnp.cumsum(la, axis=-1)
    dec = jnp.exp(jnp.where(causal_tril(l), b[..., :, None] - b[..., None, :], -jnp.inf))
    cb = jnp.einsum("bgln,bgsn->bgls", cq, bk)
    scores = cb[:, :, None] * dec.reshape(bsz, g, hg, l, l)
    xg = xv.reshape(bsz, g, hg, l, S_HD)
    hp = h_prev.reshape(bsz, g, hg, n, S_HD)
    y = (jnp.einsum("bgkls,bgksp->bgklp", scores, xg)
         + jnp.exp(b).reshape(bsz, g, hg, l)[..., None] * jnp.einsum("bgln,bgknp->bgklp", cq, hp))
    xw = (xv * jnp.exp(b[..., -1:] - b)[..., None]).reshape(bsz, g, hg, l, S_HD)
    h_new = (jnp.exp(b[..., -1])[..., None, None] * h_prev
             + jnp.einsum("bgsn,bgksp->bgknp", bk, xw).reshape(bsz, S_HEADS, n, S_HD))
    return h_new, y.reshape(bsz, S_HEADS, l, S_HD)


def hgrn_block(s_prev, xs):
    q, k, v, lf = xs
    l = q.shape[2]
    b = jnp.cumsum(lf, axis=2)
    diff = b[:, :, :, None, :] - b[:, :, None, :, :]
    w = jnp.exp(jnp.where(causal_tril(l)[:, :, None], diff, -jnp.inf))
    s = jnp.einsum("bhtk,bhsk,bhtsk->bhts", q, k, w)
    o = jnp.einsum("bhts,bhsv->bhtv", s, v) + jnp.einsum("bhtk,bhkv->bhtv", q * jnp.exp(b), s_prev)
    bl = b[:, :, -1]
    s_new = jnp.exp(bl)[..., None] * s_prev + jnp.einsum("bhsk,bhsv->bhkv", k * jnp.exp(bl[:, :, None, :] - b), v)
    return s_new, o


def mixer_layer(x, pos, states, norm_w, w_in, m_gate_b, m_norm_w, conv_w, conv_b,
                dt_bias, a_log, d_skip, s_norm_w, lb, h_norm_w, w_out):
    f32 = jnp.float32
    bsz, t, _ = x.shape
    m_c, m_n, m_m, r_s, s_h, s_buf, h_s = [s.astype(f32) for s in states]
    hn = rmsnorm(x, norm_w)
    proj = jnp.einsum("btd,dc->btc", hn, w_in).astype(f32)
    cuts = np.cumsum(IN_SIZES)[:-1].tolist()
    (mq, mk, mv, mo, mz, mif, rq, rk, rv, rg, sz, sxbc, sdt, hq, hf, hi, hg) = jnp.split(proj, cuts, axis=-1)

    lc = block_len(t, CHUNK)
    q = mq.reshape(bsz, t, M_HEADS, M_QK) * (M_QK ** -0.5)
    k = mk.reshape(bsz, t, M_HEADS, M_QK)
    v = mv.reshape(bsz, t, M_HEADS, M_HD)
    gates = (mif + m_gate_b.astype(f32)).reshape(bsz, t, 2, M_HEADS)
    ig = gates[:, :, 0]
    lf = jax.nn.log_sigmoid(gates[:, :, 1])
    (m_c, m_n, m_m), hm = lax.scan(mlstm_block, (m_c, m_n, m_m),
                                   (to_blocks(q, lc), to_blocks(k, lc), to_blocks(v, lc),
                                    to_blocks(ig, lc), to_blocks(lf, lc)))
    hm = head_rms(from_blocks(hm)) * m_norm_w.astype(f32).reshape(M_HEADS, M_HD)
    out_m = hm.reshape(bsz, t, GROUP_WIDTH) * jax.nn.sigmoid(mo) * jax.nn.silu(mz)

    q = rotary(rq.reshape(bsz, t, R_HEADS, R_QK), pos) * (R_QK ** -0.5)
    k = rotary(rk.reshape(bsz, t, R_HEADS, R_QK), pos)
    v = rv.reshape(bsz, t, R_HEADS, R_HD)
    r_s, hr = lax.scan(retention_block, r_s, (to_blocks(q, lc), to_blocks(k, lc), to_blocks(v, lc)))
    out_r = head_layernorm(from_blocks(hr)).reshape(bsz, t, GROUP_WIDTH) * jax.nn.silu(rg)

    xbc, s_buf = causal_dwconv(sxbc, s_buf, conv_w, conv_b)
    xs_, bs, cs = jnp.split(xbc, [GROUP_WIDTH, GROUP_WIDTH + S_GROUPS * S_STATE], axis=-1)
    xs_ = xs_.reshape(bsz, t, S_HEADS, S_HD)
    bs = bs.reshape(bsz, t, S_GROUPS, S_STATE)
    cs = cs.reshape(bsz, t, S_GROUPS, S_STATE)
    dt = jax.nn.softplus(sdt + dt_bias.astype(f32))
    la = dt * (-jnp.exp(a_log.astype(f32)))
    s_h, ys = lax.scan(ssd_block, s_h, (to_blocks(cs, lc), to_blocks(bs, lc),
                                        to_blocks(xs_ * dt[..., None], lc), to_blocks(la, lc)))
    ys = from_blocks(ys) + d_skip.astype(f32)[:, None] * xs_
    ys = (ys.reshape(bsz, t, GROUP_WIDTH) * jax.nn.silu(sz)).reshape(bsz, t, S_GROUPS, GROUP_WIDTH // S_GROUPS)
    out_s = head_rms(ys).reshape(bsz, t, GROUP_WIDTH) * s_norm_w.astype(f32)

    lh = block_len(t, H_BLOCK)
    q = hq.reshape(bsz, t, H_HEADS, H_KD) * (H_KD ** -0.5)
    k = ((1.0 - lb) * jax.nn.sigmoid(-hf)).reshape(bsz, t, H_HEADS, H_KD)
    lf = jnp.log(lb + (1.0 - lb) * jax.nn.sigmoid(hf)).reshape(bsz, t, H_HEADS, H_KD)
    v = hi.reshape(bsz, t, H_HEADS, H_HD)
    h_s, ho = lax.scan(hgrn_block, h_s, (to_blocks(q, lh), to_blocks(k, lh), to_blocks(v, lh), to_blocks(lf, lh)))
    ho = head_rms(from_blocks(ho)) * h_norm_w.astype(f32).reshape(H_HEADS, H_HD)
    out_h = ho.reshape(bsz, t, GROUP_WIDTH) * jax.nn.silu(hg)

    mix = jnp.concatenate([out_m, out_r, out_s, out_h], axis=-1).astype(x.dtype)
    y = x + jnp.einsum("btc,cd->btd", mix, w_out)
    return y, (m_c, m_n, m_m, r_s, s_h, s_buf, h_s)


def trunk(x, pos, layer_states, lbs, norm_w, w_in, mlstm_gate_b, mlstm_norm_w, ssd_conv_w, ssd_conv_b,
          ssd_dt_bias, ssd_a_log, ssd_d, ssd_norm_w, hgrn_norm_w, w_out, final_norm_w):
    new = []
    for l in range(DEPTH):
        x, st = mixer_layer(x, pos, layer_states[l], norm_w[l], w_in[l], mlstm_gate_b[l], mlstm_norm_w[l],
                            ssd_conv_w[l], ssd_conv_b[l], ssd_dt_bias[l], ssd_a_log[l], ssd_d[l],
                            ssd_norm_w[l], lbs[l], hgrn_norm_w[l], w_out[l])
        new.append(st)
    stacked = [jnp.stack([st[i] for st in new], axis=0) for i in range(7)]
    return rmsnorm(x, final_norm_w), stacked


def setup_inputs(seed: int = 0) -> dict:
    key = jax.random.key(seed)
    ks = jax.random.split(key, 24)
    f32 = jnp.float32

    def nrm(k, shape, s=1.0):
        return s * jax.random.normal(k, shape, f32)

    dt = jnp.exp(jax.random.uniform(ks[14], (DEPTH, S_HEADS), f32, math.log(1e-3), math.log(1e-1)))
    gate_b = jnp.concatenate([nrm(ks[11], (DEPTH, M_HEADS), 0.1),
                              jnp.linspace(3.0, 6.0, M_HEADS, dtype=f32)[None] + nrm(ks[12], (DEPTH, M_HEADS), 0.1)],
                             axis=1)
    return {
        "x_prompt": nrm(ks[0], (BATCH, SEQ, D_MODEL)),
        "x_sample": nrm(ks[1], (DEC_BATCH, DEC_SEQ, D_MODEL)),
        "state_mlstm_c": nrm(ks[2], (DEPTH, DEC_BATCH, M_HEADS, M_QK, M_HD)),
        "state_mlstm_n": nrm(ks[3], (DEPTH, DEC_BATCH, M_HEADS, M_QK)),
        "state_mlstm_m": nrm(ks[4], (DEPTH, DEC_BATCH, M_HEADS)),
        "state_ret": nrm(ks[5], (DEPTH, DEC_BATCH, R_HEADS, R_QK, R_HD)),
        "state_ssd": nrm(ks[6], (DEPTH, DEC_BATCH, S_HEADS, S_STATE, S_HD), 0.5),
        "cache_ssd_conv": nrm(ks[7], (DEPTH, DEC_BATCH, CONV_W - 1, S_CONV_DIM)),
        "state_hgrn": nrm(ks[8], (DEPTH, DEC_BATCH, H_HEADS, H_KD, H_HD)),
        "norm_w": 1.0 + nrm(ks[9], (DEPTH, D_MODEL), 0.1),
        "w_in": nrm(ks[10], (DEPTH, D_MODEL, IN_COLS), D_MODEL ** -0.5),
        "mlstm_gate_b": gate_b,
        "mlstm_norm_w": 1.0 + nrm(ks[13], (DEPTH, GROUP_WIDTH), 0.1),
        "ssd_conv_w": nrm(ks[15], (DEPTH, CONV_W, S_CONV_DIM), CONV_W ** -0.5),
        "ssd_conv_b": nrm(ks[16], (DEPTH, S_CONV_DIM), 0.01),
        "ssd_dt_bias": dt + jnp.log(-jnp.expm1(-dt)),
        "ssd_a_log": jnp.log(jax.random.uniform(ks[17], (DEPTH, S_HEADS), f32, 1.0, 16.0)),
        "ssd_d": 1.0 + nrm(ks[18], (DEPTH, S_HEADS), 0.1),
        "ssd_norm_w": 1.0 + nrm(ks[19], (DEPTH, GROUP_WIDTH), 0.1),
        "hgrn_lower_bounds": nrm(ks[20], (DEPTH, H_KW), 0.1),
        "hgrn_norm_w": 1.0 + nrm(ks[21], (DEPTH, GROUP_WIDTH), 0.1),
        "w_out": nrm(ks[22], (DEPTH, MIX_WIDTH, D_MODEL), MIX_WIDTH ** -0.5),
        "final_norm_w": 1.0 + nrm(ks[23], (D_MODEL,), 0.1),
    }


def reference(x_prompt, x_sample, state_mlstm_c, state_mlstm_n, state_mlstm_m, state_ret, state_ssd,
              cache_ssd_conv, state_hgrn, norm_w, w_in, mlstm_gate_b, mlstm_norm_w, ssd_conv_w, ssd_conv_b,
              ssd_dt_bias, ssd_a_log, ssd_d, ssd_norm_w, hgrn_lower_bounds, hgrn_norm_w, w_out, final_norm_w):
    f32 = jnp.float32
    p = jax.nn.softmax(hgrn_lower_bounds.astype(f32), axis=0)
    lbs = jnp.cumsum(p, axis=0) - p[0]
    weights = (norm_w, w_in, mlstm_gate_b, mlstm_norm_w, ssd_conv_w, ssd_conv_b, ssd_dt_bias, ssd_a_log,
               ssd_d, ssd_norm_w, hgrn_norm_w, w_out, final_norm_w)

    bp, tp = x_prompt.shape[0], x_prompt.shape[1]
    empty = (jnp.zeros((bp, M_HEADS, M_QK, M_HD), f32), jnp.zeros((bp, M_HEADS, M_QK), f32),
             jnp.full((bp, M_HEADS), NEG_INIT, f32), jnp.zeros((bp, R_HEADS, R_QK, R_HD), f32),
             jnp.zeros((bp, S_HEADS, S_STATE, S_HD), f32), jnp.zeros((bp, CONV_W - 1, S_CONV_DIM), f32),
             jnp.zeros((bp, H_HEADS, H_KD, H_HD), f32))
    y_prompt, p_st = trunk(x_prompt, jnp.arange(tp), [empty] * DEPTH, lbs, *weights)

    ts = x_sample.shape[1]
    carried = [(state_mlstm_c[l], state_mlstm_n[l], state_mlstm_m[l], state_ret[l], state_ssd[l],
                cache_ssd_conv[l], state_hgrn[l]) for l in range(DEPTH)]
    y_sample, s_st = trunk(x_sample, PAST_LEN + jnp.arange(ts), carried, lbs, *weights)

    p_mlstm_c, p_mlstm_n, p_mlstm_m, p_ret, p_ssd, p_conv, p_hgrn = p_st
    s_mlstm_c, s_mlstm_n, s_mlstm_m, s_ret, s_ssd, s_conv, s_hgrn = s_st
    return (y_prompt, y_sample, p_mlstm_c, p_mlstm_n, p_mlstm_m, p_ret, p_ssd, p_conv, p_hgrn,
            s_mlstm_c, s_mlstm_n, s_mlstm_m, s_ret, s_ssd, s_conv, s_hgrn)
```

```cpp
#include <hip/hip_runtime.h>
#include <hip/hip_cooperative_groups.h>
#include <cstdio>
namespace cg = cooperative_groups;

#define DI __device__ __forceinline__
#define OPQ(x) asm volatile("" : "+v"(x))
#define LBAR() asm volatile("s_waitcnt lgkmcnt(0)\n\ts_barrier" ::: "memory")
#define OPQS(x) asm volatile("" : "+s"(x))
typedef unsigned short u16;
typedef short bf16x8 __attribute__((ext_vector_type(8)));
typedef short bf16x4 __attribute__((ext_vector_type(4)));
typedef float f32x4 __attribute__((ext_vector_type(4)));
typedef unsigned u32x4 __attribute__((ext_vector_type(4)));
#define LAS __attribute__((address_space(3)))

#ifndef COOP
#define COOP 1
#endif
#ifndef ONLYPH
#define ONLYPH -1
#endif
#ifndef ONLYMIX
#define ONLYMIX -1
#endif
#define MIXON(x) ((MIX < 0 || MIX == (x)) && (ONLYMIX < 0 || ONLYMIX == (x)))
#define PHON(x) (ONLYPH < 0 || ONLYPH == (x))

constexpr int D_MODEL = 1024, BATCH = 16, SEQ = 2048, DEC_BATCH = 8, DEC_SEQ = 16, PAST_LEN = 1024;
constexpr int NTOK = BATCH * SEQ;
constexpr int NSTOK = DEC_BATCH * DEC_SEQ;
constexpr int IN_COLS = 7184;
constexpr int LDP = 7168;
constexpr float EPS = 1e-6f;
constexpr int LDS_BYTES = 147456;
constexpr int NPHASE = 9;

constexpr size_t WS_PROJ = 0;
constexpr size_t WS_WTIN = WS_PROJ + (size_t)NTOK * LDP * 2;
constexpr size_t WS_WTOUT = WS_WTIN + (size_t)2 * LDP * 1024 * 2;
constexpr size_t WS_GATES = WS_WTOUT + (size_t)2 * 1024 * 2048 * 2;
constexpr size_t WS_RSTD = WS_GATES + (size_t)NTOK * 16 * 4;
constexpr size_t WS_SPROJ = WS_RSTD + (size_t)NTOK * 4;
constexpr size_t WS_SGATES = WS_SPROJ + (size_t)NSTOK * LDP * 2;
constexpr size_t WS_SRSTD = WS_SGATES + (size_t)NSTOK * 16 * 4;
constexpr size_t WS_SHI = WS_SRSTD + 512;
constexpr size_t WS_SSQ = WS_SHI + (size_t)NSTOK * 1024 * 2;
constexpr size_t WS_BAR = WS_SSQ + (size_t)(NTOK + NSTOK) * 4 * 4;
constexpr size_t WS_END = WS_BAR + 16384;

constexpr size_t O_YP = 0;
constexpr size_t O_YS = O_YP + (size_t)NTOK * 1024;
constexpr size_t O_PMC = O_YS + (size_t)NSTOK * 1024;
constexpr size_t O_PMN = O_PMC + (size_t)2 * 16 * 4 * 64 * 128;
constexpr size_t O_PMM = O_PMN + (size_t)2 * 16 * 4 * 64;
constexpr size_t O_PRET = O_PMM + (size_t)2 * 16 * 4;
constexpr size_t O_PSSD = O_PRET + (size_t)2 * 16 * 4 * 64 * 128;
constexpr size_t O_PCONV = O_PSSD + (size_t)2 * 16 * 8 * 128 * 64;
constexpr size_t O_PHG = O_PCONV + (size_t)2 * 16 * 3 * 1024;
constexpr size_t O_SMC = O_PHG + (size_t)2 * 16 * 4 * 128 * 128;
constexpr size_t O_SMN = O_SMC + (size_t)2 * 8 * 4 * 64 * 128;
constexpr size_t O_SMM = O_SMN + (size_t)2 * 8 * 4 * 64;
constexpr size_t O_SRET = O_SMM + (size_t)2 * 8 * 4;
constexpr size_t O_SSSD = O_SRET + (size_t)2 * 8 * 4 * 64 * 128;
constexpr size_t O_SCONV = O_SSSD + (size_t)2 * 8 * 8 * 128 * 64;
constexpr size_t O_SHG = O_SCONV + (size_t)2 * 8 * 3 * 1024;
constexpr size_t O_END = O_SHG + (size_t)2 * 8 * 4 * 128 * 128;

struct Params {
    const float* x_prompt; const float* x_sample;
    const float* st_mc; const float* st_mn; const float* st_mm; const float* st_ret; const float* st_ssd; const float* st_conv; const float* st_hg;
    const float* norm_w; const float* w_in; const float* gate_b; const float* mnorm_w; const float* conv_w; const float* conv_b;
    const float* dt_bias; const float* a_log; const float* d_skip; const float* snorm_w; const float* lbraw; const float* hnorm_w;
    const float* w_out; const float* fnorm_w;
    float* out; unsigned char* ws;
    int ph_lo, ph_hi;
};

DI float bf2f(u16 v) { return __uint_as_float(((unsigned)v) << 16); }
typedef __bf16 bf2_t __attribute__((ext_vector_type(2)));
typedef float f2_t __attribute__((ext_vector_type(2)));
DI unsigned pk2(float a, float b) { const f2_t v = {a, b}; const bf2_t r = __builtin_convertvector(v, bf2_t); return __builtin_bit_cast(unsigned, r); }
DI u16 f2bf(float a) { return (u16)(pk2(a, 0.f) & 0xffffu); }
DI float lo16(unsigned w) { return __uint_as_float(w << 16); }
DI float hi16(unsigned w) { return __uint_as_float(w & 0xffff0000u); }
DI void unpack8(const uint4 v, float* f) {
    f[0] = lo16(v.x); f[1] = hi16(v.x); f[2] = lo16(v.y); f[3] = hi16(v.y); f[4] = lo16(v.z); f[5] = hi16(v.z); f[6] = lo16(v.w); f[7] = hi16(v.w);
}
DI uint4 pack8f(const float* f) { uint4 r; r.x = pk2(f[0], f[1]); r.y = pk2(f[2], f[3]); r.z = pk2(f[4], f[5]); r.w = pk2(f[6], f[7]); return r; }
DI bf16x8 as_frag(uint4 v) { return __builtin_bit_cast(bf16x8, v); }
DI bf16x8 pack_acc2(const f32x4 a, const f32x4 b) { uint4 r; r.x = pk2(a[0], a[1]); r.y = pk2(a[2], a[3]); r.z = pk2(b[0], b[1]); r.w = pk2(b[2], b[3]); return __builtin_bit_cast(bf16x8, r); }
DI bf16x8 ldfrag(const u16* p) { return *(const bf16x8*)p; }
DI bf16x8 ldfrag2(const u16* p) { uint2 a = *(const uint2*)p; uint2 b = *(const uint2*)(p + 16); uint4 r; r.x = a.x; r.y = a.y; r.z = b.x; r.w = b.y; return __builtin_bit_cast(bf16x8, r); }
typedef short v4s_t __attribute__((ext_vector_type(4)));
DI bf16x8 ldfrag_tr(const u16* p, const int RS) {
    const v4s_t lo = __builtin_amdgcn_ds_read_tr16_b64_v4i16((LAS v4s_t*)p);
    const v4s_t hi = __builtin_amdgcn_ds_read_tr16_b64_v4i16((LAS v4s_t*)(p + 4 * RS));
    return __builtin_shufflevector(lo, hi, 0, 1, 2, 3, 4, 5, 6, 7);
}
DI v4s_t ld_tr4(const u16* p) { return __builtin_amdgcn_ds_read_tr16_b64_v4i16((LAS v4s_t*)p); }
#define MFMA16(a, b, c) __builtin_amdgcn_mfma_f32_16x16x32_bf16((a), (b), (c), 0, 0, 0)
DI float sigmoidf_(float x) { return __builtin_amdgcn_rcpf(1.f + __expf(-x)); }
DI float siluf_(float x) { return x * __builtin_amdgcn_rcpf(1.f + __expf(-x)); }
DI float softplusf_(float x) { return fmaxf(x, 0.f) + log1pf(__expf(-fabsf(x))); }
DI float logsigf_(float x) { return fminf(x, 0.f) - log1pf(__expf(-fabsf(x))); }
DI float wscan_sum(float x, int lane) {
#pragma unroll
    for (int o = 1; o < 64; o <<= 1) { float t = __shfl_up(x, o); if (lane >= o) x += t; }
    return x;
}
DI float wscan_max(float x, int lane) {
#pragma unroll
    for (int o = 1; o < 64; o <<= 1) { float t = __shfl_up(x, o); if (lane >= o) x = fmaxf(x, t); }
    return x;
}
DI float wsum(float x) {
#pragma unroll
    for (int o = 32; o >= 1; o >>= 1) x += __shfl_xor(x, o);
    return x;
}
DI float red16(float x) { x += __shfl_xor(x, 1); x += __shfl_xor(x, 2); x += __shfl_xor(x, 4); x += __shfl_xor(x, 8); return x; }
DI uint4 ldg16(const u16* p) { return *(const uint4*)p; }
DI uint4 ldsel(const u16* base, unsigned off, bool ok) { const uint4 v = *(const uint4*)(base + (size_t)off); return ok ? v : make_uint4(0u, 0u, 0u, 0u); }
DI uint4 zero4() { uint4 z; z.x = z.y = z.z = z.w = 0u; return z; }

DI int src_col(int n) {
    if (n < 512) return 512 + n;
    if (n < 1024) return 2568 + (n - 512);
    if (n < 1536) return 3592 + (n - 1024);
    if (n < 2048) return 6672 + (n - 1536);
    if (n < 2304) return 0 + (n - 2048);
    if (n < 2560) return 256 + (n - 2304);
    if (n < 3072) return 1024 + (n - 2560);
    if (n < 3584) return 1536 + (n - 3072);
    if (n < 3840) return 2056 + (n - 3584);
    if (n < 4096) return 2312 + (n - 3840);
    if (n < 4608) return 3080 + (n - 4096);
    if (n < 5632) return 4104 + (n - 4608);
    if (n < 6144) return 5136 + (n - 5632);
    if (n < 6656) return 5648 + (n - 6144);
    return 6160 + (n - 6656);
}

namespace pg8 {
constexpr int BM = 256, BK = 64, HALF = 128, HTB = HALF * BK * 2, NXCD = 8, WGM = 8;
DI int lds_byte(int r, int c) { const int st = (r >> 4) * 2 + (c >> 5), rr = r & 15, cc = c & 31, ob = rr * 64 + cc * 2; return st * 1024 + (ob ^ (((ob >> 9) & 1) << 5)); }
DI void stage_rc(int b, int& R, int& C) { const int st = b / 1024, sb = b % 1024, swz = sb ^ (((sb >> 9) & 1) << 5); R = (st >> 1) * 16 + swz / 64; C = (st & 1) * 32 + (swz % 64) / 2; }
DI int perm32(int rho) { const int n = rho >> 4, i = rho & 15; return 8 * (i >> 2) + 4 * n + (i & 3); }
struct Unit { int pm, pn; };
struct Gemm { const u16* A; const u16* Bt; int M, N, K, lda; };
struct StaticOrder {
    int nM, nN, nwg, G, c;
    DI void init(int M, int N, int G_, int c_) { nM = M / BM; nN = N / BM; nwg = nM * nN; G = G_; c = c_; }
    DI bool next(int i, Unit& u) const {
        const long L = (long)i * G + c; if (L >= nwg) return false;
        int wgid = (int)L; { const int q = nwg / NXCD, r = nwg % NXCD, xcd = wgid % NXCD, off = wgid / NXCD; wgid = (xcd < r ? xcd * (q + 1) : r * (q + 1) + (xcd - r) * q) + off; }
        const int nig = WGM * nN, gid = wgid / nig, fm = gid * WGM, gsz = (nM - fm) < WGM ? (nM - fm) : WGM;
        u.pm = fm + ((wgid % nig) % gsz); u.pn = (wgid % nig) / gsz; return true;
    }
};
template <class Epi>
DI void gemm_phase(LAS unsigned char* lds, const Gemm g, const StaticOrder& S, const Epi& E, const int tid) {
    const int wid = __builtin_amdgcn_readfirstlane(tid >> 6), lane = tid & 63, wr = wid >> 2, wc = wid & 3, fr = lane & 15, fq = lane >> 4;
    const int K = g.K, nt = K / BK, lda = g.lda;
    unsigned voffA[2], voffB[2];
#pragma unroll
    for (int i = 0; i < 2; ++i) { int R, C; stage_rc(tid * 16 + i * 8192, R, C); const int Rb = (R & ~31) + perm32(R & 31);
        voffA[i] = (unsigned)(R * lda + C) * 2u; voffB[i] = (unsigned)(Rb * K + C) * 2u; }
    const size_t kstep = (size_t)(BK * 2);
    const size_t hstepA = (size_t)HALF * lda * 2, hstepB = (size_t)HALF * K * 2;
    const size_t tstepA = 2 * hstepA, tstepB = 2 * hstepB;
    const unsigned ldsw = (unsigned)wid * 1024u;
    const int aoff = lds_byte(wr * 64 + fr, fq * 8), boff = lds_byte(wc * 32 + fr, fq * 8);
#define PG8_SA(b, h) (((b) * 2 + (h)) * HTB)
#define PG8_SB(b, h) ((4 + (b) * 2 + (h)) * HTB)
#define PG8_STAGE(bufoff, gbase, voff) do { _Pragma("unroll") for (int _i = 0; _i < 2; ++_i) \
        __builtin_amdgcn_global_load_lds((const unsigned*)((const char*)(gbase) + (voff)[_i]), (LAS unsigned*)(lds + (bufoff) + ldsw + _i * 8192), 16, 0, 0); } while (0)
#define PG8_LDA(dst, b, h) do { _Pragma("unroll") for (int m = 0; m < 4; ++m) _Pragma("unroll") for (int k = 0; k < 2; ++k) dst[m][k] = *(const LAS bf16x8*)(lds + PG8_SA(b, h) + aoff + m * 2048 + k * 1024); } while (0)
#define PG8_LDB(dst, b, h) do { _Pragma("unroll") for (int n = 0; n < 2; ++n) _Pragma("unroll") for (int k = 0; k < 2; ++k) dst[n][k] = *(const LAS bf16x8*)(lds + PG8_SB(b, h) + boff + n * 2048 + k * 1024); } while (0)
#define PG8_MMA(ai, bj, At, Bt) do { __builtin_amdgcn_s_setprio(1); _Pragma("unroll") for (int m = 0; m < 4; ++m) _Pragma("unroll") for (int n = 0; n < 2; ++n) _Pragma("unroll") for (int k = 0; k < 2; ++k) \
        acc[ai][bj][m][n] = __builtin_amdgcn_mfma_f32_16x16x32_bf16(Bt[n][k], At[m][k], acc[ai][bj][m][n], 0, 0, 0); __builtin_amdgcn_s_setprio(0); } while (0)
#define PG8_WAIT_V(n) asm volatile("s_waitcnt vmcnt(" #n ")" ::: "memory")
#define PG8_WAIT_L(n) asm volatile("s_waitcnt lgkmcnt(" #n ")" ::: "memory")
#define PG8_BAR __builtin_amdgcn_s_barrier()
#define PG8_SCHED __builtin_amdgcn_sched_barrier(0)
    Unit cur, nxt; int ui = 0;
    if (!S.next(0, cur)) return;
    f32x4 acc[2][2][4][2];
#pragma unroll
    for (int a = 0; a < 2; ++a)
#pragma unroll
        for (int b = 0; b < 2; ++b)
#pragma unroll
            for (int m = 0; m < 4; ++m)
#pragma unroll
                for (int n = 0; n < 2; ++n) acc[a][b][m][n] = (f32x4){0.f, 0.f, 0.f, 0.f};
    bf16x8 At[4][2], B0[2][2], B1[2][2];
    const char* cA = (const char*)g.A + (size_t)cur.pm * tstepA; const char* cB = (const char*)g.Bt + (size_t)cur.pn * tstepB;
    PG8_STAGE(PG8_SB(0, 0), cB, voffB); PG8_STAGE(PG8_SA(0, 0), cA, voffA); PG8_STAGE(PG8_SB(0, 1), cB + hstepB, voffB); PG8_STAGE(PG8_SA(0, 1), cA + hstepA, voffA);
    if (wr == 1) PG8_BAR;
    PG8_WAIT_V(4); PG8_BAR;
    PG8_STAGE(PG8_SB(1, 0), cB + kstep, voffB); PG8_STAGE(PG8_SA(1, 0), cA + kstep, voffA); PG8_STAGE(PG8_SB(1, 1), cB + hstepB + kstep, voffB);
    PG8_WAIT_V(6); PG8_BAR;
    for (;;) {
        const bool has_next = S.next(ui + 1, nxt);
        const char* nA = has_next ? (const char*)g.A + (size_t)nxt.pm * tstepA : cA; const char* nB = has_next ? (const char*)g.Bt + (size_t)nxt.pn * tstepB : cB;
        for (int t = 0; t < nt; t += 2) {
            const bool last = (t == nt - 2);
            const char* a1 = cA + (size_t)(t + 1) * kstep;
            const char* a2 = last ? nA : cA + (size_t)(t + 2) * kstep; const char* b2 = last ? nB : cB + (size_t)(t + 2) * kstep;
            const char* a3 = a2 + kstep; const char* b3 = b2 + kstep;
            PG8_LDB(B0, 0, 0); PG8_SCHED; PG8_LDA(At, 0, 0); PG8_STAGE(PG8_SA(1, 1), a1 + hstepA, voffA);
            PG8_WAIT_L(8); PG8_BAR; PG8_WAIT_L(0); PG8_MMA(0, 0, At, B0); PG8_BAR; PG8_SCHED;
            PG8_LDB(B1, 0, 1); PG8_STAGE(PG8_SB(0, 0), b2, voffB);
            PG8_BAR; PG8_WAIT_L(0); PG8_MMA(0, 1, At, B1); PG8_BAR;
            PG8_LDA(At, 0, 1); PG8_STAGE(PG8_SA(0, 0), a2, voffA);
            PG8_BAR; PG8_WAIT_L(0); PG8_MMA(1, 0, At, B0); PG8_BAR; PG8_SCHED;
            PG8_STAGE(PG8_SB(0, 1), b2 + hstepB, voffB);
            PG8_WAIT_V(6); PG8_BAR; PG8_MMA(1, 1, At, B1); PG8_BAR;
            PG8_LDB(B0, 1, 0); PG8_SCHED; PG8_LDA(At, 1, 0); PG8_STAGE(PG8_SA(0, 1), a2 + hstepA, voffA);
            PG8_WAIT_L(8); PG8_BAR; PG8_WAIT_L(0); PG8_MMA(0, 0, At, B0); PG8_BAR; PG8_SCHED;
            PG8_LDB(B1, 1, 1); PG8_STAGE(PG8_SB(1, 0), b3, voffB);
            PG8_BAR; PG8_WAIT_L(0); PG8_MMA(0, 1, At, B1); PG8_BAR;
            PG8_LDA(At, 1, 1); PG8_STAGE(PG8_SA(1, 0), a3, voffA);
            PG8_BAR; PG8_WAIT_L(0); PG8_MMA(1, 0, At, B0); PG8_BAR; PG8_SCHED;
            PG8_STAGE(PG8_SB(1, 1), b3 + hstepB, voffB);
            PG8_WAIT_V(6); PG8_BAR; PG8_MMA(1, 1, At, B1); PG8_BAR;
        }
        E(acc, cur, wr, wc, fr, fq);
        if (!has_next) break;
#pragma unroll
        for (int a = 0; a < 2; ++a)
#pragma unroll
            for (int b = 0; b < 2; ++b)
#pragma unroll
                for (int m = 0; m < 4; ++m)
#pragma unroll
                    for (int n = 0; n < 2; ++n) acc[a][b][m][n] = (f32x4){0.f, 0.f, 0.f, 0.f};
        cur = nxt; cA = nA; cB = nB; ++ui;
    }
    PG8_WAIT_V(0);
    if (wr == 0) PG8_BAR;
    PG8_BAR;
#undef PG8_SA
#undef PG8_SB
#undef PG8_STAGE
#undef PG8_LDA
#undef PG8_LDB
#undef PG8_MMA
#undef PG8_WAIT_V
#undef PG8_WAIT_L
#undef PG8_BAR
#undef PG8_SCHED
}
struct EpiIn {
    u16* O; const float* rstd;
    DI void operator()(const f32x4 (&acc)[2][2][4][2], const Unit& u, int wr, int wc, int fr, int fq) const {
        const int row0 = u.pm * BM + wr * 64 + fr, col0 = u.pn * BM + wc * 32 + 8 * fq;
#pragma unroll
        for (int ai = 0; ai < 2; ++ai)
#pragma unroll
            for (int m = 0; m < 4; ++m) {
                const int r = row0 + ai * HALF + m * 16; const float rs = rstd[r];
                u16* rowp = O + (size_t)r * LDP + col0;
#pragma unroll
                for (int bj = 0; bj < 2; ++bj) {
                    const f32x4 a0 = acc[ai][bj][m][0], a1 = acc[ai][bj][m][1];
                    uint4 v; v.x = pk2(a0[0] * rs, a0[1] * rs); v.y = pk2(a0[2] * rs, a0[3] * rs); v.z = pk2(a1[0] * rs, a1[1] * rs); v.w = pk2(a1[2] * rs, a1[3] * rs);
                    *(uint4*)(rowp + bj * HALF) = v;
                }
            }
    }
};
struct EpiOut {
    u16* Xhi; u16* Xlo; const float* xin; u16* projdead; bool last;
    DI void operator()(const f32x4 (&acc)[2][2][4][2], const Unit& u, int wr, int wc, int fr, int fq) const {
        const int row0 = u.pm * BM + wr * 64 + fr, col0 = u.pn * BM + wc * 32 + 8 * fq;
#pragma unroll
        for (int ai = 0; ai < 2; ++ai)
#pragma unroll
            for (int m = 0; m < 4; ++m) {
                const int r = row0 + ai * HALF + m * 16;
#pragma unroll
                for (int bj = 0; bj < 2; ++bj) {
                    const size_t o = (size_t)r * 2048 + col0 + bj * HALF; const size_t oi = (size_t)r * 1024 + col0 + bj * HALF;
                    float res[8];
                    if (xin) { const float4 x0 = *(const float4*)(xin + oi), x1 = *(const float4*)(xin + oi + 4);
                        res[0] = x0.x; res[1] = x0.y; res[2] = x0.z; res[3] = x0.w; res[4] = x1.x; res[5] = x1.y; res[6] = x1.z; res[7] = x1.w; }
                    else { float h8[8], l8[8]; unpack8(*(const uint4*)(Xhi + o), h8); unpack8(*(const uint4*)(Xlo + o), l8);
#pragma unroll
                        for (int e = 0; e < 8; ++e) res[e] = h8[e] + l8[e]; }
                    const f32x4 a0 = acc[ai][bj][m][0], a1 = acc[ai][bj][m][1];
                    float xn[8], lo[8];
#pragma unroll
                    for (int e = 0; e < 4; ++e) { xn[e] = res[e] + a0[e]; xn[4 + e] = res[4 + e] + a1[e]; }
                    if (last) {
                        float* dp = (float*)(projdead + (size_t)r * LDP + 2048) + col0 + bj * HALF;
                        *(float4*)dp = make_float4(xn[0], xn[1], xn[2], xn[3]); *(float4*)(dp + 4) = make_float4(xn[4], xn[5], xn[6], xn[7]);
                    } else {
                        const uint4 hv = pack8f(xn); float hb[8]; unpack8(hv, hb);
#pragma unroll
                        for (int e = 0; e < 8; ++e) lo[e] = xn[e] - hb[e];
                        *(uint4*)(Xhi + o) = hv; *(uint4*)(Xlo + o) = pack8f(lo);
                    }
                }
            }
    }
};
}

DI void convert_weights(const Params& p, float* sm, const int tid) {
    const int NT_IN = 112 * 16, NT_OUT = 16 * 32;
    const int total = 2 * (NT_IN + NT_OUT);
    for (int t = blockIdx.x; t < total; t += gridDim.x) {
        const int l = t / (NT_IN + NT_OUT); int tt = t % (NT_IN + NT_OUT);
        const float* W; u16* Wt; int Ksz, ldw, n0, k0, s0; const float* sc;
        if (tt < NT_IN) { const int nt_ = tt / 16, kt = tt % 16; n0 = nt_ * 64; k0 = kt * 64; W = p.w_in + (size_t)l * 1024 * IN_COLS; ldw = IN_COLS; s0 = src_col(n0);
            Wt = (u16*)(p.ws + WS_WTIN) + (size_t)l * LDP * 1024; Ksz = 1024; sc = p.norm_w + l * 1024; }
        else { tt -= NT_IN; const int nt_ = tt / 32, kt = tt % 32; n0 = nt_ * 64; k0 = kt * 64; W = p.w_out + (size_t)l * 2048 * 1024; ldw = 1024; s0 = n0;
            Wt = (u16*)(p.ws + WS_WTOUT) + (size_t)l * 1024 * 2048; Ksz = 2048; sc = nullptr; }
        {
            const int kr = tid >> 3, c8 = (tid & 7) * 8;
            const float* src = W + (size_t)(k0 + kr) * ldw + s0 + c8;
            const float s = sc ? sc[k0 + kr] : 1.f;
#pragma unroll
            for (int e = 0; e < 8; ++e) sm[kr * 65 + c8 + e] = src[e] * s;
        }
        __syncthreads();
        {
            const int nr = tid >> 3, k8 = (tid & 7) * 8; float f[8];
#pragma unroll
            for (int e = 0; e < 8; ++e) f[e] = sm[(k8 + e) * 65 + nr];
            *(uint4*)(Wt + (size_t)(n0 + nr) * Ksz + k0 + k8) = pack8f(f);
        }
        __syncthreads();
    }
}

template <int MODE>
DI void prep_rows(const float* xf, u16* xh, int nrows, u16* hi, int hstride, bool whi, float* rstd, float* gates, float* copyf, const float* wg  , int gw, int ngw, int lane) {
    for (int r = gw; r < nrows; r += ngw) {
        float x[16];
#pragma unroll
        for (int i = 0; i < 4; ++i) {
            const int k = i * 256 + lane * 4;
            if (MODE == 0) { const float4 v = *(const float4*)(xf + (size_t)r * 1024 + k); x[4 * i] = v.x; x[4 * i + 1] = v.y; x[4 * i + 2] = v.z; x[4 * i + 3] = v.w;
                if (copyf) *(float4*)(copyf + (size_t)r * 1024 + k) = v; }
            else { const uint2 h = *(const uint2*)(xh + (size_t)r * 2048 + k), lo = *(const uint2*)(xh + (size_t)r * 2048 + 1024 + k);
                x[4 * i] = lo16(h.x) + lo16(lo.x); x[4 * i + 1] = hi16(h.x) + hi16(lo.x); x[4 * i + 2] = lo16(h.y) + lo16(lo.y); x[4 * i + 3] = hi16(h.y) + hi16(lo.y); }
        }
        float ss = 0.f;
#pragma unroll
        for (int i = 0; i < 16; ++i) ss += x[i] * x[i];
        ss = wsum(ss);
        const float rs = rsqrtf(ss * (1.f / 1024.f) + EPS);
        if (whi) {
#pragma unroll
            for (int i = 0; i < 4; ++i) { uint2 v; v.x = pk2(x[4 * i], x[4 * i + 1]); v.y = pk2(x[4 * i + 2], x[4 * i + 3]); *(uint2*)(hi + (size_t)r * hstride + i * 256 + lane * 4) = v; }
        }
        float acc[16];
        {
            int ln = lane; OPQ(ln);
#pragma unroll
            for (int j = 0; j < 16; ++j) {
                float a = 0.f;
#pragma unroll
                for (int i = 0; i < 4; ++i) { const f32x4 w = *(const f32x4*)(wg + j * 1024 + i * 256 + ln * 4); a += x[4 * i] * w[0] + x[4 * i + 1] * w[1] + x[4 * i + 2] * w[2] + x[4 * i + 3] * w[3]; }
                acc[j] = a;
            }
        }
        float b8[8], b4[4], b2[2], b1;
        { const bool h = (lane & 1) != 0;
#pragma unroll
          for (int i = 0; i < 8; ++i) { const float snd = h ? acc[i] : acc[i + 8], kp = h ? acc[i + 8] : acc[i]; b8[i] = kp + __shfl_xor(snd, 1); } }
        { const bool h = (lane & 2) != 0;
#pragma unroll
          for (int i = 0; i < 4; ++i) { const float snd = h ? b8[i] : b8[i + 4], kp = h ? b8[i + 4] : b8[i]; b4[i] = kp + __shfl_xor(snd, 2); } }
        { const bool h = (lane & 4) != 0;
#pragma unroll
          for (int i = 0; i < 2; ++i) { const float snd = h ? b4[i] : b4[i + 2], kp = h ? b4[i + 2] : b4[i]; b2[i] = kp + __shfl_xor(snd, 4); } }
        { const bool h = (lane & 8) != 0; const float snd = h ? b2[0] : b2[1], kp = h ? b2[1] : b2[0]; b1 = kp + __shfl_xor(snd, 8); }
        b1 += __shfl_xor(b1, 16); b1 += __shfl_xor(b1, 32);
        const int jg = ((lane & 1) << 3) | ((lane & 2) << 1) | ((lane & 4) >> 1) | ((lane & 8) >> 3);
        if (lane < 16) gates[(size_t)r * 16 + jg] = b1 * rs;
        if (lane == 0) rstd[r] = rs;
    }
}
DI void build_wg(const Params& p, int l, float* wg, const int tid) {
    for (int idx = tid; idx < 16 * 1024; idx += 512) {
        const int k = idx >> 4, j = idx & 15;
        const int col = j < 8 ? 2048 + j : 5128 + (j - 8);
        wg[j * 1024 + k] = p.norm_w[l * 1024 + k] * p.w_in[((size_t)l * 1024 + k) * IN_COLS + col];
    }
}

template <int MODE>
DI void sample_gemm(const u16* A, int lda, const u16* Bt, int N, int K, int gw, int ngw, int lane, u16* sproj, const float* srstd, const float* resid, float* ys) {
    const int fr = lane & 15, fq = lane >> 4;
    const int ntasks = 8 * (N / 16);
    for (int t = gw; t < ntasks; t += ngw) {
        const int rt = t & 7, ct = t >> 3;
        const u16* ap = A + (size_t)(rt * 16 + fr) * lda + 8 * fq;
        const u16* bp = Bt + (size_t)(ct * 16 + fr) * K + 8 * fq;
        f32x4 acc = (f32x4){0.f, 0.f, 0.f, 0.f};
#pragma unroll 16
        for (int k = 0; k < K; k += 32) acc = MFMA16(as_frag(ldg16(ap + k)), as_frag(ldg16(bp + k)), acc);
#pragma unroll
        for (int j = 0; j < 4; ++j) {
            const int r = rt * 16 + 4 * fq + j, c = ct * 16 + fr;
            if (MODE == 0) sproj[(size_t)r * LDP + c] = f2bf(acc[j] * srstd[r]);
            else ys[(size_t)r * 1024 + c] = resid[(size_t)r * 1024 + c] + acc[j];
        }
    }
}

template <int MODE>
DI void chain_mr(unsigned char* sm, const int ht_o, const int hw, const int lane_o, u16* seq, const float* gates,
                 const int nvalid, const int nch, const int pos0, const int h,
                 const float* initC, const float* initN, const float* initM, float* outC, float* outN, float* outM,
                 const float* normw, const float gbi, const float gbf) {
    const int fr_o = lane_o & 15, fq_o = lane_o >> 4;
    const int fr = fr_o, fq = fq_o, ht = ht_o, lane = lane_o;
    u16* sQ = (u16*)sm; u16* sK = (u16*)(sm + 9216); u16* sKW = (u16*)(sm + 18432); u16* sV = (u16*)(sm + 27648); u16* sP = (u16*)(sm + 45056);
    u16* sH = (u16*)sm;
    float* fb = (float*)(sm + 54272);
    float* sCV = fb; float* sMV = fb + 64; float* sWI = fb + 128; float* sEMT = fb + 192; float* sDA = fb + 256; float* sDB = fb + 320; float* sN = fb + 384;
    float* sSQ = fb + 448; float* sSM = fb + 704;
    const int qoff = MODE == 0 ? 2048 + h * 64 : 3584 + h * 64;
    const int koff = MODE == 0 ? 2304 + h * 64 : 3840 + h * 64;
    const int voff = MODE == 0 ? h * 128 : 512 + h * 128;
    const int g1off = MODE == 0 ? 2560 + h * 128 : 4096 + h * 128;
    const int g2off = 3072 + h * 128;
    const float lg = log1pf(-exp2f(-5.f - (float)h));

    f32x4 Cacc[4][2];
#pragma unroll
    for (int m = 0; m < 4; ++m)
#pragma unroll
        for (int n = 0; n < 2; ++n)
#pragma unroll
            for (int j = 0; j < 4; ++j) { const int k = 16 * m + 4 * fq + j, v = 32 * hw + 16 * n + fr; Cacc[m][n][j] = initC ? initC[k * 128 + v] : 0.f; }
    if (MODE == 0 && ht < 64) sN[ht] = initN ? initN[ht] : 0.f;
    float mprev = (MODE == 0) ? (initM ? initM[0] : -1e30f) : 0.f;
    float frq[8];
    if (MODE == 1) {
#pragma unroll
        for (int e = 0; e < 8; ++e) { const int j = (lane & 3) * 8 + e; frq[e] = exp2f(-(float)j * (13.287712379549449f / 32.f)) * 0.15915494309189535f; }
    }
    const int qrow = ht >> 3, qcol = (ht & 7) * 8;
    uint4 pq[2], pk[2], pv[4], pg1[4]; float gi = 0.f, gf = 0.f;
#define MR_OFFQ(i) ((unsigned)((((i) * 32 + (ht >> 3)) < nvalid ? ((i) * 32 + (ht >> 3)) : 0) * LDP + qoff + (ht & 7) * 8))
#define MR_OKQ(i) (((i) * 32 + (ht >> 3)) < nvalid)
#define MR_OFFV(i) ((unsigned)((((i) * 16 + (ht >> 4)) < nvalid ? ((i) * 16 + (ht >> 4)) : 0) * LDP + voff + (ht & 15) * 8))
#define MR_OKV(i) (((i) * 16 + (ht >> 4)) < nvalid)
#define MR_LOAD(c) do { const u16* cb_ = seq + (size_t)(c) * 64 * LDP; \
        _Pragma("unroll") for (int i = 0; i < 2; ++i) { pq[i] = ldsel(cb_, MR_OFFQ(i), MR_OKQ(i)); pk[i] = ldsel(cb_ + (koff - qoff), MR_OFFQ(i), MR_OKQ(i)); } \
        _Pragma("unroll") for (int i = 0; i < 4; ++i) pv[i] = ldsel(cb_, MR_OFFV(i), MR_OKV(i)); \
        if (MODE == 0) { const float* gp = gates + (size_t)(c) * 64 * 16; const unsigned og_ = (unsigned)((lane < nvalid ? lane : 0) * 16 + h); gi = gp[og_]; gf = gp[og_ + 4]; } } while (0)
    MR_LOAD(0);
    __syncthreads();
    for (int c = 0; c < nch; ++c) {
        int fr = fr_o, fq = fq_o, ht = ht_o, lane = lane_o; OPQ(fr); OPQ(fq); OPQ(ht); OPQ(lane);
        const int qrow = ht >> 3, qcol = (ht & 7) * 8;
        float wk_l, wc, mnew = 0.f;
        if (MODE == 0) {
            const float ig = (lane < nvalid) ? gi + gbi : -1e30f;
            const float lf = (lane < nvalid) ? logsigf_(gf + gbf) : 0.f;
            const float b = wscan_sum(lf, lane);
            const float cval = ig - b;
            const float pm = wscan_max(cval, lane);
            const float Ml = fmaxf(mprev, pm);
            const float blast = __shfl(b, 63), M63 = __shfl(Ml, 63);
            wk_l = __expf(cval - M63); wc = __expf(mprev - M63); mnew = blast + M63;
            if (hw == 0) { sCV[lane] = cval; sMV[lane] = Ml; sWI[lane] = __expf(mprev - Ml); sEMT[lane] = __expf(-(b + Ml)); }
        } else {
            wk_l = (lane < nvalid) ? __expf((float)(nvalid - 1 - lane) * lg) : 0.f; wc = __expf((float)nvalid * lg);
            if (hw == 0) sWI[lane] = __expf((float)(lane + 1) * lg);
        }
#pragma unroll
        for (int i = 0; i < 2; ++i) {
            const int row = i * 32 + qrow;
            float kf[8];
            if (MODE == 1) {
                float qf[8], qp[8], kp[8];
                uint4 qv = pq[i], kv = pk[i], qo, ko;
                qo.x = __shfl_xor(qv.x, 4); qo.y = __shfl_xor(qv.y, 4); qo.z = __shfl_xor(qv.z, 4); qo.w = __shfl_xor(qv.w, 4);
                ko.x = __shfl_xor(kv.x, 4); ko.y = __shfl_xor(kv.y, 4); ko.z = __shfl_xor(kv.z, 4); ko.w = __shfl_xor(kv.w, 4);
                unpack8(qv, qf); unpack8(kv, kf); unpack8(qo, qp); unpack8(ko, kp);
                const float sgn = (lane & 4) ? 1.f : -1.f;
                const float pos = (float)(pos0 + c * 64 + row);
#pragma unroll
                for (int e = 0; e < 8; ++e) {
                    float t = pos * frq[e]; t = t - rintf(t);
                    const float cs = __builtin_amdgcn_cosf(t), sn = __builtin_amdgcn_sinf(t);
                    qf[e] = qf[e] * cs + sgn * qp[e] * sn; kf[e] = kf[e] * cs + sgn * kp[e] * sn;
                }
                *(uint4*)(sQ + row * 72 + qcol) = pack8f(qf); *(uint4*)(sK + row * 72 + qcol) = pack8f(kf);
            } else {
                *(uint4*)(sQ + row * 72 + qcol) = pq[i]; *(uint4*)(sK + row * 72 + qcol) = pk[i];
                unpack8(pk[i], kf);
            }
            const float wkr = __shfl(wk_l, row);
#pragma unroll
            for (int e = 0; e < 8; ++e) kf[e] *= wkr;
            *(uint4*)(sKW + row * 72 + qcol) = pack8f(kf);
            __builtin_amdgcn_sched_barrier(0);
        }
#pragma unroll
        for (int i = 0; i < 4; ++i) {
            const int id = i * 256 + ht, row = id >> 4, col = (id & 15) * 8;
            *(uint4*)(sV + row * 136 + col) = pv[i];
        }
        LBAR(); OPQ(fr); OPQ(fq); OPQ(ht); OPQ(lane);
        if (c + 1 < nch) MR_LOAD(c + 1);
        { const u16* cb_ = seq + (size_t)c * 64 * LDP;
#pragma unroll
        for (int i = 0; i < 4; ++i) { pg1[i] = ldsel(cb_ + (g1off - voff), MR_OFFV(i), MR_OKV(i)); } }
        f32x4 O[4][2];
#pragma unroll
        for (int m = 0; m < 4; ++m)
#pragma unroll
            for (int n = 0; n < 2; ++n) O[m][n] = (f32x4){0.f, 0.f, 0.f, 0.f};
#pragma unroll
        for (int t = 0; t < 2; ++t) {
            bf16x8 Bf[2];
#pragma unroll
            for (int n = 0; n < 2; ++n) Bf[n] = pack_acc2(Cacc[2 * t][n], Cacc[2 * t + 1][n]);
#pragma unroll
            for (int m = 0; m < 4; ++m) { const bf16x8 A = ldfrag2(sQ + (16 * m + fr) * 72 + 32 * t + 4 * fq);
#pragma unroll
                for (int n = 0; n < 2; ++n) O[m][n] = MFMA16(A, Bf[n], O[m][n]); }
        }
#pragma unroll
        for (int m = 0; m < 4; ++m) { const f32x4 w4 = *(const f32x4*)(sWI + 16 * m + 4 * fq);
#pragma unroll
            for (int n = 0; n < 2; ++n)
#pragma unroll
                for (int j = 0; j < 4; ++j) O[m][n][j] *= 0.125f * w4[j]; }
        {
            const f32x4 M4 = (MODE == 0) ? *(const f32x4*)(sMV + 16 * hw + 4 * fq) : (f32x4){0.f, 0.f, 0.f, 0.f};
            float rsum[4] = {0.f, 0.f, 0.f, 0.f};
#pragma unroll
            for (int n = 0; n < 4; ++n) {
                if (n <= hw) {
                    f32x4 S = (f32x4){0.f, 0.f, 0.f, 0.f};
#pragma unroll
                    for (int t = 0; t < 2; ++t) S = MFMA16(ldfrag(sQ + (16 * hw + fr) * 72 + 32 * t + 8 * fq), ldfrag(sK + (16 * n + fr) * 72 + 32 * t + 8 * fq), S);
                    const int s = 16 * n + fr; const float cs = (MODE == 0) ? sCV[s] : 0.f;
#pragma unroll
                    for (int j = 0; j < 4; ++j) {
                        const int l = 16 * hw + 4 * fq + j;
                        float w;
                        if (MODE == 0) w = (s <= l) ? 0.125f * __expf(cs - M4[j]) : 0.f; else w = (s <= l) ? 0.125f * __expf((float)(l - s) * lg) : 0.f;
                        const float pp = S[j] * w; rsum[j] += pp; sP[l * 72 + s] = f2bf(pp);
                    }
                } else {
#pragma unroll
                    for (int j = 0; j < 4; ++j) sP[(16 * hw + 4 * fq + j) * 72 + 16 * n + fr] = 0;
                }
            }
            if (MODE == 0) {
#pragma unroll
                for (int j = 0; j < 4; ++j) { const float r = red16(rsum[j]); if (fr == 0) sDA[16 * hw + 4 * fq + j] = r; }
            }
        }
        float nn = 0.f;
        if (MODE == 0) {
            const int l = ht >> 2, part = ht & 3; float a = 0.f, b2 = 0.f;
#pragma unroll
            for (int e = 0; e < 16; ++e) { a += bf2f(sQ[l * 72 + part * 16 + e]) * sN[part * 16 + e]; b2 += bf2f(sKW[(part * 16 + e) * 72 + l]); }
            a += __shfl_xor(a, 1); a += __shfl_xor(a, 2); b2 += __shfl_xor(b2, 1); b2 += __shfl_xor(b2, 2);
            if (part == 0) sDB[l] = 0.125f * a;
            nn = wc * sN[l] + b2;
        }
        LBAR(); OPQ(fr); OPQ(fq); OPQ(ht); OPQ(lane);
        if (MODE == 0 && (ht & 3) == 0) sN[ht >> 2] = nn;
#pragma unroll
        for (int m = 0; m < 4; ++m)
#pragma unroll
            for (int n = 0; n < 2; ++n)
#pragma unroll
                for (int j = 0; j < 4; ++j) Cacc[m][n][j] *= wc;
#pragma unroll
        for (int t = 0; t < 2; ++t) {
            bf16x8 Bv[2];
#pragma unroll
            for (int n = 0; n < 2; ++n) Bv[n] = ldfrag_tr(sV + (32 * t + 8 * fq + ((fr >> 2) & 3)) * 136 + 32 * hw + 16 * n + 4 * (fr & 3), 136);
#pragma unroll
            for (int m = 0; m < 4; ++m) { const bf16x8 Ap = ldfrag(sP + (16 * m + fr) * 72 + 32 * t + 8 * fq); const bf16x8 Ak = ldfrag_tr(sKW + (32 * t + 8 * fq + ((fr >> 2) & 3)) * 72 + 16 * m + 4 * (fr & 3), 72);
#pragma unroll
                for (int n = 0; n < 2; ++n) { O[m][n] = MFMA16(Ap, Bv[n], O[m][n]); Cacc[m][n] = MFMA16(Ak, Bv[n], Cacc[m][n]); } }
        }
#pragma unroll
        for (int m = 0; m < 4; ++m) {
            f32x4 dn = (f32x4){1.f, 1.f, 1.f, 1.f};
            if (MODE == 0) { const f32x4 da = *(const f32x4*)(sDA + 16 * m + 4 * fq), db = *(const f32x4*)(sDB + 16 * m + 4 * fq), wi = *(const f32x4*)(sWI + 16 * m + 4 * fq), em = *(const f32x4*)(sEMT + 16 * m + 4 * fq);
#pragma unroll
                for (int j = 0; j < 4; ++j) dn[j] = __builtin_amdgcn_rcpf(fmaxf(fabsf(da[j] + wi[j] * db[j]), em[j])); }
#pragma unroll
            for (int j = 0; j < 4; ++j) {
                const int l = 16 * m + 4 * fq + j;
                const float h0 = O[m][0][j] * dn[j], h1 = O[m][1][j] * dn[j];
                float sq = h0 * h0 + h1 * h1, su = h0 + h1;
                sq = red16(sq); if (MODE == 1) su = red16(su);
                if (fr == 0) { sSQ[hw * 64 + l] = sq; if (MODE == 1) sSM[hw * 64 + l] = su; }
                sH[l * 136 + 32 * hw + fr] = f2bf(h0); sH[l * 136 + 32 * hw + 16 + fr] = f2bf(h1);
            }
        }
        LBAR(); OPQ(fr); OPQ(fq); OPQ(ht); OPQ(lane);
#pragma unroll
        for (int i = 0; i < 4; ++i) {
            const int id = i * 256 + ht, row = id >> 4, col = (id & 15) * 8;
            if (row < nvalid) {
                const float ssq = sSQ[row] + sSQ[64 + row] + sSQ[128 + row] + sSQ[192 + row];
                float hv[8], g1[8], o[8]; unpack8(*(const uint4*)(sH + row * 136 + col), hv); unpack8(pg1[i], g1);
                if (MODE == 0) {
                    float g2[8]; unpack8(ldsel(seq + (size_t)c * 64 * LDP + (g2off - voff), MR_OFFV(i), true), g2);
                    const float rs = rsqrtf(ssq * (1.f / 128.f) + EPS);
#pragma unroll
                    for (int e = 0; e < 8; ++e) o[e] = hv[e] * rs * normw[col + e] * sigmoidf_(g1[e]) * siluf_(g2[e]);
                } else {
                    const float mean = (sSM[row] + sSM[64 + row] + sSM[128 + row] + sSM[192 + row]) * (1.f / 128.f);
                    const float var = fmaxf(ssq * (1.f / 128.f) - mean * mean, 0.f);
                    const float rs = rsqrtf(var + EPS);
#pragma unroll
                    for (int e = 0; e < 8; ++e) o[e] = (hv[e] - mean) * rs * siluf_(g1[e]);
                }
                *(uint4*)(seq + (size_t)c * 64 * LDP + (size_t)MR_OFFV(i)) = pack8f(o);
            }
            __builtin_amdgcn_sched_barrier(0);
        }
        mprev = mnew;
        LBAR(); OPQ(fr); OPQ(fq); OPQ(ht); OPQ(lane);
    }
#undef MR_LOAD
#undef MR_OFFQ
#undef MR_OKQ
#undef MR_OFFV
#undef MR_OKV
    OPQS(outC); OPQS(outN); OPQS(outM);
#pragma unroll
    for (int m = 0; m < 4; ++m)
#pragma unroll
        for (int n = 0; n < 2; ++n)
#pragma unroll
            for (int j = 0; j < 4; ++j) { const int k = 16 * m + 4 * fq + j, v = 32 * hw + 16 * n + fr; outC[k * 128 + v] = Cacc[m][n][j]; }
    if (MODE == 0) { if (ht < 64) outN[ht] = sN[ht]; if (ht == 0) outM[0] = mprev; }
}

DI void chain_hgrn(unsigned char* sm, const int tid_o, const int w, const int lane_o, u16* seq, const int nvalid, const int nch, const int h,
                   const float* lbraw, const int layer, const float* initS, float* outS, const float* normw) {
    const int fr_o = lane_o & 15, fq_o = lane_o >> 4;
    const int fr = fr_o, fq = fq_o, tid = tid_o;
    float* LFB = (float*)sm;
    u16* sQ = (u16*)(sm + 33792); u16* sK = (u16*)(sm + 51200); u16* sKW = (u16*)(sm + 68608); u16* sV = (u16*)(sm + 86016); u16* sP = (u16*)(sm + 103424);
    u16* sH = sQ;
    float* TOT = (float*)(sm + 112640); float* BLAST = (float*)(sm + 114688); float* DEC = (float*)(sm + 115200); float* SSQ = (float*)(sm + 115712);
    const int qoff = 5632 + h * 128, foff = 6144 + h * 128, ioff = 6656 + h * 128, goff = 1536 + h * 128;
    const int k0 = (tid & 15) * 8;
    float lbv[8];
#pragma unroll
    for (int e = 0; e < 8; ++e) { const int cidx = h * 128 + k0 + e; lbv[e] = (float)layer * sigmoidf_(lbraw[512 + cidx] - lbraw[cidx]); }
    f32x4 Sacc[8];
#pragma unroll
    for (int m = 0; m < 8; ++m)
#pragma unroll
        for (int j = 0; j < 4; ++j) Sacc[m][j] = initS ? initS[(16 * m + 4 * fq + j) * 128 + 16 * w + fr] : 0.f;
    uint4 phq[2], phf[2], phi[2], pg[2];
#define HG_OFF(i) ((unsigned)((((i) * 32 + (tid >> 4)) < nvalid ? ((i) * 32 + (tid >> 4)) : 0) * LDP + qoff + (tid & 15) * 8))
#define HG_OK(i) (((i) * 32 + (tid >> 4)) < nvalid)
#define HG_LOAD(c) do { const u16* cb_ = seq + (size_t)(c) * 64 * LDP; _Pragma("unroll") for (int i = 0; i < 2; ++i) { \
        phq[i] = ldsel(cb_, HG_OFF(i), HG_OK(i)); phf[i] = ldsel(cb_ + (foff - qoff), HG_OFF(i), HG_OK(i)); phi[i] = ldsel(cb_ + (ioff - qoff), HG_OFF(i), HG_OK(i)); } } while (0)
    HG_LOAD(0);
    __syncthreads();
    for (int c = 0; c < nch; ++c) {
        int fr = fr_o, fq = fq_o, tid = tid_o; OPQ(fr); OPQ(fq); OPQ(tid);
        const int k0 = (tid & 15) * 8;
        float qf[2][8], kk[2][8];
#pragma unroll
        for (int i = 0; i < 2; ++i) {
            const int row = (i * 512 + tid) >> 4;
            float hf[8], lf[8]; unpack8(phq[i], qf[i]); unpack8(phf[i], hf);
#pragma unroll
            for (int e = 0; e < 8; ++e) {
                const float sg = sigmoidf_(hf[e]);
                if (row < nvalid) { lf[e] = __logf(lbv[e] + (1.f - lbv[e]) * sg); kk[i][e] = (1.f - lbv[e]) * (1.f - sg); } else { lf[e] = 0.f; kk[i][e] = 0.f; }
            }
            *(f32x4*)(LFB + row * 132 + k0) = (f32x4){lf[0], lf[1], lf[2], lf[3]}; *(f32x4*)(LFB + row * 132 + k0 + 4) = (f32x4){lf[4], lf[5], lf[6], lf[7]};
            *(uint4*)(sV + row * 136 + k0) = phi[i];
        }
        LBAR(); OPQ(fr); OPQ(fq); OPQ(tid);
        {
            const int k = tid & 127, seg = tid >> 7; float loc[16], run = 0.f;
#pragma unroll
            for (int i = 0; i < 16; ++i) { run += LFB[(16 * seg + i) * 132 + k]; loc[i] = run; }
            TOT[seg * 128 + k] = run;
            LBAR(); OPQ(fr); OPQ(fq); OPQ(tid);
            float off = 0.f;
#pragma unroll
            for (int s2 = 0; s2 < 3; ++s2) if (s2 < seg) off += TOT[s2 * 128 + k];
#pragma unroll
            for (int i = 0; i < 16; ++i) LFB[(16 * seg + i) * 132 + k] = loc[i] + off;
            if (seg == 3) { const float bl = off + run; BLAST[k] = bl; DEC[k] = __expf(bl); }
        }
        LBAR(); OPQ(fr); OPQ(fq); OPQ(tid);
#pragma unroll
        for (int i = 0; i < 2; ++i) {
            const int row = (i * 512 + tid) >> 4;
            const f32x4 b0 = *(const f32x4*)(LFB + row * 132 + k0), b1 = *(const f32x4*)(LFB + row * 132 + k0 + 4);
            const f32x4 l0 = *(const f32x4*)(BLAST + k0), l1 = *(const f32x4*)(BLAST + k0 + 4);
            float qt[8], kt[8], kw[8];
#pragma unroll
            for (int e = 0; e < 8; ++e) {
                const float b = e < 4 ? b0[e & 3] : b1[e & 3], bl = e < 4 ? l0[e & 3] : l1[e & 3];
                qt[e] = qf[i][e] * __expf(b); kt[e] = kk[i][e] * __expf(fminf(-b, 80.f));
                kw[e] = kk[i][e] * __expf(bl - b);
            }
            *(uint4*)(sQ + row * 136 + k0) = pack8f(qt); *(uint4*)(sK + row * 136 + k0) = pack8f(kt); *(uint4*)(sKW + row * 136 + k0) = pack8f(kw);
        }
        LBAR(); OPQ(fr); OPQ(fq); OPQ(tid);
        if (c + 1 < nch) HG_LOAD(c + 1);
#pragma unroll
        for (int i = 0; i < 2; ++i) pg[i] = ldsel(seq + (size_t)c * 64 * LDP + goff - qoff, HG_OFF(i), HG_OK(i));
        f32x4 O[4];
#pragma unroll
        for (int m = 0; m < 4; ++m) O[m] = (f32x4){0.f, 0.f, 0.f, 0.f};
#pragma unroll
        for (int t = 0; t < 4; ++t) {
            const bf16x8 Bf = pack_acc2(Sacc[2 * t], Sacc[2 * t + 1]);
#pragma unroll
            for (int m = 0; m < 4; ++m) O[m] = MFMA16(ldfrag2(sQ + (16 * m + fr) * 136 + 32 * t + 4 * fq), Bf, O[m]);
        }
        {
            const int mt = w >> 1;
#pragma unroll
            for (int nn = 0; nn < 2; ++nn) {
                const int n = (w & 1) * 2 + nn;
                if (n <= mt) {
                    f32x4 S = (f32x4){0.f, 0.f, 0.f, 0.f};
#pragma unroll
                    for (int t = 0; t < 4; ++t) S = MFMA16(ldfrag(sQ + (16 * mt + fr) * 136 + 32 * t + 8 * fq), ldfrag(sK + (16 * n + fr) * 136 + 32 * t + 8 * fq), S);
#pragma unroll
                    for (int j = 0; j < 4; ++j) { const int l = 16 * mt + 4 * fq + j, s = 16 * n + fr; sP[l * 72 + s] = (s <= l) ? f2bf(S[j]) : (u16)0; }
                } else {
#pragma unroll
                    for (int j = 0; j < 4; ++j) sP[(16 * mt + 4 * fq + j) * 72 + 16 * n + fr] = 0;
                }
            }
        }
        LBAR(); OPQ(fr); OPQ(fq); OPQ(tid);
#pragma unroll
        for (int m = 0; m < 8; ++m) { const f32x4 d4 = *(const f32x4*)(DEC + 16 * m + 4 * fq);
#pragma unroll
            for (int j = 0; j < 4; ++j) Sacc[m][j] *= d4[j]; }
#pragma unroll
        for (int t = 0; t < 2; ++t) {
            const bf16x8 Bv = ldfrag_tr(sV + (32 * t + 8 * fq + ((fr >> 2) & 3)) * 136 + 16 * w + 4 * (fr & 3), 136);
#pragma unroll
            for (int m = 0; m < 4; ++m) O[m] = MFMA16(ldfrag(sP + (16 * m + fr) * 72 + 32 * t + 8 * fq), Bv, O[m]);
#pragma unroll
            for (int m = 0; m < 8; ++m) Sacc[m] = MFMA16(ldfrag_tr(sKW + (32 * t + 8 * fq + ((fr >> 2) & 3)) * 136 + 16 * m + 4 * (fr & 3), 136), Bv, Sacc[m]);
        }
#pragma unroll
        for (int m = 0; m < 4; ++m)
#pragma unroll
            for (int j = 0; j < 4; ++j) {
                const int l = 16 * m + 4 * fq + j; const float o = O[m][j] * 0.08838834764831845f;
                const float sq = red16(o * o);
                if (fr == 0) SSQ[w * 64 + l] = sq;
                sH[l * 136 + 16 * w + fr] = f2bf(o);
            }
        LBAR(); OPQ(fr); OPQ(fq); OPQ(tid);
#pragma unroll
        for (int i = 0; i < 2; ++i) {
            const int row = (i * 512 + tid) >> 4;
            if (row < nvalid) {
                float ssq = 0.f;
#pragma unroll
                for (int ww = 0; ww < 8; ++ww) ssq += SSQ[ww * 64 + row];
                const float rs = rsqrtf(ssq * (1.f / 128.f) + EPS);
                float hv[8], g[8], o[8]; unpack8(*(const uint4*)(sH + row * 136 + k0), hv); unpack8(pg[i], g);
#pragma unroll
                for (int e = 0; e < 8; ++e) o[e] = hv[e] * rs * normw[k0 + e] * siluf_(g[e]);
                *(uint4*)(seq + (size_t)c * 64 * LDP + goff - qoff + (size_t)HG_OFF(i)) = pack8f(o);
            }
            __builtin_amdgcn_sched_barrier(0);
        }
        LBAR(); OPQ(fr); OPQ(fq); OPQ(tid);
    }
#undef HG_LOAD
#undef HG_OFF
#undef HG_OK
    OPQS(outS);
#pragma unroll
    for (int m = 0; m < 8; ++m)
#pragma unroll
        for (int j = 0; j < 4; ++j) outS[(16 * m + 4 * fq + j) * 128 + 16 * w + fr] = Sacc[m][j];
}

DI void block_ssd(unsigned char* sm, const int tid_o, const int w, const int lane_o, u16* seq, const float* gates, const int nvalid, const int nch, const int g, const int hp,
                  const float* convw, const float* convb, const float* dtb, const float* alog, const float* dsk, const float* snw,
                  const float* initH, const float* initConv, float* outH, float* outConv, float* ssq) {
    const int fr_o = lane_o & 15, fq_o = lane_o >> 4, hh = w >> 2, jw = w & 3, head = g * 4 + hp * 2 + hh;
    const int fr = fr_o, fq = fq_o, lane = lane_o, tid = tid_o;
    u16* sC = (u16*)sm; u16* sB = (u16*)(sm + 17408); u16* sX = (u16*)(sm + 34816);
    u16* sP = (u16*)(sm + 52224 + hh * 9216);
    u16* OB = (u16*)sm;
    float* TAB = (float*)(sm + 70656);
    float* BV = (float*)(sm + 78336); float* DTV = BV + 128; float* WV = BV + 256;
    const int rs8 = w;
    for (int idx = tid; idx < 5 * 384; idx += 512) {
        const int tap = idx / 384, lc = idx - tap * 384, c8 = lc >> 3, e = lc & 7;
        const int ch = (c8 < 16 ? g * 256 + hp * 128 + c8 * 8 : (c8 < 32 ? 512 + g * 128 + (c8 - 16) * 8 : 768 + g * 128 + (c8 - 32) * 8)) + e;
        TAB[idx] = tap < 4 ? convw[tap * 1024 + ch] : convb[ch];
    }
    f32x4 hacc[8];
#pragma unroll
    for (int m = 0; m < 8; ++m)
#pragma unroll
        for (int j = 0; j < 4; ++j) hacc[m][j] = initH ? initH[((size_t)head * 128 + 16 * m + 4 * fq + j) * 64 + 16 * jw + fr] : 0.f;
    const float dtbias = dtb[head], Aneg = -__expf(alog[head]), Dsk = dsk[head];
    uint4 pr[11]; float sdt = 0.f;
#define SSD_CP (lane < 48 ? lane : 47)
#define SSD_GCOL (SSD_CP < 16 ? 4608 + g * 256 + hp * 128 + SSD_CP * 8 : (SSD_CP < 32 ? 4608 + 512 + g * 128 + (SSD_CP - 16) * 8 : 4608 + 768 + g * 128 + (SSD_CP - 32) * 8))
#define SSD_OFFZ(i) ((unsigned)((((i) * 32 + (tid >> 4)) < nvalid ? ((i) * 32 + (tid >> 4)) : 0) * LDP + 1024 + g * 256 + hp * 128 + (tid & 15) * 8))
#define SSD_OKZ(i) (((i) * 32 + (tid >> 4)) < nvalid)
#define SSD_LOAD(c) do { const u16* cb_ = seq + (size_t)(c) * 64 * LDP; const unsigned gc_ = (unsigned)SSD_GCOL; _Pragma("unroll") for (int i = 0; i < 11; ++i) { const int row = 8 * rs8 - 3 + i; \
        const bool ok_ = row < nvalid && ((c) * 64 + row) >= 0; pr[i] = ldsel(cb_ + (ok_ ? row * LDP : 0), gc_, ok_); } \
        sdt = (lane < nvalid) ? gates[(size_t)(c) * 64 * 16 + (unsigned)((lane < nvalid ? lane : 0) * 16 + 8 + head)] : 0.f; } while (0)
    SSD_LOAD(0);
    __syncthreads();
    for (int c = 0; c < nch; ++c) {
        int fr = fr_o, fq = fq_o, lane = lane_o, tid = tid_o; OPQ(fr); OPQ(fq); OPQ(lane); OPQ(tid);
        const int cp = SSD_CP; const bool act = lane < 48; const int gcol = SSD_GCOL;
        {
            const bool useinit = (c == 0 && rs8 == 0 && initConv != nullptr);
            u16* dstp = cp < 16 ? sX + cp * 8 : (cp < 32 ? sB + (cp - 16) * 8 : sC + (cp - 32) * 8);
            uint2 ylo[8];
#pragma unroll 1
            for (int half = 0; half < 2; ++half) {
                f32x4 tw[5];
#pragma unroll
                for (int tp = 0; tp < 5; ++tp) tw[tp] = *(const f32x4*)(TAB + tp * 384 + cp * 8 + half * 4);
                f32x4 acc[8];
#pragma unroll
                for (int i = 0; i < 8; ++i) acc[i] = tw[4];
#pragma unroll
                for (int k = 0; k < 11; ++k) {
                    const unsigned w0 = half ? pr[k].z : pr[k].x, w1 = half ? pr[k].w : pr[k].y;
                    f32x4 cur = (f32x4){lo16(w0), hi16(w0), lo16(w1), hi16(w1)};
                    if (k < 3 && useinit) cur = *(const f32x4*)(initConv + k * 1024 + (gcol - 4608) + half * 4);
#pragma unroll
                    for (int i = 0; i < 8; ++i) {
                        if (k - i >= 0 && k - i <= 3) {
#pragma unroll
                            for (int e = 0; e < 4; ++e) acc[i][e] += tw[k - i][e] * cur[e];
                        }
                    }
                }
#pragma unroll
                for (int i = 0; i < 8; ++i) {
                    const int row = 8 * rs8 + i;
                    float y[4];
#pragma unroll
                    for (int e = 0; e < 4; ++e) y[e] = (row < nvalid) ? siluf_(acc[i][e]) : 0.f;
                    uint2 pk; pk.x = pk2(y[0], y[1]); pk.y = pk2(y[2], y[3]);
                    if (half == 0) ylo[i] = pk;
                    else if (act) { uint4 v; v.x = ylo[i].x; v.y = ylo[i].y; v.z = pk.x; v.w = pk.y; *(uint4*)(dstp + row * 136) = v; }
                }
            }
        }
        float blast;
        {
            const float dt = (lane < nvalid) ? softplusf_(sdt + dtbias) : 0.f;
            const float la = dt * Aneg;
            const float b = wscan_sum(la, lane);
            blast = __shfl(b, 63);
            if (jw == 0) { BV[hh * 64 + lane] = b; DTV[hh * 64 + lane] = dt; WV[hh * 64 + lane] = __expf(blast - b) * dt; }
        }
        LBAR(); OPQ(fr); OPQ(fq); OPQ(lane); OPQ(tid);
        uint4 psz[2];
#pragma unroll
        for (int i = 0; i < 2; ++i) psz[i] = ldsel(seq + (size_t)c * 64 * LDP, SSD_OFFZ(i), SSD_OKZ(i));
        f32x4 O[4];
#pragma unroll
        for (int m = 0; m < 4; ++m) O[m] = (f32x4){0.f, 0.f, 0.f, 0.f};
#pragma unroll
        for (int t = 0; t < 4; ++t) {
            const bf16x8 Bf = pack_acc2(hacc[2 * t], hacc[2 * t + 1]);
#pragma unroll
            for (int m = 0; m < 4; ++m) O[m] = MFMA16(ldfrag2(sC + (16 * m + fr) * 136 + 32 * t + 4 * fq), Bf, O[m]);
        }
#pragma unroll
        for (int m = 0; m < 4; ++m) { const f32x4 b4 = *(const f32x4*)(BV + hh * 64 + 16 * m + 4 * fq);
#pragma unroll
            for (int j = 0; j < 4; ++j) O[m][j] *= __expf(b4[j]); }
        {
            const int mt = jw;
            const f32x4 bl4 = *(const f32x4*)(BV + hh * 64 + 16 * mt + 4 * fq);
#pragma unroll
            for (int n = 0; n < 4; ++n) {
                if (n <= mt) {
                    f32x4 S = (f32x4){0.f, 0.f, 0.f, 0.f};
#pragma unroll
                    for (int t = 0; t < 4; ++t) S = MFMA16(ldfrag(sC + (16 * mt + fr) * 136 + 32 * t + 8 * fq), ldfrag(sB + (16 * n + fr) * 136 + 32 * t + 8 * fq), S);
                    const int s = 16 * n + fr; const float bs = BV[hh * 64 + s], ds = DTV[hh * 64 + s];
#pragma unroll
                    for (int j = 0; j < 4; ++j) { const int l = 16 * mt + 4 * fq + j; sP[l * 72 + s] = (s <= l) ? f2bf(S[j] * __expf(bl4[j] - bs) * ds) : (u16)0; }
                } else {
#pragma unroll
                    for (int j = 0; j < 4; ++j) sP[(16 * mt + 4 * fq + j) * 72 + 16 * n + fr] = 0;
                }
            }
        }
        LBAR(); OPQ(fr); OPQ(fq); OPQ(lane); OPQ(tid);
        if (c + 1 < nch) SSD_LOAD(c + 1);
        {
            const float eb = __expf(blast);
#pragma unroll
            for (int m = 0; m < 8; ++m)
#pragma unroll
                for (int j = 0; j < 4; ++j) hacc[m][j] *= eb;
        }
#pragma unroll
        for (int t = 0; t < 2; ++t) {
            const f32x4 w0 = *(const f32x4*)(WV + hh * 64 + 32 * t + 8 * fq), w1 = *(const f32x4*)(WV + hh * 64 + 32 * t + 8 * fq + 4);
            const bf16x8 Bv = ldfrag_tr(sX + (32 * t + 8 * fq + ((fr >> 2) & 3)) * 136 + hh * 64 + 16 * jw + 4 * (fr & 3), 136);
            float x[8]; unpack8(__builtin_bit_cast(uint4, Bv), x);
#pragma unroll
            for (int e = 0; e < 4; ++e) { x[e] *= w0[e]; x[4 + e] *= w1[e]; }
            const bf16x8 Bw = as_frag(pack8f(x));
#pragma unroll
            for (int m = 0; m < 4; ++m) O[m] = MFMA16(ldfrag(sP + (16 * m + fr) * 72 + 32 * t + 8 * fq), Bv, O[m]);
#pragma unroll
            for (int m = 0; m < 8; ++m) hacc[m] = MFMA16(ldfrag_tr(sB + (32 * t + 8 * fq + ((fr >> 2) & 3)) * 136 + 16 * m + 4 * (fr & 3), 136), Bw, hacc[m]);
        }
#pragma unroll
        for (int m = 0; m < 4; ++m) {
            const int pcol = hh * 64 + 16 * jw + fr;
            const uint2 xr = __builtin_bit_cast(uint2, ld_tr4(sX + (16 * m + 4 * fq + ((fr >> 2) & 3)) * 136 + hh * 64 + 16 * jw + 4 * (fr & 3)));
            const float xs0 = lo16(xr.x), xs1 = hi16(xr.x), xs2 = lo16(xr.y), xs3 = hi16(xr.y);
            const int l0 = 16 * m + 4 * fq;
            OB[(l0 + 0) * 136 + pcol] = f2bf(O[m][0] + Dsk * xs0);
            OB[(l0 + 1) * 136 + pcol] = f2bf(O[m][1] + Dsk * xs1);
            OB[(l0 + 2) * 136 + pcol] = f2bf(O[m][2] + Dsk * xs2);
            OB[(l0 + 3) * 136 + pcol] = f2bf(O[m][3] + Dsk * xs3);
        }
        LBAR(); OPQ(fr); OPQ(fq); OPQ(lane); OPQ(tid);
#pragma unroll
        for (int i = 0; i < 2; ++i) {
            const int id = i * 512 + tid, row = id >> 4, col = (id & 15) * 8;
            float yv[8], z[8], val[8]; unpack8(*(const uint4*)(OB + row * 136 + col), yv); unpack8(psz[i], z);
            float ss = 0.f;
#pragma unroll
            for (int e = 0; e < 8; ++e) { val[e] = yv[e] * siluf_(z[e]); ss += val[e] * val[e]; }
            ss = red16(ss);
            if (row < nvalid) {
                if ((tid & 15) == 0) ssq[(size_t)(c * 64 + row) * 4 + g * 2 + hp] = ss;
                float o[8];
#pragma unroll
                for (int e = 0; e < 8; ++e) o[e] = val[e] * snw[g * 256 + hp * 128 + col + e];
                *(uint4*)(seq + (size_t)c * 64 * LDP + (size_t)SSD_OFFZ(i)) = pack8f(o);
            }
            __builtin_amdgcn_sched_barrier(0);
        }
        LBAR(); OPQ(fr); OPQ(fq); OPQ(lane); OPQ(tid);
    }
#undef SSD_LOAD
#undef SSD_GCOL
#undef SSD_CP
#undef SSD_OFFZ
#undef SSD_OKZ
    OPQS(outH); OPQS(outConv);
#pragma unroll
    for (int m = 0; m < 8; ++m)
#pragma unroll
        for (int j = 0; j < 4; ++j) outH[((size_t)head * 128 + 16 * m + 4 * fq + j) * 64 + 16 * jw + fr] = hacc[m][j];
    if (hp == 0) {
        const int T = (nch - 1) * 64 + nvalid;
        for (int idx = tid; idx < 3 * 512; idx += 512) { const int rr = idx >> 9, ch = g * 512 + (idx & 511);
            outConv[rr * 1024 + ch] = bf2f(seq[(size_t)(T - 3 + rr) * LDP + 4608 + ch]); }
    }
}

template <int MIX>
DI void mixer_phase(const Params& p, int l_in, unsigned char* sm) {
    const int l = __builtin_amdgcn_readfirstlane(l_in);
    u16* proj = (u16*)(p.ws + WS_PROJ); u16* sproj = (u16*)(p.ws + WS_SPROJ);
    const float* gates = (const float*)(p.ws + WS_GATES); const float* sgates = (const float*)(p.ws + WS_SGATES);
    float* out = p.out;
    float* ssqb = (float*)(p.ws + WS_SSQ);
    for (int task = blockIdx.x; task < 288; task += gridDim.x) {
        int tid = threadIdx.x; OPQ(tid);
        const int w = __builtin_amdgcn_readfirstlane(tid >> 6), lane = tid & 63;
        const int tk = __builtin_amdgcn_readfirstlane(task);
        if (MIXON(0) && (tk < 32 || (tk >= 96 && tk < 160))) {
            const bool smp = tk < 32; const int t2 = smp ? tk : tk - 96; const int b = t2 >> 2, g = (t2 >> 1) & 1, hp = t2 & 1;
            u16* seq = smp ? sproj + (size_t)b * 16 * LDP : proj + (size_t)b * SEQ * LDP;
            const float* gt = smp ? sgates + (size_t)b * 16 * 16 : gates + (size_t)b * SEQ * 16;
            const int nb = smp ? DEC_BATCH : BATCH;
            float* oH = out + (smp ? O_SSSD : O_PSSD) + ((size_t)l * nb + b) * 8 * 128 * 64;
            float* oC = out + (smp ? O_SCONV : O_PCONV) + ((size_t)l * nb + b) * 3 * 1024;
            float* sq = ssqb + (smp ? (size_t)(NTOK + b * 16) * 4 : (size_t)b * SEQ * 4);
            block_ssd(sm, tid, w, lane, seq, gt, smp ? 16 : 64, smp ? 1 : 32, g, hp,
                      p.conv_w + (size_t)l * 4 * 1024, p.conv_b + l * 1024, p.dt_bias + l * 8, p.a_log + l * 8, p.d_skip + l * 8, p.snorm_w + l * 512,
                      smp ? p.st_ssd + ((size_t)l * DEC_BATCH + b) * 8 * 128 * 64 : nullptr, smp ? p.st_conv + ((size_t)l * DEC_BATCH + b) * 3 * 1024 : nullptr, oH, oC, sq);
        } else if (MIXON(1) && ((tk >= 32 && tk < 64) || tk >= 224)) {
            const bool smp = tk < 64; const int t2 = smp ? tk - 32 : tk - 224; const int b = t2 >> 2, h = t2 & 3;
            u16* seq = smp ? sproj + (size_t)b * 16 * LDP : proj + (size_t)b * SEQ * LDP;
            const int nb = smp ? DEC_BATCH : BATCH;
            float* oS = out + (smp ? O_SHG : O_PHG) + (((size_t)l * nb + b) * 4 + h) * 128 * 128;
            chain_hgrn(sm, tid, w, lane, seq, smp ? 16 : 64, smp ? 1 : 32, h, p.lbraw, l,
                       smp ? p.st_hg + (((size_t)l * DEC_BATCH + b) * 4 + h) * 128 * 128 : nullptr, oS, p.hnorm_w + l * 512 + h * 128);
        } else if ((tk >= 64 && tk < 96) || (tk >= 160 && tk < 224)) {
            int t2; bool smp, ret;
            if (tk < 80) { smp = true; ret = false; t2 = tk - 64; }
            else if (tk < 96) { smp = true; ret = true; t2 = tk - 80; }
            else if (tk < 192) { smp = false; ret = false; t2 = tk - 160; }
            else { smp = false; ret = true; t2 = tk - 192; }
            const int chain = t2 * 2 + (w >> 2); const int b = chain >> 2, h = chain & 3;
            u16* seq = smp ? sproj + (size_t)b * 16 * LDP : proj + (size_t)b * SEQ * LDP;
            const float* gt = smp ? sgates + (size_t)b * 16 * 16 : gates + (size_t)b * SEQ * 16;
            const int nb = smp ? DEC_BATCH : BATCH;
            const size_t si = ((size_t)l * nb + b) * 4 + h;
            unsigned char* csm = sm + (w >> 2) * 65536;
            if (MIXON(2) && !ret) {
                chain_mr<0>(csm, tid & 255, w & 3, lane, seq, gt, smp ? 16 : 64, smp ? 1 : 32, 0, h,
                            smp ? p.st_mc + si * 64 * 128 : nullptr, smp ? p.st_mn + si * 64 : nullptr, smp ? p.st_mm + si : nullptr,
                            out + (smp ? O_SMC : O_PMC) + si * 64 * 128, out + (smp ? O_SMN : O_PMN) + si * 64, out + (smp ? O_SMM : O_PMM) + si,
                            p.mnorm_w + l * 512 + h * 128, p.gate_b[l * 8 + h], p.gate_b[l * 8 + 4 + h]);
            } else if (MIXON(3) && ret) {
                chain_mr<1>(csm, tid & 255, w & 3, lane, seq, gt, smp ? 16 : 64, smp ? 1 : 32, smp ? PAST_LEN : 0, h,
                            smp ? p.st_ret + si * 64 * 128 : nullptr, nullptr, nullptr,
                            out + (smp ? O_SRET : O_PRET) + si * 64 * 128, nullptr, nullptr, nullptr, 0.f, 0.f);
            }
        }
        __syncthreads();
    }
}

DI void final_norm(const Params& p, int gw, int ngw, int lane) {
    const u16* X = (const u16*)(p.ws + WS_PROJ);
    for (int r = gw; r < NTOK + NSTOK; r += ngw) {
        float x[16];
        if (r < NTOK) {
#pragma unroll
            for (int i = 0; i < 4; ++i) { const float4 v = *(const float4*)((const float*)(X + (size_t)r * LDP + 2048) + i * 256 + lane * 4); x[4 * i] = v.x; x[4 * i + 1] = v.y; x[4 * i + 2] = v.z; x[4 * i + 3] = v.w; }
        } else {
#pragma unroll
            for (int i = 0; i < 4; ++i) { const float4 v = *(const float4*)(p.out + O_YS + (size_t)(r - NTOK) * 1024 + i * 256 + lane * 4); x[4 * i] = v.x; x[4 * i + 1] = v.y; x[4 * i + 2] = v.z; x[4 * i + 3] = v.w; }
        }
        float ss = 0.f;
#pragma unroll
        for (int i = 0; i < 16; ++i) ss += x[i] * x[i];
        ss = wsum(ss);
        const float rs = rsqrtf(ss * (1.f / 1024.f) + EPS);
        float* dst = (r < NTOK) ? p.out + O_YP + (size_t)r * 1024 : p.out + O_YS + (size_t)(r - NTOK) * 1024;
#pragma unroll
        for (int i = 0; i < 4; ++i) { const int k = i * 256 + lane * 4; const float4 wv = *(const float4*)(p.fnorm_w + k);
            float4 o; o.x = x[4 * i] * rs * wv.x; o.y = x[4 * i + 1] * rs * wv.y; o.z = x[4 * i + 2] * rs * wv.z; o.w = x[4 * i + 3] * rs * wv.w;
            *(float4*)(dst + k) = o; }
    }
}


#define XB_TMO      128
#define XB_XCNT(j)  (256  + 64 * (j))
#define XB_XSUB(j)  (1280 + 64 * (j))
#define XB_XGEN(j)  (2304 + 64 * (j))
#define XB_TOP      3328
#define XB_TOPGEN   3392
#define XCD_BAR_WORDS 3456
#define XB_SPIN_CAP (1u << 18)
DI unsigned xb_ld(unsigned* p)              { return __hip_atomic_load(p, __ATOMIC_RELAXED, __HIP_MEMORY_SCOPE_AGENT); }
DI unsigned xb_add(unsigned* p, unsigned v) { return __hip_atomic_fetch_add(p, v, __ATOMIC_RELAXED, __HIP_MEMORY_SCOPE_AGENT); }
DI unsigned xb_xcc_id() { return (unsigned)__builtin_amdgcn_s_getreg((3 << 11) | 20) & 0xFu; }
#define XB_SPIN(cond, bar) do { unsigned _sp = 0; while (cond) { __builtin_amdgcn_s_sleep(1); \
    if ((++_sp & 255u) == 0u) { if (xb_ld(&(bar)[XB_TMO])) break; if (_sp > XB_SPIN_CAP) { atomicAdd(&(bar)[XB_TMO], 1u); break; } } } } while (0)
struct XcdBarrier { unsigned* bar; unsigned x; volatile LAS unsigned* st; };
DI void xcd_barrier_post(unsigned* bar) { if (threadIdx.x == 0) (void)xb_add(&bar[XB_XCNT(xb_xcc_id())], 1u); }
DI void xcd_barrier_complete(unsigned* bar, unsigned x, unsigned& nloc, unsigned& nx) {
    const unsigned G = gridDim.x * gridDim.y * gridDim.z;
    unsigned sum, cnt, mine, sp = 0u;
    for (;;) {
        sum = 0u; cnt = 0u; mine = 0u;
#pragma unroll
        for (unsigned j = 0; j < 16; ++j) { const unsigned c = xb_ld(&bar[XB_XCNT(j)]); sum += c; cnt += (c > 0u) ? 1u : 0u; mine = (j == x) ? c : mine; }
        if (sum == G) break;
        __builtin_amdgcn_s_sleep(1);
        if ((++sp & 255u) == 0u) { if (xb_ld(&bar[XB_TMO])) break; if (sp > XB_SPIN_CAP) { atomicAdd(&bar[XB_TMO], 1u); break; } }
    }
    nloc = mine > 0u ? mine : 1u; nx = cnt > 0u ? cnt : 1u;
}
DI void xcd_barrier(const XcdBarrier& b) {
    asm volatile("s_waitcnt vmcnt(0)" ::: "memory");
    __syncthreads();
    if (threadIdx.x == 0) {
        unsigned* bar = b.bar;
        __builtin_amdgcn_s_waitcnt(0);
        unsigned nloc = b.st[0], nx = b.st[1];
        if (nloc == 0u) { xcd_barrier_complete(bar, b.x, nloc, nx); b.st[0] = nloc; b.st[1] = nx; }
        const unsigned old = xb_add(&bar[XB_XSUB(b.x)], 1u);
        const unsigned gen = old / nloc;
        if (old + 1u == (gen + 1u) * nloc) {
            __builtin_amdgcn_fence(__ATOMIC_RELEASE, "agent");
            asm volatile("s_waitcnt vmcnt(0)" ::: "memory");
            const unsigned og = xb_add(&bar[XB_TOP], 1u);
            const unsigned tg = og / nx;
            if (og + 1u == (tg + 1u) * nx) xb_add(&bar[XB_TOPGEN], 1u);
            else XB_SPIN(xb_ld(&bar[XB_TOPGEN]) == tg, bar);
            __builtin_amdgcn_fence(__ATOMIC_ACQUIRE, "agent");
            xb_add(&bar[XB_XGEN(b.x)], 1u);
            asm volatile("s_waitcnt vmcnt(0)" ::: "memory");
        } else {
            XB_SPIN(xb_ld(&bar[XB_XGEN(b.x)]) == gen, bar);
            __builtin_amdgcn_fence(__ATOMIC_ACQUIRE, "agent");
            asm volatile("s_waitcnt vmcnt(0)" ::: "memory");
        }
    }
    __syncthreads();
}
#define GRID_SEAM(first) do { if (first) cg::this_grid().sync(); else { XcdBarrier xb_; xb_.bar = (unsigned*)(p.ws + WS_BAR); xb_.x = xb_xcc_id(); xb_.st = (volatile LAS unsigned*)(LAS unsigned char*)(lds + LDS_BYTES - 16); xcd_barrier(xb_); } } while (0)

template <int PHSEL, int MIX>
DI void run_phases(const Params& p, unsigned char* lds) {
#define PSEL(x) (PHSEL < 0 || PHSEL == (x))
    if (COOP) { volatile LAS unsigned* st_ = (volatile LAS unsigned*)(LAS unsigned char*)(lds + LDS_BYTES - 16); if (threadIdx.x < 2) st_[threadIdx.x] = 0u; __syncthreads(); xcd_barrier_post((unsigned*)(p.ws + WS_BAR)); }
#ifndef PROG
#define PROG 0x876543210ull
#define NPROG 9
#endif
    for (int pi = p.ph_lo; pi < p.ph_hi; ++pi) {
        const int ph = __builtin_amdgcn_readfirstlane((int)((PROG >> (4 * pi)) & 15ull));
#define PH_IDS int tid = threadIdx.x; OPQ(tid); const int w = __builtin_amdgcn_readfirstlane(tid >> 6), lane = tid & 63; const int gw = blockIdx.x * 8 + w, ngw = gridDim.x * 8; (void)gw; (void)ngw; (void)lane
        u16* proj = (u16*)(p.ws + WS_PROJ); u16* sproj = (u16*)(p.ws + WS_SPROJ);
        float* gates = (float*)(p.ws + WS_GATES); float* sgates = (float*)(p.ws + WS_SGATES);
        float* rstd = (float*)(p.ws + WS_RSTD); float* srstd = (float*)(p.ws + WS_SRSTD);
        u16* shi = (u16*)(p.ws + WS_SHI);
        u16* X = (u16*)(p.out + O_YP);
        float* ys = p.out + O_YS;
        if (PSEL(0) && ph == 0) {
            PH_IDS;
            convert_weights(p, (float*)lds, tid);
            build_wg(p, 0, (float*)lds, tid);
            __syncthreads();
            prep_rows<0>(p.x_prompt, nullptr, NTOK, X, 2048, true, rstd, gates, nullptr, (const float*)lds, gw, ngw, lane);
            prep_rows<0>(p.x_sample, nullptr, NSTOK, shi, 1024, true, srstd, sgates, ys, (const float*)lds, gw, ngw, lane);
        } else if (PSEL(4) && ph == 4) {
            PH_IDS;
            build_wg(p, 1, (float*)lds, tid);
            __syncthreads();
            prep_rows<1>(nullptr, X, NTOK, nullptr, 0, false, rstd, gates, nullptr, (const float*)lds, gw, ngw, lane);
            prep_rows<0>(ys, nullptr, NSTOK, shi, 1024, true, srstd, sgates, nullptr, (const float*)lds, gw, ngw, lane);
        } else if (PSEL(1) && (ph == 1 || ph == 5)) {
            PH_IDS;
            const int l = ph == 1 ? 0 : 1;
            const u16* wt = (const u16*)(p.ws + WS_WTIN) + (size_t)l * LDP * 1024;
            sample_gemm<0>(shi, 1024, wt, LDP, 1024, gw, ngw, lane, sproj, srstd, nullptr, nullptr);
            __syncthreads();
            pg8::Gemm g; g.A = X; g.Bt = wt; g.M = NTOK; g.N = LDP; g.K = 1024; g.lda = 2048;
            pg8::StaticOrder S; S.init(g.M, g.N, (int)gridDim.x, (int)blockIdx.x);
            pg8::EpiIn E; E.O = proj; E.rstd = rstd;
            pg8::gemm_phase<pg8::EpiIn>((LAS unsigned char*)lds, g, S, E, tid);
        } else if (PSEL(2) && (ph == 2 || ph == 6)) {
            mixer_phase<MIX>(p, ph == 2 ? 0 : 1, lds);
        } else if (PSEL(3) && (ph == 3 || ph == 7)) {
            PH_IDS;
            const int l = ph == 3 ? 0 : 1;
            const u16* wt = (const u16*)(p.ws + WS_WTOUT) + (size_t)l * 1024 * 2048;
            {
                const float* ssqb = (const float*)(p.ws + WS_SSQ);
                for (int r = gw; r < NTOK + NSTOK; r += ngw) {
                    u16* rowp = (r < NTOK ? proj + (size_t)r * LDP : sproj + (size_t)(r - NTOK) * LDP) + 1024 + lane * 8;
                    const float4 s4 = *(const float4*)(ssqb + (size_t)r * 4);
                    const float tot = (lane >> 5) ? s4.z + s4.w : s4.x + s4.y;
                    const float rs = rsqrtf(tot * (1.f / 256.f) + EPS);
                    float v[8]; unpack8(*(const uint4*)rowp, v);
#pragma unroll
                    for (int e = 0; e < 8; ++e) v[e] *= rs;
                    *(uint4*)rowp = pack8f(v);
                }
                GRID_SEAM(false);
            }
            {
                const int fr = lane & 15, fq = lane >> 4; float* red = (float*)lds;
                const float* resid = l == 0 ? p.x_sample : ys;
                for (int t = blockIdx.x; t < 512; t += gridDim.x) {
                    const int rt = t & 7, ct = t >> 3;
                    const u16* ap = sproj + (size_t)(rt * 16 + fr) * LDP + w * 256 + 8 * fq;
                    const u16* bp = wt + (size_t)(ct * 16 + fr) * 2048 + w * 256 + 8 * fq;
                    f32x4 acc = (f32x4){0.f, 0.f, 0.f, 0.f};
#pragma unroll
                    for (int k = 0; k < 256; k += 32) acc = MFMA16(as_frag(ldg16(ap + k)), as_frag(ldg16(bp + k)), acc);
                    *(f32x4*)(red + (w * 64 + lane) * 4) = acc;
                    __syncthreads();
                    if (w == 0) {
                        f32x4 tot = acc;
#pragma unroll
                        for (int ww = 1; ww < 8; ++ww) { const f32x4 o = *(const f32x4*)(red + (ww * 64 + lane) * 4); tot[0] += o[0]; tot[1] += o[1]; tot[2] += o[2]; tot[3] += o[3]; }
#pragma unroll
                        for (int j = 0; j < 4; ++j) { const size_t o = (size_t)(rt * 16 + 4 * fq + j) * 1024 + ct * 16 + fr; ys[o] = resid[o] + tot[j]; }
                    }
                    __syncthreads();
                }
            }
            pg8::Gemm g; g.A = proj; g.Bt = wt; g.M = NTOK; g.N = 1024; g.K = 2048; g.lda = LDP;
            pg8::StaticOrder S; S.init(g.M, g.N, (int)gridDim.x, (int)blockIdx.x);
            pg8::EpiOut E; E.Xhi = X; E.Xlo = X + 1024; E.xin = l == 0 ? p.x_prompt : nullptr; E.projdead = proj; E.last = (l == 1);
            pg8::gemm_phase<pg8::EpiOut>((LAS unsigned char*)lds, g, S, E, tid);
        } else if (PSEL(8) && ph == 8) {
            PH_IDS;
            final_norm(p, gw, ngw, lane);
        }
        if (pi + 1 < p.ph_hi) { GRID_SEAM(p.ph_hi > 64); }
    }
#undef PSEL
}
#if COOP
__global__ __launch_bounds__(512) void mega(Params p) {
    extern __shared__ __attribute__((aligned(16))) unsigned char lds[];
    run_phases<-1, -1>(p, lds);
}
#else
template <int PHSEL, int MIX>
__global__ __launch_bounds__(512) void phase_k(Params p) {
    extern __shared__ __attribute__((aligned(16))) unsigned char lds[];
    run_phases<PHSEL, MIX>(p, lds);
}
#endif

extern "C" void kernel_launch(void* const* d_in, const int* in_sizes, int n_in, void* d_out, int out_size, void* d_ws, size_t ws_size, hipStream_t stream) {
    static int grid = 0;
    if (grid == 0) {
        if (n_in != 23 || (size_t)out_size != O_END || ws_size < WS_END) { fprintf(stderr, "kernel_launch: unexpected shapes n_in %d out %d ws %zu (need %zu)\n", n_in, out_size, ws_size, (size_t)WS_END); grid = -1; return; }
        int dev = 0, cus = 0, per_cu = 0;
        (void)hipGetDevice(&dev); (void)hipDeviceGetAttribute(&cus, hipDeviceAttributeMultiprocessorCount, dev);
#if COOP
        if (hipFuncSetAttribute((const void*)mega, hipFuncAttributeMaxDynamicSharedMemorySize, LDS_BYTES) != hipSuccess) { fprintf(stderr, "hipFuncSetAttribute failed\n"); grid = -1; return; }
        (void)hipOccupancyMaxActiveBlocksPerMultiprocessor(&per_cu, (const void*)mega, 512, LDS_BYTES);
        (void)hipGetLastError();
#else
        hipError_t e = hipSuccess;
#define SETA(PH, MX) if (e == hipSuccess) e = hipFuncSetAttribute((const void*)phase_k<PH, MX>, hipFuncAttributeMaxDynamicSharedMemorySize, LDS_BYTES)
        SETA(0, -1); SETA(1, -1); SETA(2, 0); SETA(2, 1); SETA(2, 2); SETA(2, 3); SETA(3, -1); SETA(4, -1); SETA(8, -1);
#undef SETA
        if (e != hipSuccess) { fprintf(stderr, "hipFuncSetAttribute failed\n"); grid = -1; return; }
#endif
        if (per_cu < 1) per_cu = 1;
        grid = cus * per_cu; if (grid > 256) grid = 256;
    }
    if (grid < 0) return;
    Params p{};
    p.x_prompt = (const float*)d_in[0]; p.x_sample = (const float*)d_in[1];
    p.st_mc = (const float*)d_in[2]; p.st_mn = (const float*)d_in[3]; p.st_mm = (const float*)d_in[4]; p.st_ret = (const float*)d_in[5];
    p.st_ssd = (const float*)d_in[6]; p.st_conv = (const float*)d_in[7]; p.st_hg = (const float*)d_in[8];
    p.norm_w = (const float*)d_in[9]; p.w_in = (const float*)d_in[10]; p.gate_b = (const float*)d_in[11]; p.mnorm_w = (const float*)d_in[12];
    p.conv_w = (const float*)d_in[13]; p.conv_b = (const float*)d_in[14]; p.dt_bias = (const float*)d_in[15]; p.a_log = (const float*)d_in[16];
    p.d_skip = (const float*)d_in[17]; p.snorm_w = (const float*)d_in[18]; p.lbraw = (const float*)d_in[19]; p.hnorm_w = (const float*)d_in[20];
    p.w_out = (const float*)d_in[21]; p.fnorm_w = (const float*)d_in[22];
    p.out = (float*)d_out; p.ws = (unsigned char*)d_ws;
#if COOP
    p.ph_lo = 0; p.ph_hi = NPROG;
    if (hipMemsetAsync((char*)d_ws + WS_BAR, 0, 16384, stream) != hipSuccess) { fprintf(stderr, "hipMemsetAsync failed\n"); return; }
    void* args[] = {&p};
    hipError_t e = hipLaunchCooperativeKernel((const void*)mega, dim3(grid), dim3(512), args, LDS_BYTES, stream);
    if (e != hipSuccess) fprintf(stderr, "cooperative launch failed: %s (grid %d)\n", hipGetErrorString(e), grid);
#else
#ifndef MAXL
#define MAXL 99
#endif
    int nl_ = 0;
#define LAUNCH(PH, MX, ph_) do { if (nl_++ >= MAXL) break; p.ph_lo = (ph_); p.ph_hi = (ph_) + 1; hipLaunchKernelGGL((phase_k<PH, MX>), dim3(grid), dim3(512), LDS_BYTES, stream, p); } while (0)
    LAUNCH(0, -1, 0); LAUNCH(1, -1, 1);
    LAUNCH(2, 0, 2); LAUNCH(2, 1, 2); LAUNCH(2, 2, 2); LAUNCH(2, 3, 2);
    LAUNCH(3, -1, 3); LAUNCH(4, -1, 4); LAUNCH(1, -1, 5);
    LAUNCH(2, 0, 6); LAUNCH(2, 1, 6); LAUNCH(2, 2, 6); LAUNCH(2, 3, 6);
    LAUNCH(3, -1, 7); LAUNCH(8, -1, 8);
#undef LAUNCH
#endif
}
```

```cpp
#include <hip/hip_runtime.h>
#include <hip/hip_cooperative_groups.h>
#include <cstdio>
namespace cg = cooperative_groups;

#define DI __device__ __forceinline__
#define OPQ(x) asm volatile("" : "+v"(x))
#define LBAR() asm volatile("s_waitcnt lgkmcnt(0)\n\ts_barrier" ::: "memory")
#define OPQS(x) asm volatile("" : "+s"(x))
typedef unsigned short u16;
typedef short bf16x8 __attribute__((ext_vector_type(8)));
typedef short bf16x4 __attribute__((ext_vector_type(4)));
typedef float f32x4 __attribute__((ext_vector_type(4)));
typedef unsigned u32x4 __attribute__((ext_vector_type(4)));
#define LAS __attribute__((address_space(3)))

#ifndef COOP
#define COOP 1
#endif
#ifndef ONLYPH
#define ONLYPH -1
#endif
#ifndef ONLYMIX
#define ONLYMIX -1
#endif
#define MIXON(x) ((MIX < 0 || MIX == (x)) && (ONLYMIX < 0 || ONLYMIX == (x)))
#define PHON(x) (ONLYPH < 0 || ONLYPH == (x))

constexpr int D_MODEL = 1024, BATCH = 16, SEQ = 2048, DEC_BATCH = 8, DEC_SEQ = 16, PAST_LEN = 1024;
constexpr int NTOK = BATCH * SEQ;
constexpr int NSTOK = DEC_BATCH * DEC_SEQ;
constexpr int IN_COLS = 7184;
constexpr int LDP = 7168;
constexpr float EPS = 1e-6f;
constexpr int LDS_BYTES = 147456;
constexpr int NPHASE = 9;

constexpr size_t WS_PROJ = 0;
constexpr size_t WS_WTIN = WS_PROJ + (size_t)NTOK * LDP * 2;
constexpr size_t WS_WTOUT = WS_WTIN + (size_t)2 * LDP * 1024 * 2;
constexpr size_t WS_GATES = WS_WTOUT + (size_t)2 * 1024 * 2048 * 2;
constexpr size_t WS_RSTD = WS_GATES + (size_t)NTOK * 16 * 4;
constexpr size_t WS_SPROJ = WS_RSTD + (size_t)NTOK * 4;
constexpr size_t WS_SGATES = WS_SPROJ + (size_t)NSTOK * LDP * 2;
constexpr size_t WS_SRSTD = WS_SGATES + (size_t)NSTOK * 16 * 4;
constexpr size_t WS_SHI = WS_SRSTD + 512;
constexpr size_t WS_SSQ = WS_SHI + (size_t)NSTOK * 1024 * 2;
constexpr size_t WS_BAR = WS_SSQ + (size_t)(NTOK + NSTOK) * 4 * 4;
constexpr size_t WS_END = WS_BAR + 16384;

constexpr size_t O_YP = 0;
constexpr size_t O_YS = O_YP + (size_t)NTOK * 1024;
constexpr size_t O_PMC = O_YS + (size_t)NSTOK * 1024;
constexpr size_t O_PMN = O_PMC + (size_t)2 * 16 * 4 * 64 * 128;
constexpr size_t O_PMM = O_PMN + (size_t)2 * 16 * 4 * 64;
constexpr size_t O_PRET = O_PMM + (size_t)2 * 16 * 4;
constexpr size_t O_PSSD = O_PRET + (size_t)2 * 16 * 4 * 64 * 128;
constexpr size_t O_PCONV = O_PSSD + (size_t)2 * 16 * 8 * 128 * 64;
constexpr size_t O_PHG = O_PCONV + (size_t)2 * 16 * 3 * 1024;
constexpr size_t O_SMC = O_PHG + (size_t)2 * 16 * 4 * 128 * 128;
constexpr size_t O_SMN = O_SMC + (size_t)2 * 8 * 4 * 64 * 128;
constexpr size_t O_SMM = O_SMN + (size_t)2 * 8 * 4 * 64;
constexpr size_t O_SRET = O_SMM + (size_t)2 * 8 * 4;
constexpr size_t O_SSSD = O_SRET + (size_t)2 * 8 * 4 * 64 * 128;
constexpr size_t O_SCONV = O_SSSD + (size_t)2 * 8 * 8 * 128 * 64;
constexpr size_t O_SHG = O_SCONV + (size_t)2 * 8 * 3 * 1024;
constexpr size_t O_END = O_SHG + (size_t)2 * 8 * 4 * 128 * 128;

struct Params {
    const float* x_prompt; const float* x_sample;
    const float* st_mc; const float* st_mn; const float* st_mm; const float* st_ret; const float* st_ssd; const float* st_conv; const float* st_hg;
    const float* norm_w; const float* w_in; const float* gate_b; const float* mnorm_w; const float* conv_w; const float* conv_b;
    const float* dt_bias; const float* a_log; const float* d_skip; const float* snorm_w; const float* lbraw; const float* hnorm_w;
    const float* w_out; const float* fnorm_w;
    float* out; unsigned char* ws;
    int ph_lo, ph_hi;
};

DI float bf2f(u16 v) { return __uint_as_float(((unsigned)v) << 16); }
typedef __bf16 bf2_t __attribute__((ext_vector_type(2)));
typedef float f2_t __attribute__((ext_vector_type(2)));
DI unsigned pk2(float a, float b) { const f2_t v = {a, b}; const bf2_t r = __builtin_convertvector(v, bf2_t); return __builtin_bit_cast(unsigned, r); }
DI u16 f2bf(float a) { return (u16)(pk2(a, 0.f) & 0xffffu); }
DI float lo16(unsigned w) { return __uint_as_float(w << 16); }
DI float hi16(unsigned w) { return __uint_as_float(w & 0xffff0000u); }
DI void unpack8(const uint4 v, float* f) {
    f[0] = lo16(v.x); f[1] = hi16(v.x); f[2] = lo16(v.y); f[3] = hi16(v.y); f[4] = lo16(v.z); f[5] = hi16(v.z); f[6] = lo16(v.w); f[7] = hi16(v.w);
}
DI uint4 pack8f(const float* f) { uint4 r; r.x = pk2(f[0], f[1]); r.y = pk2(f[2], f[3]); r.z = pk2(f[4], f[5]); r.w = pk2(f[6], f[7]); return r; }
DI bf16x8 as_frag(uint4 v) { return __builtin_bit_cast(bf16x8, v); }
DI bf16x8 pack_acc2(const f32x4 a, const f32x4 b) { uint4 r; r.x = pk2(a[0], a[1]); r.y = pk2(a[2], a[3]); r.z = pk2(b[0], b[1]); r.w = pk2(b[2], b[3]); return __builtin_bit_cast(bf16x8, r); }
DI bf16x8 ldfrag(const u16* p) { return *(const bf16x8*)p; }
DI bf16x8 ldfrag2(const u16* p) { uint2 a = *(const uint2*)p; uint2 b = *(const uint2*)(p + 16); uint4 r; r.x = a.x; r.y = a.y; r.z = b.x; r.w = b.y; return __builtin_bit_cast(bf16x8, r); }
typedef short v4s_t __attribute__((ext_vector_type(4)));
DI bf16x8 ldfrag_tr(const u16* p, const int RS) {
    const v4s_t lo = __builtin_amdgcn_ds_read_tr16_b64_v4i16((LAS v4s_t*)p);
    const v4s_t hi = __builtin_amdgcn_ds_read_tr16_b64_v4i16((LAS v4s_t*)(p + 4 * RS));
    return __builtin_shufflevector(lo, hi, 0, 1, 2, 3, 4, 5, 6, 7);
}
DI v4s_t ld_tr4(const u16* p) { return __builtin_amdgcn_ds_read_tr16_b64_v4i16((LAS v4s_t*)p); }
#define MFMA16(a, b, c) __builtin_amdgcn_mfma_f32_16x16x32_bf16((a), (b), (c), 0, 0, 0)
DI float sigmoidf_(float x) { return __builtin_amdgcn_rcpf(1.f + __expf(-x)); }
DI float siluf_(float x) { return x * __builtin_amdgcn_rcpf(1.f + __expf(-x)); }
DI float softplusf_(float x) { return fmaxf(x, 0.f) + log1pf(__expf(-fabsf(x))); }
DI float logsigf_(float x) { return fminf(x, 0.f) - log1pf(__expf(-fabsf(x))); }
DI float wscan_sum(float x, int lane) {
#pragma unroll
    for (int o = 1; o < 64; o <<= 1) { float t = __shfl_up(x, o); if (lane >= o) x += t; }
    return x;
}
DI float wscan_max(float x, int lane) {
#pragma unroll
    for (int o = 1; o < 64; o <<= 1) { float t = __shfl_up(x, o); if (lane >= o) x = fmaxf(x, t); }
    return x;
}
DI float wsum(float x) {
#pragma unroll
    for (int o = 32; o >= 1; o >>= 1) x += __shfl_xor(x, o);
    return x;
}
DI float red16(float x) { x += __shfl_xor(x, 1); x += __shfl_xor(x, 2); x += __shfl_xor(x, 4); x += __shfl_xor(x, 8); return x; }
DI uint4 ldg16(const u16* p) { return *(const uint4*)p; }
DI uint4 ldsel(const u16* base, unsigned off, bool ok) { const uint4 v = *(const uint4*)(base + (size_t)off); return ok ? v : make_uint4(0u, 0u, 0u, 0u); }
DI uint4 zero4() { uint4 z; z.x = z.y = z.z = z.w = 0u; return z; }

DI int src_col(int n) {
    if (n < 512) return 512 + n;
    if (n < 1024) return 2568 + (n - 512);
    if (n < 1536) return 3592 + (n - 1024);
    if (n < 2048) return 6672 + (n - 1536);
    if (n < 2304) return 0 + (n - 2048);
    if (n < 2560) return 256 + (n - 2304);
    if (n < 3072) return 1024 + (n - 2560);
    if (n < 3584) return 1536 + (n - 3072);
    if (n < 3840) return 2056 + (n - 3584);
    if (n < 4096) return 2312 + (n - 3840);
    if (n < 4608) return 3080 + (n - 4096);
    if (n < 5632) return 4104 + (n - 4608);
    if (n < 6144) return 5136 + (n - 5632);
    if (n < 6656) return 5648 + (n - 6144);
    return 6160 + (n - 6656);
}

namespace pg8 {
constexpr int BM = 256, BK = 64, HALF = 128, HTB = HALF * BK * 2, NXCD = 8, WGM = 8;
DI int lds_byte(int r, int c) { const int st = (r >> 4) * 2 + (c >> 5), rr = r & 15, cc = c & 31, ob = rr * 64 + cc * 2; return st * 1024 + (ob ^ (((ob >> 9) & 1) << 5)); }
DI void stage_rc(int b, int& R, int& C) { const int st = b / 1024, sb = b % 1024, swz = sb ^ (((sb >> 9) & 1) << 5); R = (st >> 1) * 16 + swz / 64; C = (st & 1) * 32 + (swz % 64) / 2; }
DI int perm32(int rho) { const int n = rho >> 4, i = rho & 15; return 8 * (i >> 2) + 4 * n + (i & 3); }
struct Unit { int pm, pn; };
struct Gemm { const u16* A; const u16* Bt; int M, N, K, lda; };
struct StaticOrder {
    int nM, nN, nwg, G, c;
    DI void init(int M, int N, int G_, int c_) { nM = M / BM; nN = N / BM; nwg = nM * nN; G = G_; c = c_; }
    DI bool next(int i, Unit& u) const {
        const long L = (long)i * G + c; if (L >= nwg) return false;
        int wgid = (int)L; { const int q = nwg / NXCD, r = nwg % NXCD, xcd = wgid % NXCD, off = wgid / NXCD; wgid = (xcd < r ? xcd * (q + 1) : r * (q + 1) + (xcd - r) * q) + off; }
        const int nig = WGM * nN, gid = wgid / nig, fm = gid * WGM, gsz = (nM - fm) < WGM ? (nM - fm) : WGM;
        u.pm = fm + ((wgid % nig) % gsz); u.pn = (wgid % nig) / gsz; return true;
    }
};
template <class Epi>
DI void gemm_phase(LAS unsigned char* lds, const Gemm g, const StaticOrder& S, const Epi& E, const int tid) {
    const int wid = __builtin_amdgcn_readfirstlane(tid >> 6), lane = tid & 63, wr = wid >> 2, wc = wid & 3, fr = lane & 15, fq = lane >> 4;
    const int K = g.K, nt = K / BK, lda = g.lda;
    unsigned voffA[2], voffB[2];
#pragma unroll
    for (int i = 0; i < 2; ++i) { int R, C; stage_rc(tid * 16 + i * 8192, R, C); const int Rb = (R & ~31) + perm32(R & 31);
        voffA[i] = (unsigned)(R * lda + C) * 2u; voffB[i] = (unsigned)(Rb * K + C) * 2u; }
    const size_t kstep = (size_t)(BK * 2);
    const size_t hstepA = (size_t)HALF * lda * 2, hstepB = (size_t)HALF * K * 2;
    const size_t tstepA = 2 * hstepA, tstepB = 2 * hstepB;
    const unsigned ldsw = (unsigned)wid * 1024u;
    const int aoff = lds_byte(wr * 64 + fr, fq * 8), boff = lds_byte(wc * 32 + fr, fq * 8);
#define PG8_SA(b, h) (((b) * 2 + (h)) * HTB)
#define PG8_SB(b, h) ((4 + (b) * 2 + (h)) * HTB)
#define PG8_STAGE(bufoff, gbase, voff) do { _Pragma("unroll") for (int _i = 0; _i < 2; ++_i) \
        __builtin_amdgcn_global_load_lds((const unsigned*)((const char*)(gbase) + (voff)[_i]), (LAS unsigned*)(lds + (bufoff) + ldsw + _i * 8192), 16, 0, 0); } while (0)
#define PG8_LDA(dst, b, h) do { _Pragma("unroll") for (int m = 0; m < 4; ++m) _Pragma("unroll") for (int k = 0; k < 2; ++k) dst[m][k] = *(const LAS bf16x8*)(lds + PG8_SA(b, h) + aoff + m * 2048 + k * 1024); } while (0)
#define PG8_LDB(dst, b, h) do { _Pragma("unroll") for (int n = 0; n < 2; ++n) _Pragma("unroll") for (int k = 0; k < 2; ++k) dst[n][k] = *(const LAS bf16x8*)(lds + PG8_SB(b, h) + boff + n * 2048 + k * 1024); } while (0)
#define PG8_MMA(ai, bj, At, Bt) do { __builtin_amdgcn_s_setprio(1); _Pragma("unroll") for (int m = 0; m < 4; ++m) _Pragma("unroll") for (int n = 0; n < 2; ++n) _Pragma("unroll") for (int k = 0; k < 2; ++k) \
        acc[ai][bj][m][n] = __builtin_amdgcn_mfma_f32_16x16x32_bf16(Bt[n][k], At[m][k], acc[ai][bj][m][n], 0, 0, 0); __builtin_amdgcn_s_setprio(0); } while (0)
#define PG8_WAIT_V(n) asm volatile("s_waitcnt vmcnt(" #n ")" ::: "memory")
#define PG8_WAIT_L(n) asm volatile("s_waitcnt lgkmcnt(" #n ")" ::: "memory")
#define PG8_BAR __builtin_amdgcn_s_barrier()
#define PG8_SCHED __builtin_amdgcn_sched_barrier(0)
    Unit cur, nxt; int ui = 0;
    if (!S.next(0, cur)) return;
    f32x4 acc[2][2][4][2];
#pragma unroll
    for (int a = 0; a < 2; ++a)
#pragma unroll
        for (int b = 0; b < 2; ++b)
#pragma unroll
            for (int m = 0; m < 4; ++m)
#pragma unroll
                for (int n = 0; n < 2; ++n) acc[a][b][m][n] = (f32x4){0.f, 0.f, 0.f, 0.f};
    bf16x8 At[4][2], B0[2][2], B1[2][2];
    const char* cA = (const char*)g.A + (size_t)cur.pm * tstepA; const char* cB = (const char*)g.Bt + (size_t)cur.pn * tstepB;
    PG8_STAGE(PG8_SB(0, 0), cB, voffB); PG8_STAGE(PG8_SA(0, 0), cA, voffA); PG8_STAGE(PG8_SB(0, 1), cB + hstepB, voffB); PG8_STAGE(PG8_SA(0, 1), cA + hstepA, voffA);
    if (wr == 1) PG8_BAR;
    PG8_WAIT_V(4); PG8_BAR;
    PG8_STAGE(PG8_SB(1, 0), cB + kstep, voffB); PG8_STAGE(PG8_SA(1, 0), cA + kstep, voffA); PG8_STAGE(PG8_SB(1, 1), cB + hstepB + kstep, voffB);
    PG8_WAIT_V(6); PG8_BAR;
    for (;;) {
        const bool has_next = S.next(ui + 1, nxt);
        const char* nA = has_next ? (const char*)g.A + (size_t)nxt.pm * tstepA : cA; const char* nB = has_next ? (const char*)g.Bt + (size_t)nxt.pn * tstepB : cB;
        for (int t = 0; t < nt; t += 2) {
            const bool last = (t == nt - 2);
            const char* a1 = cA + (size_t)(t + 1) * kstep;
            const char* a2 = last ? nA : cA + (size_t)(t + 2) * kstep; const char* b2 = last ? nB : cB + (size_t)(t + 2) * kstep;
            const char* a3 = a2 + kstep; const char* b3 = b2 + kstep;
            PG8_LDB(B0, 0, 0); PG8_SCHED; PG8_LDA(At, 0, 0); PG8_STAGE(PG8_SA(1, 1), a1 + hstepA, voffA);
            PG8_WAIT_L(8); PG8_BAR; PG8_WAIT_L(0); PG8_MMA(0, 0, At, B0); PG8_BAR; PG8_SCHED;
            PG8_LDB(B1, 0, 1); PG8_STAGE(PG8_SB(0, 0), b2, voffB);
            PG8_BAR; PG8_WAIT_L(0); PG8_MMA(0, 1, At, B1); PG8_BAR;
            PG8_LDA(At, 0, 1); PG8_STAGE(PG8_SA(0, 0), a2, voffA);
            PG8_BAR; PG8_WAIT_L(0); PG8_MMA(1, 0, At, B0); PG8_BAR; PG8_SCHED;
            PG8_STAGE(PG8_SB(0, 1), b2 + hstepB, voffB);
            PG8_WAIT_V(6); PG8_BAR; PG8_MMA(1, 1, At, B1); PG8_BAR;
            PG8_LDB(B0, 1, 0); PG8_SCHED; PG8_LDA(At, 1, 0); PG8_STAGE(PG8_SA(0, 1), a2 + hstepA, voffA);
            PG8_WAIT_L(8); PG8_BAR; PG8_WAIT_L(0); PG8_MMA(0, 0, At, B0); PG8_BAR; PG8_SCHED;
            PG8_LDB(B1, 1, 1); PG8_STAGE(PG8_SB(1, 0), b3, voffB);
            PG8_BAR; PG8_WAIT_L(0); PG8_MMA(0, 1, At, B1); PG8_BAR;
            PG8_LDA(At, 1, 1); PG8_STAGE(PG8_SA(1, 0), a3, voffA);
            PG8_BAR; PG8_WAIT_L(0); PG8_MMA(1, 0, At, B0); PG8_BAR; PG8_SCHED;
            PG8_STAGE(PG8_SB(1, 1), b3 + hstepB, voffB);
            PG8_WAIT_V(6); PG8_BAR; PG8_MMA(1, 1, At, B1); PG8_BAR;
        }
        E(acc, cur, wr, wc, fr, fq);
        if (!has_next) break;
#pragma unroll
        for (int a = 0; a < 2; ++a)
#pragma unroll
            for (int b = 0; b < 2; ++b)
#pragma unroll
                for (int m = 0; m < 4; ++m)
#pragma unroll
                    for (int n = 0; n < 2; ++n) acc[a][b][m][n] = (f32x4){0.f, 0.f, 0.f, 0.f};
        cur = nxt; cA = nA; cB = nB; ++ui;
    }
    PG8_WAIT_V(0);
    if (wr == 0) PG8_BAR;
    PG8_BAR;
#undef PG8_SA
#undef PG8_SB
#undef PG8_STAGE
#undef PG8_LDA
#undef PG8_LDB
#undef PG8_MMA
#undef PG8_WAIT_V
#undef PG8_WAIT_L
#undef PG8_BAR
#undef PG8_SCHED
}
struct EpiIn {
    u16* O; const float* rstd;
    DI void operator()(const f32x4 (&acc)[2][2][4][2], const Unit& u, int wr, int wc, int fr, int fq) const {
        const int row0 = u.pm * BM + wr * 64 + fr, col0 = u.pn * BM + wc * 32 + 8 * fq;
#pragma unroll
        for (int ai = 0; ai < 2; ++ai)
#pragma unroll
            for (int m = 0; m < 4; ++m) {
                const int r = row0 + ai * HALF + m * 16; const float rs = rstd[r];
                u16* rowp = O + (size_t)r * LDP + col0;
#pragma unroll
                for (int bj = 0; bj < 2; ++bj) {
                    const f32x4 a0 = acc[ai][bj][m][0], a1 = acc[ai][bj][m][1];
                    uint4 v; v.x = pk2(a0[0] * rs, a0[1] * rs); v.y = pk2(a0[2] * rs, a0[3] * rs); v.z = pk2(a1[0] * rs, a1[1] * rs); v.w = pk2(a1[2] * rs, a1[3] * rs);
                    *(uint4*)(rowp + bj * HALF) = v;
                }
            }
    }
};
struct EpiOut {
    u16* Xhi; u16* Xlo; const float* xin; u16* projdead; bool last;
    DI void operator()(const f32x4 (&acc)[2][2][4][2], const Unit& u, int wr, int wc, int fr, int fq) const {
        const int row0 = u.pm * BM + wr * 64 + fr, col0 = u.pn * BM + wc * 32 + 8 * fq;
#pragma unroll
        for (int ai = 0; ai < 2; ++ai)
#pragma unroll
            for (int m = 0; m < 4; ++m) {
                const int r = row0 + ai * HALF + m * 16;
#pragma unroll
                for (int bj = 0; bj < 2; ++bj) {
                    const size_t o = (size_t)r * 2048 + col0 + bj * HALF; const size_t oi = (size_t)r * 1024 + col0 + bj * HALF;
                    float res[8];
                    if (xin) { const float4 x0 = *(const float4*)(xin + oi), x1 = *(const float4*)(xin + oi + 4);
                        res[0] = x0.x; res[1] = x0.y; res[2] = x0.z; res[3] = x0.w; res[4] = x1.x; res[5] = x1.y; res[6] = x1.z; res[7] = x1.w; }
                    else { float h8[8], l8[8]; unpack8(*(const uint4*)(Xhi + o), h8); unpack8(*(const uint4*)(Xlo + o), l8);
#pragma unroll
                        for (int e = 0; e < 8; ++e) res[e] = h8[e] + l8[e]; }
                    const f32x4 a0 = acc[ai][bj][m][0], a1 = acc[ai][bj][m][1];
                    float xn[8], lo[8];
#pragma unroll
                    for (int e = 0; e < 4; ++e) { xn[e] = res[e] + a0[e]; xn[4 + e] = res[4 + e] + a1[e]; }
                    if (last) {
                        float* dp = (float*)(projdead + (size_t)r * LDP + 2048) + col0 + bj * HALF;
                        *(float4*)dp = make_float4(xn[0], xn[1], xn[2], xn[3]); *(float4*)(dp + 4) = make_float4(xn[4], xn[5], xn[6], xn[7]);
                    } else {
                        const uint4 hv = pack8f(xn); float hb[8]; unpack8(hv, hb);
#pragma unroll
                        for (int e = 0; e < 8; ++e) lo[e] = xn[e] - hb[e];
                        *(uint4*)(Xhi + o) = hv; *(uint4*)(Xlo + o) = pack8f(lo);
                    }
                }
            }
    }
};
}

DI void convert_weights(const Params& p, float* sm, const int tid) {
    const int NT_IN = 112 * 16, NT_OUT = 16 * 32;
    const int total = 2 * (NT_IN + NT_OUT);
    for (int t = blockIdx.x; t < total; t += gridDim.x) {
        const int l = t / (NT_IN + NT_OUT); int tt = t % (NT_IN + NT_OUT);
        const float* W; u16* Wt; int Ksz, ldw, n0, k0, s0; const float* sc;
        if (tt < NT_IN) { const int nt_ = tt / 16, kt = tt % 16; n0 = nt_ * 64; k0 = kt * 64; W = p.w_in + (size_t)l * 1024 * IN_COLS; ldw = IN_COLS; s0 = src_col(n0);
            Wt = (u16*)(p.ws + WS_WTIN) + (size_t)l * LDP * 1024; Ksz = 1024; sc = p.norm_w + l * 1024; }
        else { tt -= NT_IN; const int nt_ = tt / 32, kt = tt % 32; n0 = nt_ * 64; k0 = kt * 64; W = p.w_out + (size_t)l * 2048 * 1024; ldw = 1024; s0 = n0;
            Wt = (u16*)(p.ws + WS_WTOUT) + (size_t)l * 1024 * 2048; Ksz = 2048; sc = nullptr; }
        {
            const int kr = tid >> 3, c8 = (tid & 7) * 8;
            const float* src = W + (size_t)(k0 + kr) * ldw + s0 + c8;
            const float s = sc ? sc[k0 + kr] : 1.f;
#pragma unroll
            for (int e = 0; e < 8; ++e) sm[kr * 65 + c8 + e] = src[e] * s;
        }
        __syncthreads();
        {
            const int nr = tid >> 3, k8 = (tid & 7) * 8; float f[8];
#pragma unroll
            for (int e = 0; e < 8; ++e) f[e] = sm[(k8 + e) * 65 + nr];
            *(uint4*)(Wt + (size_t)(n0 + nr) * Ksz + k0 + k8) = pack8f(f);
        }
        __syncthreads();
    }
}

template <int MODE>
DI void prep_rows(const float* xf, u16* xh, int nrows, u16* hi, int hstride, bool whi, float* rstd, float* gates, float* copyf, const float* wg  , int gw, int ngw, int lane) {
    for (int r = gw; r < nrows; r += ngw) {
        float x[16];
#pragma unroll
        for (int i = 0; i < 4; ++i) {
            const int k = i * 256 + lane * 4;
            if (MODE == 0) { const float4 v = *(const float4*)(xf + (size_t)r * 1024 + k); x[4 * i] = v.x; x[4 * i + 1] = v.y; x[4 * i + 2] = v.z; x[4 * i + 3] = v.w;
                if (copyf) *(float4*)(copyf + (size_t)r * 1024 + k) = v; }
            else { const uint2 h = *(const uint2*)(xh + (size_t)r * 2048 + k), lo = *(const uint2*)(xh + (size_t)r * 2048 + 1024 + k);
                x[4 * i] = lo16(h.x) + lo16(lo.x); x[4 * i + 1] = hi16(h.x) + hi16(lo.x); x[4 * i + 2] = lo16(h.y) + lo16(lo.y); x[4 * i + 3] = hi16(h.y) + hi16(lo.y); }
        }
        float ss = 0.f;
#pragma unroll
        for (int i = 0; i < 16; ++i) ss += x[i] * x[i];
        ss = wsum(ss);
        const float rs = rsqrtf(ss * (1.f / 1024.f) + EPS);
        if (whi) {
#pragma unroll
            for (int i = 0; i < 4; ++i) { uint2 v; v.x = pk2(x[4 * i], x[4 * i + 1]); v.y = pk2(x[4 * i + 2], x[4 * i + 3]); *(uint2*)(hi + (size_t)r * hstride + i * 256 + lane * 4) = v; }
        }
        float acc[16];
        {
            int ln = lane; OPQ(ln);
#pragma unroll
            for (int j = 0; j < 16; ++j) {
                float a = 0.f;
#pragma unroll
                for (int i = 0; i < 4; ++i) { const f32x4 w = *(const f32x4*)(wg + j * 1024 + i * 256 + ln * 4); a += x[4 * i] * w[0] + x[4 * i + 1] * w[1] + x[4 * i + 2] * w[2] + x[4 * i + 3] * w[3]; }
                acc[j] = a;
            }
        }
        float b8[8], b4[4], b2[2], b1;
        { const bool h = (lane & 1) != 0;
#pragma unroll
          for (int i = 0; i < 8; ++i) { const float snd = h ? acc[i] : acc[i + 8], kp = h ? acc[i + 8] : acc[i]; b8[i] = kp + __shfl_xor(snd, 1); } }
        { const bool h = (lane & 2) != 0;
#pragma unroll
          for (int i = 0; i < 4; ++i) { const float snd = h ? b8[i] : b8[i + 4], kp = h ? b8[i + 4] : b8[i]; b4[i] = kp + __shfl_xor(snd, 2); } }
        { const bool h = (lane & 4) != 0;
#pragma unroll
          for (int i = 0; i < 2; ++i) { const float snd = h ? b4[i] : b4[i + 2], kp = h ? b4[i + 2] : b4[i]; b2[i] = kp + __shfl_xor(snd, 4); } }
        { const bool h = (lane & 8) != 0; const float snd = h ? b2[0] : b2[1], kp = h ? b2[1] : b2[0]; b1 = kp + __shfl_xor(snd, 8); }
        b1 += __shfl_xor(b1, 16); b1 += __shfl_xor(b1, 32);
        const int jg = ((lane & 1) << 3) | ((lane & 2) << 1) | ((lane & 4) >> 1) | ((lane & 8) >> 3);
        if (lane < 16) gates[(size_t)r * 16 + jg] = b1 * rs;
        if (lane == 0) rstd[r] = rs;
    }
}
DI void build_wg(const Params& p, int l, float* wg, const int tid) {
    for (int idx = tid; idx < 16 * 1024; idx += 512) {
        const int k = idx >> 4, j = idx & 15;
        const int col = j < 8 ? 2048 + j : 5128 + (j - 8);
        wg[j * 1024 + k] = p.norm_w[l * 1024 + k] * p.w_in[((size_t)l * 1024 + k) * IN_COLS + col];
    }
}

template <int MODE>
DI void sample_gemm(const u16* A, int lda, const u16* Bt, int N, int K, int gw, int ngw, int lane, u16* sproj, const float* srstd, const float* resid, float* ys) {
    const int fr = lane & 15, fq = lane >> 4;
    const int ntasks = 8 * (N / 16);
    for (int t = gw; t < ntasks; t += ngw) {
        const int rt = t & 7, ct = t >> 3;
        const u16* ap = A + (size_t)(rt * 16 + fr) * lda + 8 * fq;
        const u16* bp = Bt + (size_t)(ct * 16 + fr) * K + 8 * fq;
        f32x4 acc = (f32x4){0.f, 0.f, 0.f, 0.f};
#pragma unroll 16
        for (int k = 0; k < K; k += 32) acc = MFMA16(as_frag(ldg16(ap + k)), as_frag(ldg16(bp + k)), acc);
#pragma unroll
        for (int j = 0; j < 4; ++j) {
            const int r = rt * 16 + 4 * fq + j, c = ct * 16 + fr;
            if (MODE == 0) sproj[(size_t)r * LDP + c] = f2bf(acc[j] * srstd[r]);
            else ys[(size_t)r * 1024 + c] = resid[(size_t)r * 1024 + c] + acc[j];
        }
    }
}

template <int MODE>
DI void chain_mr(unsigned char* sm, const int ht_o, const int hw, const int lane_o, u16* seq, const float* gates,
                 const int nvalid, const int nch, const int pos0, const int h,
                 const float* initC, const float* initN, const float* initM, float* outC, float* outN, float* outM,
                 const float* normw, const float gbi, const float gbf) {
    const int fr_o = lane_o & 15, fq_o = lane_o >> 4;
    const int fr = fr_o, fq = fq_o, ht = ht_o, lane = lane_o;
    u16* sQ = (u16*)sm; u16* sK = (u16*)(sm + 9216); u16* sKW = (u16*)(sm + 18432); u16* sV = (u16*)(sm + 27648); u16* sP = (u16*)(sm + 45056);
    u16* sH = (u16*)sm;
    float* fb = (float*)(sm + 54272);
    float* sCV = fb; float* sMV = fb + 64; float* sWI = fb + 128; float* sEMT = fb + 192; float* sDA = fb + 256; float* sDB = fb + 320; float* sN = fb + 384;
    float* sSQ = fb + 448; float* sSM = fb + 704;
    const int qoff = MODE == 0 ? 2048 + h * 64 : 3584 + h * 64;
    const int koff = MODE == 0 ? 2304 + h * 64 : 3840 + h * 64;
    const int voff = MODE == 0 ? h * 128 : 512 + h * 128;
    const int g1off = MODE == 0 ? 2560 + h * 128 : 4096 + h * 128;
    const int g2off = 3072 + h * 128;
    const float lg = log1pf(-exp2f(-5.f - (float)h));

    f32x4 Cacc[4][2];
#pragma unroll
    for (int m = 0; m < 4; ++m)
#pragma unroll
        for (int n = 0; n < 2; ++n)
#pragma unroll
            for (int j = 0; j < 4; ++j) { const int k = 16 * m + 4 * fq + j, v = 32 * hw + 16 * n + fr; Cacc[m][n][j] = initC ? initC[k * 128 + v] : 0.f; }
    if (MODE == 0 && ht < 64) sN[ht] = initN ? initN[ht] : 0.f;
    float mprev = (MODE == 0) ? (initM ? initM[0] : -1e30f) : 0.f;
    float frq[8];
    if (MODE == 1) {
#pragma unroll
        for (int e = 0; e < 8; ++e) { const int j = (lane & 3) * 8 + e; frq[e] = exp2f(-(float)j * (13.287712379549449f / 32.f)) * 0.15915494309189535f; }
    }
    const int qrow = ht >> 3, qcol = (ht & 7) * 8;
    uint4 pq[2], pk[2], pv[4], pg1[4], pg2[4]; float gi = 0.f, gf = 0.f;
#define MR_OFFQ(i) ((unsigned)((((i) * 32 + (ht >> 3)) < nvalid ? ((i) * 32 + (ht >> 3)) : 0) * LDP + qoff + (ht & 7) * 8))
#define MR_OKQ(i) (((i) * 32 + (ht >> 3)) < nvalid)
#define MR_OFFV(i) ((unsigned)((((i) * 16 + (ht >> 4)) < nvalid ? ((i) * 16 + (ht >> 4)) : 0) * LDP + voff + (ht & 15) * 8))
#define MR_OKV(i) (((i) * 16 + (ht >> 4)) < nvalid)
#define MR_LOAD(c) do { const u16* cb_ = seq + (size_t)(c) * 64 * LDP; \
        _Pragma("unroll") for (int i = 0; i < 2; ++i) { pq[i] = ldsel(cb_, MR_OFFQ(i), MR_OKQ(i)); pk[i] = ldsel(cb_ + (koff - qoff), MR_OFFQ(i), MR_OKQ(i)); } \
        _Pragma("unroll") for (int i = 0; i < 4; ++i) pv[i] = ldsel(cb_, MR_OFFV(i), MR_OKV(i)); \
        if (MODE == 0) { const float* gp = gates + (size_t)(c) * 64 * 16; const unsigned og_ = (unsigned)((lane < nvalid ? lane : 0) * 16 + h); gi = gp[og_]; gf = gp[og_ + 4]; } } while (0)
    MR_LOAD(0);
    __syncthreads();
    for (int c = 0; c < nch; ++c) {
        int fr = fr_o, fq = fq_o, ht = ht_o, lane = lane_o; OPQ(fr); OPQ(fq); OPQ(ht); OPQ(lane);
        const int qrow = ht >> 3, qcol = (ht & 7) * 8;
        float wk_l, wc, mnew = 0.f;
        if (MODE == 0) {
            const float ig = (lane < nvalid) ? gi + gbi : -1e30f;
            const float lf = (lane < nvalid) ? logsigf_(gf + gbf) : 0.f;
            const float b = wscan_sum(lf, lane);
            const float cval = ig - b;
            const float pm = wscan_max(cval, lane);
            const float Ml = fmaxf(mprev, pm);
            const float blast = __shfl(b, 63), M63 = __shfl(Ml, 63);
            wk_l = __expf(cval - M63); wc = __expf(mprev - M63); mnew = blast + M63;
            if (hw == 0) { sCV[lane] = cval; sMV[lane] = Ml; sWI[lane] = __expf(mprev - Ml); sEMT[lane] = __expf(-(b + Ml)); }
        } else {
            wk_l = (lane < nvalid) ? __expf((float)(nvalid - 1 - lane) * lg) : 0.f; wc = __expf((float)nvalid * lg);
            if (hw == 0) sWI[lane] = __expf((float)(lane + 1) * lg);
        }
#pragma unroll
        for (int i = 0; i < 2; ++i) {
            const int row = i * 32 + qrow;
            float kf[8];
            if (MODE == 1) {
                float qf[8], qp[8], kp[8];
                uint4 qv = pq[i], kv = pk[i], qo, ko;
                qo.x = __shfl_xor(qv.x, 4); qo.y = __shfl_xor(qv.y, 4); qo.z = __shfl_xor(qv.z, 4); qo.w = __shfl_xor(qv.w, 4);
                ko.x = __shfl_xor(kv.x, 4); ko.y = __shfl_xor(kv.y, 4); ko.z = __shfl_xor(kv.z, 4); ko.w = __shfl_xor(kv.w, 4);
                unpack8(qv, qf); unpack8(kv, kf); unpack8(qo, qp); unpack8(ko, kp);
                const float sgn = (lane & 4) ? 1.f : -1.f;
                const float pos = (float)(pos0 + c * 64 + row);
#pragma unroll
                for (int e = 0; e < 8; ++e) {
                    float t = pos * frq[e]; t = t - rintf(t);
                    const float cs = __builtin_amdgcn_cosf(t), sn = __builtin_amdgcn_sinf(t);
                    qf[e] = qf[e] * cs + sgn * qp[e] * sn; kf[e] = kf[e] * cs + sgn * kp[e] * sn;
                }
                *(uint4*)(sQ + row * 72 + qcol) = pack8f(qf); *(uint4*)(sK + row * 72 + qcol) = pack8f(kf);
            } else {
                *(uint4*)(sQ + row * 72 + qcol) = pq[i]; *(uint4*)(sK + row * 72 + qcol) = pk[i];
                unpack8(pk[i], kf);
            }
            const float wkr = __shfl(wk_l, row);
#pragma unroll
            for (int e = 0; e < 8; ++e) kf[e] *= wkr;
            *(uint4*)(sKW + row * 72 + qcol) = pack8f(kf);
            __builtin_amdgcn_sched_barrier(0);
        }
#pragma unroll
        for (int i = 0; i < 4; ++i) {
            const int id = i * 256 + ht, row = id >> 4, col = (id & 15) * 8;
            *(uint4*)(sV + row * 136 + col) = pv[i];
        }
        LBAR(); OPQ(fr); OPQ(fq); OPQ(ht); OPQ(lane);
        if (c + 1 < nch) MR_LOAD(c + 1);
        { const u16* cb_ = seq + (size_t)c * 64 * LDP;
#pragma unroll
        for (int i = 0; i < 4; ++i) { pg1[i] = ldsel(cb_ + (g1off - voff), MR_OFFV(i), MR_OKV(i)); if (MODE == 0) pg2[i] = ldsel(cb_ + (g2off - voff), MR_OFFV(i), MR_OKV(i)); } }
        f32x4 O[4][2];
#pragma unroll
        for (int m = 0; m < 4; ++m)
#pragma unroll
            for (int n = 0; n < 2; ++n) O[m][n] = (f32x4){0.f, 0.f, 0.f, 0.f};
#pragma unroll
        for (int t = 0; t < 2; ++t) {
            bf16x8 Bf[2];
#pragma unroll
            for (int n = 0; n < 2; ++n) Bf[n] = pack_acc2(Cacc[2 * t][n], Cacc[2 * t + 1][n]);
#pragma unroll
            for (int m = 0; m < 4; ++m) { const bf16x8 A = ldfrag2(sQ + (16 * m + fr) * 72 + 32 * t + 4 * fq);
#pragma unroll
                for (int n = 0; n < 2; ++n) O[m][n] = MFMA16(A, Bf[n], O[m][n]); }
        }
#pragma unroll
        for (int m = 0; m < 4; ++m) { const f32x4 w4 = *(const f32x4*)(sWI + 16 * m + 4 * fq);
#pragma unroll
            for (int n = 0; n < 2; ++n)
#pragma unroll
                for (int j = 0; j < 4; ++j) O[m][n][j] *= 0.125f * w4[j]; }
        {
            const f32x4 M4 = (MODE == 0) ? *(const f32x4*)(sMV + 16 * hw + 4 * fq) : (f32x4){0.f, 0.f, 0.f, 0.f};
            float rsum[4] = {0.f, 0.f, 0.f, 0.f};
#pragma unroll
            for (int n = 0; n < 4; ++n) {
                if (n <= hw) {
                    f32x4 S = (f32x4){0.f, 0.f, 0.f, 0.f};
#pragma unroll
                    for (int t = 0; t < 2; ++t) S = MFMA16(ldfrag(sQ + (16 * hw + fr) * 72 + 32 * t + 8 * fq), ldfrag(sK + (16 * n + fr) * 72 + 32 * t + 8 * fq), S);
                    const int s = 16 * n + fr; const float cs = (MODE == 0) ? sCV[s] : 0.f;
#pragma unroll
                    for (int j = 0; j < 4; ++j) {
                        const int l = 16 * hw + 4 * fq + j;
                        float w;
                        if (MODE == 0) w = (s <= l) ? 0.125f * __expf(cs - M4[j]) : 0.f; else w = (s <= l) ? 0.125f * __expf((float)(l - s) * lg) : 0.f;
                        const float pp = S[j] * w; rsum[j] += pp; sP[l * 72 + s] = f2bf(pp);
                    }
                } else {
#pragma unroll
                    for (int j = 0; j < 4; ++j) sP[(16 * hw + 4 * fq + j) * 72 + 16 * n + fr] = 0;
                }
            }
            if (MODE == 0) {
#pragma unroll
                for (int j = 0; j < 4; ++j) { const float r = red16(rsum[j]); if (fr == 0) sDA[16 * hw + 4 * fq + j] = r; }
            }
        }
        float nn = 0.f;
        if (MODE == 0) {
            const int l = ht >> 2, part = ht & 3; float a = 0.f, b2 = 0.f;
#pragma unroll
            for (int e = 0; e < 16; ++e) { a += bf2f(sQ[l * 72 + part * 16 + e]) * sN[part * 16 + e]; b2 += bf2f(sKW[(part * 16 + e) * 72 + l]); }
            a += __shfl_xor(a, 1); a += __shfl_xor(a, 2); b2 += __shfl_xor(b2, 1); b2 += __shfl_xor(b2, 2);
            if (part == 0) sDB[l] = 0.125f * a;
            nn = wc * sN[l] + b2;
        }
        LBAR(); OPQ(fr); OPQ(fq); OPQ(ht); OPQ(lane);
        if (MODE == 0 && (ht & 3) == 0) sN[ht >> 2] = nn;
#pragma unroll
        for (int m = 0; m < 4; ++m)
#pragma unroll
            for (int n = 0; n < 2; ++n)
#pragma unroll
                for (int j = 0; j < 4; ++j) Cacc[m][n][j] *= wc;
#pragma unroll
        for (int t = 0; t < 2; ++t) {
            bf16x8 Bv[2];
#pragma unroll
            for (int n = 0; n < 2; ++n) Bv[n] = ldfrag_tr(sV + (32 * t + 8 * fq + ((fr >> 2) & 3)) * 136 + 32 * hw + 16 * n + 4 * (fr & 3), 136);
#pragma unroll
            for (int m = 0; m < 4; ++m) { const bf16x8 Ap = ldfrag(sP + (16 * m + fr) * 72 + 32 * t + 8 * fq); const bf16x8 Ak = ldfrag_tr(sKW + (32 * t + 8 * fq + ((fr >> 2) & 3)) * 72 + 16 * m + 4 * (fr & 3), 72);
#pragma unroll
                for (int n = 0; n < 2; ++n) { O[m][n] = MFMA16(Ap, Bv[n], O[m][n]); Cacc[m][n] = MFMA16(Ak, Bv[n], Cacc[m][n]); } }
        }
#pragma unroll
        for (int m = 0; m < 4; ++m) {
            f32x4 dn = (f32x4){1.f, 1.f, 1.f, 1.f};
            if (MODE == 0) { const f32x4 da = *(const f32x4*)(sDA + 16 * m + 4 * fq), db = *(const f32x4*)(sDB + 16 * m + 4 * fq), wi = *(const f32x4*)(sWI + 16 * m + 4 * fq), em = *(const f32x4*)(sEMT + 16 * m + 4 * fq);
#pragma unroll
                for (int j = 0; j < 4; ++j) dn[j] = __builtin_amdgcn_rcpf(fmaxf(fabsf(da[j] + wi[j] * db[j]), em[j])); }
#pragma unroll
            for (int j = 0; j < 4; ++j) {
                const int l = 16 * m + 4 * fq + j;
                const float h0 = O[m][0][j] * dn[j], h1 = O[m][1][j] * dn[j];
                float sq = h0 * h0 + h1 * h1, su = h0 + h1;
                sq = red16(sq); if (MODE == 1) su = red16(su);
                if (fr == 0) { sSQ[hw * 64 + l] = sq; if (MODE == 1) sSM[hw * 64 + l] = su; }
                sH[l * 136 + 32 * hw + fr] = f2bf(h0); sH[l * 136 + 32 * hw + 16 + fr] = f2bf(h1);
            }
        }
        LBAR(); OPQ(fr); OPQ(fq); OPQ(ht); OPQ(lane);
#pragma unroll
        for (int i = 0; i < 4; ++i) {
            const int id = i * 256 + ht, row = id >> 4, col = (id & 15) * 8;
            if (row < nvalid) {
                const float ssq = sSQ[row] + sSQ[64 + row] + sSQ[128 + row] + sSQ[192 + row];
                float hv[8], g1[8], o[8]; unpack8(*(const uint4*)(sH + row * 136 + col), hv); unpack8(pg1[i], g1);
                if (MODE == 0) {
                    float g2[8]; unpack8(pg2[i], g2);
                    const float rs = rsqrtf(ssq * (1.f / 128.f) + EPS);
#pragma unroll
                    for (int e = 0; e < 8; ++e) o[e] = hv[e] * rs * normw[col + e] * sigmoidf_(g1[e]) * siluf_(g2[e]);
                } else {
                    const float mean = (sSM[row] + sSM[64 + row] + sSM[128 + row] + sSM[192 + row]) * (1.f / 128.f);
                    const float var = fmaxf(ssq * (1.f / 128.f) - mean * mean, 0.f);
                    const float rs = rsqrtf(var + EPS);
#pragma unroll
                    for (int e = 0; e < 8; ++e) o[e] = (hv[e] - mean) * rs * siluf_(g1[e]);
                }
                *(uint4*)(seq + (size_t)c * 64 * LDP + (size_t)MR_OFFV(i)) = pack8f(o);
            }
            __builtin_amdgcn_sched_barrier(0);
        }
        mprev = mnew;
        LBAR(); OPQ(fr); OPQ(fq); OPQ(ht); OPQ(lane);
    }
#undef MR_LOAD
#undef MR_OFFQ
#undef MR_OKQ
#undef MR_OFFV
#undef MR_OKV
    OPQS(outC); OPQS(outN); OPQS(outM);
#pragma unroll
    for (int m = 0; m < 4; ++m)
#pragma unroll
        for (int n = 0; n < 2; ++n)
#pragma unroll
            for (int j = 0; j < 4; ++j) { const int k = 16 * m + 4 * fq + j, v = 32 * hw + 16 * n + fr; outC[k * 128 + v] = Cacc[m][n][j]; }
    if (MODE == 0) { if (ht < 64) outN[ht] = sN[ht]; if (ht == 0) outM[0] = mprev; }
}

DI void chain_hgrn(unsigned char* sm, const int tid_o, const int w, const int lane_o, u16* seq, const int nvalid, const int nch, const int h,
                   const float* lbraw, const int layer, const float* initS, float* outS, const float* normw) {
    const int fr_o = lane_o & 15, fq_o = lane_o >> 4;
    const int fr = fr_o, fq = fq_o, tid = tid_o;
    float* LFB = (float*)sm;
    u16* sQ = (u16*)(sm + 33792); u16* sK = (u16*)(sm + 51200); u16* sKW = (u16*)(sm + 68608); u16* sV = (u16*)(sm + 86016); u16* sP = (u16*)(sm + 103424);
    u16* sH = sQ;
    float* TOT = (float*)(sm + 112640); float* BLAST = (float*)(sm + 114688); float* DEC = (float*)(sm + 115200); float* SSQ = (float*)(sm + 115712);
    const int qoff = 5632 + h * 128, foff = 6144 + h * 128, ioff = 6656 + h * 128, goff = 1536 + h * 128;
    const int k0 = (tid & 15) * 8;
    float lbv[8];
#pragma unroll
    for (int e = 0; e < 8; ++e) { const int cidx = h * 128 + k0 + e; lbv[e] = (float)layer * sigmoidf_(lbraw[512 + cidx] - lbraw[cidx]); }
    f32x4 Sacc[8];
#pragma unroll
    for (int m = 0; m < 8; ++m)
#pragma unroll
        for (int j = 0; j < 4; ++j) Sacc[m][j] = initS ? initS[(16 * m + 4 * fq + j) * 128 + 16 * w + fr] : 0.f;
    uint4 phq[2], phf[2], phi[2], pg[2];
#define HG_OFF(i) ((unsigned)((((i) * 32 + (tid >> 4)) < nvalid ? ((i) * 32 + (tid >> 4)) : 0) * LDP + qoff + (tid & 15) * 8))
#define HG_OK(i) (((i) * 32 + (tid >> 4)) < nvalid)
#define HG_LOAD(c) do { const u16* cb_ = seq + (size_t)(c) * 64 * LDP; _Pragma("unroll") for (int i = 0; i < 2; ++i) { \
        phq[i] = ldsel(cb_, HG_OFF(i), HG_OK(i)); phf[i] = ldsel(cb_ + (foff - qoff), HG_OFF(i), HG_OK(i)); phi[i] = ldsel(cb_ + (ioff - qoff), HG_OFF(i), HG_OK(i)); } } while (0)
    HG_LOAD(0);
    __syncthreads();
    for (int c = 0; c < nch; ++c) {
        int fr = fr_o, fq = fq_o, tid = tid_o; OPQ(fr); OPQ(fq); OPQ(tid);
        const int k0 = (tid & 15) * 8;
        float qf[2][8], kk[2][8];
#pragma unroll
        for (int i = 0; i < 2; ++i) {
            const int row = (i * 512 + tid) >> 4;
            float hf[8], lf[8]; unpack8(phq[i], qf[i]); unpack8(phf[i], hf);
#pragma unroll
            for (int e = 0; e < 8; ++e) {
                const float sg = sigmoidf_(hf[e]);
                if (row < nvalid) { lf[e] = __logf(lbv[e] + (1.f - lbv[e]) * sg); kk[i][e] = (1.f - lbv[e]) * (1.f - sg); } else { lf[e] = 0.f; kk[i][e] = 0.f; }
            }
            *(f32x4*)(LFB + row * 132 + k0) = (f32x4){lf[0], lf[1], lf[2], lf[3]}; *(f32x4*)(LFB + row * 132 + k0 + 4) = (f32x4){lf[4], lf[5], lf[6], lf[7]};
            *(uint4*)(sV + row * 136 + k0) = phi[i];
        }
        LBAR(); OPQ(fr); OPQ(fq); OPQ(tid);
        {
            const int k = tid & 127, seg = tid >> 7; float loc[16], run = 0.f;
#pragma unroll
            for (int i = 0; i < 16; ++i) { run += LFB[(16 * seg + i) * 132 + k]; loc[i] = run; }
            TOT[seg * 128 + k] = run;
            LBAR(); OPQ(fr); OPQ(fq); OPQ(tid);
            float off = 0.f;
#pragma unroll
            for (int s2 = 0; s2 < 3; ++s2) if (s2 < seg) off += TOT[s2 * 128 + k];
#pragma unroll
            for (int i = 0; i < 16; ++i) LFB[(16 * seg + i) * 132 + k] = loc[i] + off;
            if (seg == 3) { const float bl = off + run; BLAST[k] = bl; DEC[k] = __expf(bl); }
        }
        LBAR(); OPQ(fr); OPQ(fq); OPQ(tid);
#pragma unroll
        for (int i = 0; i < 2; ++i) {
            const int row = (i * 512 + tid) >> 4;
            const f32x4 b0 = *(const f32x4*)(LFB + row * 132 + k0), b1 = *(const f32x4*)(LFB + row * 132 + k0 + 4);
            const f32x4 l0 = *(const f32x4*)(BLAST + k0), l1 = *(const f32x4*)(BLAST + k0 + 4);
            float qt[8], kt[8], kw[8];
#pragma unroll
            for (int e = 0; e < 8; ++e) {
                const float b = e < 4 ? b0[e & 3] : b1[e & 3], bl = e < 4 ? l0[e & 3] : l1[e & 3];
                qt[e] = qf[i][e] * __expf(b); kt[e] = kk[i][e] * __expf(fminf(-b, 80.f));
                kw[e] = kk[i][e] * __expf(bl - b);
            }
            *(uint4*)(sQ + row * 136 + k0) = pack8f(qt); *(uint4*)(sK + row * 136 + k0) = pack8f(kt); *(uint4*)(sKW + row * 136 + k0) = pack8f(kw);
        }
        LBAR(); OPQ(fr); OPQ(fq); OPQ(tid);
        if (c + 1 < nch) HG_LOAD(c + 1);
#pragma unroll
        for (int i = 0; i < 2; ++i) pg[i] = ldsel(seq + (size_t)c * 64 * LDP + goff - qoff, HG_OFF(i), HG_OK(i));
        f32x4 O[4];
#pragma unroll
        for (int m = 0; m < 4; ++m) O[m] = (f32x4){0.f, 0.f, 0.f, 0.f};
#pragma unroll
        for (int t = 0; t < 4; ++t) {
            const bf16x8 Bf = pack_acc2(Sacc[2 * t], Sacc[2 * t + 1]);
#pragma unroll
            for (int m = 0; m < 4; ++m) O[m] = MFMA16(ldfrag2(sQ + (16 * m + fr) * 136 + 32 * t + 4 * fq), Bf, O[m]);
        }
        {
            const int mt = w >> 1;
#pragma unroll
            for (int nn = 0; nn < 2; ++nn) {
                const int n = (w & 1) * 2 + nn;
                if (n <= mt) {
                    f32x4 S = (f32x4){0.f, 0.f, 0.f, 0.f};
#pragma unroll
                    for (int t = 0; t < 4; ++t) S = MFMA16(ldfrag(sQ + (16 * mt + fr) * 136 + 32 * t + 8 * fq), ldfrag(sK + (16 * n + fr) * 136 + 32 * t + 8 * fq), S);
#pragma unroll
                    for (int j = 0; j < 4; ++j) { const int l = 16 * mt + 4 * fq + j, s = 16 * n + fr; sP[l * 72 + s] = (s <= l) ? f2bf(S[j]) : (u16)0; }
                } else {
#pragma unroll
                    for (int j = 0; j < 4; ++j) sP[(16 * mt + 4 * fq + j) * 72 + 16 * n + fr] = 0;
                }
            }
        }
        LBAR(); OPQ(fr); OPQ(fq); OPQ(tid);
#pragma unroll
        for (int m = 0; m < 8; ++m) { const f32x4 d4 = *(const f32x4*)(DEC + 16 * m + 4 * fq);
#pragma unroll
            for (int j = 0; j < 4; ++j) Sacc[m][j] *= d4[j]; }
#pragma unroll
        for (int t = 0; t < 2; ++t) {
            const bf16x8 Bv = ldfrag_tr(sV + (32 * t + 8 * fq + ((fr >> 2) & 3)) * 136 + 16 * w + 4 * (fr & 3), 136);
#pragma unroll
            for (int m = 0; m < 4; ++m) O[m] = MFMA16(ldfrag(sP + (16 * m + fr) * 72 + 32 * t + 8 * fq), Bv, O[m]);
#pragma unroll
            for (int m = 0; m < 8; ++m) Sacc[m] = MFMA16(ldfrag_tr(sKW + (32 * t + 8 * fq + ((fr >> 2) & 3)) * 136 + 16 * m + 4 * (fr & 3), 136), Bv, Sacc[m]);
        }
#pragma unroll
        for (int m = 0; m < 4; ++m)
#pragma unroll
            for (int j = 0; j < 4; ++j) {
                const int l = 16 * m + 4 * fq + j; const float o = O[m][j] * 0.08838834764831845f;
                const float sq = red16(o * o);
                if (fr == 0) SSQ[w * 64 + l] = sq;
                sH[l * 136 + 16 * w + fr] = f2bf(o);
            }
        LBAR(); OPQ(fr); OPQ(fq); OPQ(tid);
#pragma unroll
        for (int i = 0; i < 2; ++i) {
            const int row = (i * 512 + tid) >> 4;
            if (row < nvalid) {
                float ssq = 0.f;
#pragma unroll
                for (int ww = 0; ww < 8; ++ww) ssq += SSQ[ww * 64 + row];
                const float rs = rsqrtf(ssq * (1.f / 128.f) + EPS);
                float hv[8], g[8], o[8]; unpack8(*(const uint4*)(sH + row * 136 + k0), hv); unpack8(pg[i], g);
#pragma unroll
                for (int e = 0; e < 8; ++e) o[e] = hv[e] * rs * normw[k0 + e] * siluf_(g[e]);
                *(uint4*)(seq + (size_t)c * 64 * LDP + goff - qoff + (size_t)HG_OFF(i)) = pack8f(o);
            }
            __builtin_amdgcn_sched_barrier(0);
        }
        LBAR(); OPQ(fr); OPQ(fq); OPQ(tid);
    }
#undef HG_LOAD
#undef HG_OFF
#undef HG_OK
    OPQS(outS);
#pragma unroll
    for (int m = 0; m < 8; ++m)
#pragma unroll
        for (int j = 0; j < 4; ++j) outS[(16 * m + 4 * fq + j) * 128 + 16 * w + fr] = Sacc[m][j];
}

DI void block_ssd(unsigned char* sm, const int tid_o, const int w, const int lane_o, u16* seq, const float* gates, const int nvalid, const int nch, const int g, const int hp,
                  const float* convw, const float* convb, const float* dtb, const float* alog, const float* dsk, const float* snw,
                  const float* initH, const float* initConv, float* outH, float* outConv, float* ssq) {
    const int fr_o = lane_o & 15, fq_o = lane_o >> 4, hh = w >> 2, jw = w & 3, head = g * 4 + hp * 2 + hh;
    const int fr = fr_o, fq = fq_o, lane = lane_o, tid = tid_o;
    u16* sC = (u16*)sm; u16* sB = (u16*)(sm + 17408); u16* sX = (u16*)(sm + 34816);
    u16* sP = (u16*)(sm + 52224 + hh * 9216);
    u16* OB = (u16*)sm;
    float* TAB = (float*)(sm + 70656);
    float* BV = (float*)(sm + 78336); float* DTV = BV + 128; float* WV = BV + 256;
    const int rs8 = w;
    for (int idx = tid; idx < 5 * 384; idx += 512) {
        const int tap = idx / 384, lc = idx - tap * 384, c8 = lc >> 3, e = lc & 7;
        const int ch = (c8 < 16 ? g * 256 + hp * 128 + c8 * 8 : (c8 < 32 ? 512 + g * 128 + (c8 - 16) * 8 : 768 + g * 128 + (c8 - 32) * 8)) + e;
        TAB[idx] = tap < 4 ? convw[tap * 1024 + ch] : convb[ch];
    }
    f32x4 hacc[8];
#pragma unroll
    for (int m = 0; m < 8; ++m)
#pragma unroll
        for (int j = 0; j < 4; ++j) hacc[m][j] = initH ? initH[((size_t)head * 128 + 16 * m + 4 * fq + j) * 64 + 16 * jw + fr] : 0.f;
    const float dtbias = dtb[head], Aneg = -__expf(alog[head]), Dsk = dsk[head];
    uint4 pr[11]; float sdt = 0.f;
#define SSD_CP (lane < 48 ? lane : 47)
#define SSD_GCOL (SSD_CP < 16 ? 4608 + g * 256 + hp * 128 + SSD_CP * 8 : (SSD_CP < 32 ? 4608 + 512 + g * 128 + (SSD_CP - 16) * 8 : 4608 + 768 + g * 128 + (SSD_CP - 32) * 8))
#define SSD_OFFZ(i) ((unsigned)((((i) * 32 + (tid >> 4)) < nvalid ? ((i) * 32 + (tid >> 4)) : 0) * LDP + 1024 + g * 256 + hp * 128 + (tid & 15) * 8))
#define SSD_OKZ(i) (((i) * 32 + (tid >> 4)) < nvalid)
#define SSD_LOAD(c) do { const u16* cb_ = seq + (size_t)(c) * 64 * LDP; const unsigned gc_ = (unsigned)SSD_GCOL; _Pragma("unroll") for (int i = 0; i < 11; ++i) { const int row = 8 * rs8 - 3 + i; \
        const bool ok_ = row < nvalid && ((c) * 64 + row) >= 0; pr[i] = ldsel(cb_ + (ok_ ? row * LDP : 0), gc_, ok_); } \
        sdt = (lane < nvalid) ? gates[(size_t)(c) * 64 * 16 + (unsigned)((lane < nvalid ? lane : 0) * 16 + 8 + head)] : 0.f; } while (0)
    SSD_LOAD(0);
    __syncthreads();
    for (int c = 0; c < nch; ++c) {
        int fr = fr_o, fq = fq_o, lane = lane_o, tid = tid_o; OPQ(fr); OPQ(fq); OPQ(lane); OPQ(tid);
        const int cp = SSD_CP; const bool act = lane < 48; const int gcol = SSD_GCOL;
        {
            const bool useinit = (c == 0 && rs8 == 0 && initConv != nullptr);
            u16* dstp = cp < 16 ? sX + cp * 8 : (cp < 32 ? sB + (cp - 16) * 8 : sC + (cp - 32) * 8);
            uint2 ylo[8];
#pragma unroll 1
            for (int half = 0; half < 2; ++half) {
                f32x4 tw[5];
#pragma unroll
                for (int tp = 0; tp < 5; ++tp) tw[tp] = *(const f32x4*)(TAB + tp * 384 + cp * 8 + half * 4);
                f32x4 acc[8];
#pragma unroll
                for (int i = 0; i < 8; ++i) acc[i] = tw[4];
#pragma unroll
                for (int k = 0; k < 11; ++k) {
                    const unsigned w0 = half ? pr[k].z : pr[k].x, w1 = half ? pr[k].w : pr[k].y;
                    f32x4 cur = (f32x4){lo16(w0), hi16(w0), lo16(w1), hi16(w1)};
                    if (k < 3 && useinit) cur = *(const f32x4*)(initConv + k * 1024 + (gcol - 4608) + half * 4);
#pragma unroll
                    for (int i = 0; i < 8; ++i) {
                        if (k - i >= 0 && k - i <= 3) {
#pragma unroll
                            for (int e = 0; e < 4; ++e) acc[i][e] += tw[k - i][e] * cur[e];
                        }
                    }
                }
#pragma unroll
                for (int i = 0; i < 8; ++i) {
                    const int row = 8 * rs8 + i;
                    float y[4];
#pragma unroll
                    for (int e = 0; e < 4; ++e) y[e] = (row < nvalid) ? siluf_(acc[i][e]) : 0.f;
                    uint2 pk; pk.x = pk2(y[0], y[1]); pk.y = pk2(y[2], y[3]);
                    if (half == 0) ylo[i] = pk;
                    else if (act) { uint4 v; v.x = ylo[i].x; v.y = ylo[i].y; v.z = pk.x; v.w = pk.y; *(uint4*)(dstp + row * 136) = v; }
                }
            }
        }
        float blast;
        {
            const float dt = (lane < nvalid) ? softplusf_(sdt + dtbias) : 0.f;
            const float la = dt * Aneg;
            const float b = wscan_sum(la, lane);
            blast = __shfl(b, 63);
            if (jw == 0) { BV[hh * 64 + lane] = b; DTV[hh * 64 + lane] = dt; WV[hh * 64 + lane] = __expf(blast - b) * dt; }
        }
        LBAR(); OPQ(fr); OPQ(fq); OPQ(lane); OPQ(tid);
        f32x4 O[4];
#pragma unroll
        for (int m = 0; m < 4; ++m) O[m] = (f32x4){0.f, 0.f, 0.f, 0.f};
#pragma unroll
        for (int t = 0; t < 4; ++t) {
            const bf16x8 Bf = pack_acc2(hacc[2 * t], hacc[2 * t + 1]);
#pragma unroll
            for (int m = 0; m < 4; ++m) O[m] = MFMA16(ldfrag2(sC + (16 * m + fr) * 136 + 32 * t + 4 * fq), Bf, O[m]);
        }
#pragma unroll
        for (int m = 0; m < 4; ++m) { const f32x4 b4 = *(const f32x4*)(BV + hh * 64 + 16 * m + 4 * fq);
#pragma unroll
            for (int j = 0; j < 4; ++j) O[m][j] *= __expf(b4[j]); }
        {
            const int mt = jw;
            const f32x4 bl4 = *(const f32x4*)(BV + hh * 64 + 16 * mt + 4 * fq);
#pragma unroll
            for (int n = 0; n < 4; ++n) {
                if (n <= mt) {
                    f32x4 S = (f32x4){0.f, 0.f, 0.f, 0.f};
#pragma unroll
                    for (int t = 0; t < 4; ++t) S = MFMA16(ldfrag(sC + (16 * mt + fr) * 136 + 32 * t + 8 * fq), ldfrag(sB + (16 * n + fr) * 136 + 32 * t + 8 * fq), S);
                    const int s = 16 * n + fr; const float bs = BV[hh * 64 + s], ds = DTV[hh * 64 + s];
#pragma unroll
                    for (int j = 0; j < 4; ++j) { const int l = 16 * mt + 4 * fq + j; sP[l * 72 + s] = (s <= l) ? f2bf(S[j] * __expf(bl4[j] - bs) * ds) : (u16)0; }
                } else {
#pragma unroll
                    for (int j = 0; j < 4; ++j) sP[(16 * mt + 4 * fq + j) * 72 + 16 * n + fr] = 0;
                }
            }
        }
        LBAR(); OPQ(fr); OPQ(fq); OPQ(lane); OPQ(tid);
        {
            const float eb = __expf(blast);
#pragma unroll
            for (int m = 0; m < 8; ++m)
#pragma unroll
                for (int j = 0; j < 4; ++j) hacc[m][j] *= eb;
        }
#pragma unroll
        for (int t = 0; t < 2; ++t) {
            const f32x4 w0 = *(const f32x4*)(WV + hh * 64 + 32 * t + 8 * fq), w1 = *(const f32x4*)(WV + hh * 64 + 32 * t + 8 * fq + 4);
            const bf16x8 Bv = ldfrag_tr(sX + (32 * t + 8 * fq + ((fr >> 2) & 3)) * 136 + hh * 64 + 16 * jw + 4 * (fr & 3), 136);
            float x[8]; unpack8(__builtin_bit_cast(uint4, Bv), x);
#pragma unroll
            for (int e = 0; e < 4; ++e) { x[e] *= w0[e]; x[4 + e] *= w1[e]; }
            const bf16x8 Bw = as_frag(pack8f(x));
#pragma unroll
            for (int m = 0; m < 4; ++m) O[m] = MFMA16(ldfrag(sP + (16 * m + fr) * 72 + 32 * t + 8 * fq), Bv, O[m]);
#pragma unroll
            for (int m = 0; m < 8; ++m) hacc[m] = MFMA16(ldfrag_tr(sB + (32 * t + 8 * fq + ((fr >> 2) & 3)) * 136 + 16 * m + 4 * (fr & 3), 136), Bw, hacc[m]);
        }
#pragma unroll
        for (int m = 0; m < 4; ++m) {
            const int pcol = hh * 64 + 16 * jw + fr;
            const uint2 xr = __builtin_bit_cast(uint2, ld_tr4(sX + (16 * m + 4 * fq + ((fr >> 2) & 3)) * 136 + hh * 64 + 16 * jw + 4 * (fr & 3)));
            const float xs0 = lo16(xr.x), xs1 = hi16(xr.x), xs2 = lo16(xr.y), xs3 = hi16(xr.y);
            const int l0 = 16 * m + 4 * fq;
            OB[(l0 + 0) * 136 + pcol] = f2bf(O[m][0] + Dsk * xs0);
            OB[(l0 + 1) * 136 + pcol] = f2bf(O[m][1] + Dsk * xs1);
            OB[(l0 + 2) * 136 + pcol] = f2bf(O[m][2] + Dsk * xs2);
            OB[(l0 + 3) * 136 + pcol] = f2bf(O[m][3] + Dsk * xs3);
        }
        LBAR(); OPQ(fr); OPQ(fq); OPQ(lane); OPQ(tid);
        if (c + 1 < nch) SSD_LOAD(c + 1);
#pragma unroll
        for (int i = 0; i < 2; ++i) {
            const int id = i * 512 + tid, row = id >> 4, col = (id & 15) * 8;
            float yv[8], z[8], val[8]; unpack8(*(const uint4*)(OB + row * 136 + col), yv); unpack8(ldsel(seq + (size_t)c * 64 * LDP, SSD_OFFZ(i), SSD_OKZ(i)), z);
            float ss = 0.f;
#pragma unroll
            for (int e = 0; e < 8; ++e) { val[e] = yv[e] * siluf_(z[e]); ss += val[e] * val[e]; }
            ss = red16(ss);
            if (row < nvalid) {
                if ((tid & 15) == 0) ssq[(size_t)(c * 64 + row) * 4 + g * 2 + hp] = ss;
                float o[8];
#pragma unroll
                for (int e = 0; e < 8; ++e) o[e] = val[e] * snw[g * 256 + hp * 128 + col + e];
                *(uint4*)(seq + (size_t)c * 64 * LDP + (size_t)SSD_OFFZ(i)) = pack8f(o);
            }
            __builtin_amdgcn_sched_barrier(0);
        }
        LBAR(); OPQ(fr); OPQ(fq); OPQ(lane); OPQ(tid);
    }
#undef SSD_LOAD
#undef SSD_GCOL
#undef SSD_CP
#undef SSD_OFFZ
#undef SSD_OKZ
    OPQS(outH); OPQS(outConv);
#pragma unroll
    for (int m = 0; m < 8; ++m)
#pragma unroll
        for (int j = 0; j < 4; ++j) outH[((size_t)head * 128 + 16 * m + 4 * fq + j) * 64 + 16 * jw + fr] = hacc[m][j];
    if (hp == 0) {
        const int T = (nch - 1) * 64 + nvalid;
        for (int idx = tid; idx < 3 * 512; idx += 512) { const int rr = idx >> 9, ch = g * 512 + (idx & 511);
            outConv[rr * 1024 + ch] = bf2f(seq[(size_t)(T - 3 + rr) * LDP + 4608 + ch]); }
    }
}

template <int MIX>
DI void mixer_phase(const Params& p, int l_in, unsigned char* sm) {
    const int l = __builtin_amdgcn_readfirstlane(l_in);
    u16* proj = (u16*)(p.ws + WS_PROJ); u16* sproj = (u16*)(p.ws + WS_SPROJ);
    const float* gates = (const float*)(p.ws + WS_GATES); const float* sgates = (const float*)(p.ws + WS_SGATES);
    float* out = p.out;
    float* ssqb = (float*)(p.ws + WS_SSQ);
    for (int task = blockIdx.x; task < 288; task += gridDim.x) {
        int tid = threadIdx.x; OPQ(tid);
        const int w = __builtin_amdgcn_readfirstlane(tid >> 6), lane = tid & 63;
        const int tk = __builtin_amdgcn_readfirstlane(task);
        if (MIXON(0) && (tk < 32 || (tk >= 96 && tk < 160))) {
            const bool smp = tk < 32; const int t2 = smp ? tk : tk - 96; const int b = t2 >> 2, g = (t2 >> 1) & 1, hp = t2 & 1;
            u16* seq = smp ? sproj + (size_t)b * 16 * LDP : proj + (size_t)b * SEQ * LDP;
            const float* gt = smp ? sgates + (size_t)b * 16 * 16 : gates + (size_t)b * SEQ * 16;
            const int nb = smp ? DEC_BATCH : BATCH;
            float* oH = out + (smp ? O_SSSD : O_PSSD) + ((size_t)l * nb + b) * 8 * 128 * 64;
            float* oC = out + (smp ? O_SCONV : O_PCONV) + ((size_t)l * nb + b) * 3 * 1024;
            float* sq = ssqb + (smp ? (size_t)(NTOK + b * 16) * 4 : (size_t)b * SEQ * 4);
            block_ssd(sm, tid, w, lane, seq, gt, smp ? 16 : 64, smp ? 1 : 32, g, hp,
                      p.conv_w + (size_t)l * 4 * 1024, p.conv_b + l * 1024, p.dt_bias + l * 8, p.a_log + l * 8, p.d_skip + l * 8, p.snorm_w + l * 512,
                      smp ? p.st_ssd + ((size_t)l * DEC_BATCH + b) * 8 * 128 * 64 : nullptr, smp ? p.st_conv + ((size_t)l * DEC_BATCH + b) * 3 * 1024 : nullptr, oH, oC, sq);
        } else if (MIXON(1) && ((tk >= 32 && tk < 64) || tk >= 224)) {
            const bool smp = tk < 64; const int t2 = smp ? tk - 32 : tk - 224; const int b = t2 >> 2, h = t2 & 3;
            u16* seq = smp ? sproj + (size_t)b * 16 * LDP : proj + (size_t)b * SEQ * LDP;
            const int nb = smp ? DEC_BATCH : BATCH;
            float* oS = out + (smp ? O_SHG : O_PHG) + (((size_t)l * nb + b) * 4 + h) * 128 * 128;
            chain_hgrn(sm, tid, w, lane, seq, smp ? 16 : 64, smp ? 1 : 32, h, p.lbraw, l,
                       smp ? p.st_hg + (((size_t)l * DEC_BATCH + b) * 4 + h) * 128 * 128 : nullptr, oS, p.hnorm_w + l * 512 + h * 128);
        } else if ((tk >= 64 && tk < 96) || (tk >= 160 && tk < 224)) {
            int t2; bool smp, ret;
            if (tk < 80) { smp = true; ret = false; t2 = tk - 64; }
            else if (tk < 96) { smp = true; ret = true; t2 = tk - 80; }
            else if (tk < 192) { smp = false; ret = false; t2 = tk - 160; }
            else { smp = false; ret = true; t2 = tk - 192; }
            const int chain = t2 * 2 + (w >> 2); const int b = chain >> 2, h = chain & 3;
            u16* seq = smp ? sproj + (size_t)b * 16 * LDP : proj + (size_t)b * SEQ * LDP;
            const float* gt = smp ? sgates + (size_t)b * 16 * 16 : gates + (size_t)b * SEQ * 16;
            const int nb = smp ? DEC_BATCH : BATCH;
            const size_t si = ((size_t)l * nb + b) * 4 + h;
            unsigned char* csm = sm + (w >> 2) * 65536;
            if (MIXON(2) && !ret) {
                chain_mr<0>(csm, tid & 255, w & 3, lane, seq, gt, smp ? 16 : 64, smp ? 1 : 32, 0, h,
                            smp ? p.st_mc + si * 64 * 128 : nullptr, smp ? p.st_mn + si * 64 : nullptr, smp ? p.st_mm + si : nullptr,
                            out + (smp ? O_SMC : O_PMC) + si * 64 * 128, out + (smp ? O_SMN : O_PMN) + si * 64, out + (smp ? O_SMM : O_PMM) + si,
                            p.mnorm_w + l * 512 + h * 128, p.gate_b[l * 8 + h], p.gate_b[l * 8 + 4 + h]);
            } else if (MIXON(3) && ret) {
                chain_mr<1>(csm, tid & 255, w & 3, lane, seq, gt, smp ? 16 : 64, smp ? 1 : 32, smp ? PAST_LEN : 0, h,
                            smp ? p.st_ret + si * 64 * 128 : nullptr, nullptr, nullptr,
                            out + (smp ? O_SRET : O_PRET) + si * 64 * 128, nullptr, nullptr, nullptr, 0.f, 0.f);
            }
        }
        __syncthreads();
    }
}

DI void final_norm(const Params& p, int gw, int ngw, int lane) {
    const u16* X = (const u16*)(p.ws + WS_PROJ);
    for (int r = gw; r < NTOK + NSTOK; r += ngw) {
        float x[16];
        if (r < NTOK) {
#pragma unroll
            for (int i = 0; i < 4; ++i) { const float4 v = *(const float4*)((const float*)(X + (size_t)r * LDP + 2048) + i * 256 + lane * 4); x[4 * i] = v.x; x[4 * i + 1] = v.y; x[4 * i + 2] = v.z; x[4 * i + 3] = v.w; }
        } else {
#pragma unroll
            for (int i = 0; i < 4; ++i) { const float4 v = *(const float4*)(p.out + O_YS + (size_t)(r - NTOK) * 1024 + i * 256 + lane * 4); x[4 * i] = v.x; x[4 * i + 1] = v.y; x[4 * i + 2] = v.z; x[4 * i + 3] = v.w; }
        }
        float ss = 0.f;
#pragma unroll
        for (int i = 0; i < 16; ++i) ss += x[i] * x[i];
        ss = wsum(ss);
        const float rs = rsqrtf(ss * (1.f / 1024.f) + EPS);
        float* dst = (r < NTOK) ? p.out + O_YP + (size_t)r * 1024 : p.out + O_YS + (size_t)(r - NTOK) * 1024;
#pragma unroll
        for (int i = 0; i < 4; ++i) { const int k = i * 256 + lane * 4; const float4 wv = *(const float4*)(p.fnorm_w + k);
            float4 o; o.x = x[4 * i] * rs * wv.x; o.y = x[4 * i + 1] * rs * wv.y; o.z = x[4 * i + 2] * rs * wv.z; o.w = x[4 * i + 3] * rs * wv.w;
            *(float4*)(dst + k) = o; }
    }
}


#define XB_TMO      128
#define XB_XCNT(j)  (256  + 64 * (j))
#define XB_XSUB(j)  (1280 + 64 * (j))
#define XB_XGEN(j)  (2304 + 64 * (j))
#define XB_TOP      3328
#define XB_TOPGEN   3392
#define XCD_BAR_WORDS 3456
#define XB_SPIN_CAP (1u << 18)
DI unsigned xb_ld(unsigned* p)              { return __hip_atomic_load(p, __ATOMIC_RELAXED, __HIP_MEMORY_SCOPE_AGENT); }
DI unsigned xb_add(unsigned* p, unsigned v) { return __hip_atomic_fetch_add(p, v, __ATOMIC_RELAXED, __HIP_MEMORY_SCOPE_AGENT); }
DI unsigned xb_xcc_id() { return (unsigned)__builtin_amdgcn_s_getreg((3 << 11) | 20) & 0xFu; }
#define XB_SPIN(cond, bar) do { unsigned _sp = 0; while (cond) { __builtin_amdgcn_s_sleep(1); \
    if ((++_sp & 255u) == 0u) { if (xb_ld(&(bar)[XB_TMO])) break; if (_sp > XB_SPIN_CAP) { atomicAdd(&(bar)[XB_TMO], 1u); break; } } } } while (0)
struct XcdBarrier { unsigned* bar; unsigned x; volatile LAS unsigned* st; };
DI void xcd_barrier_post(unsigned* bar) { if (threadIdx.x == 0) (void)xb_add(&bar[XB_XCNT(xb_xcc_id())], 1u); }
DI void xcd_barrier_complete(unsigned* bar, unsigned x, unsigned& nloc, unsigned& nx) {
    const unsigned G = gridDim.x * gridDim.y * gridDim.z;
    unsigned sum, cnt, mine, sp = 0u;
    for (;;) {
        sum = 0u; cnt = 0u; mine = 0u;
#pragma unroll
        for (unsigned j = 0; j < 16; ++j) { const unsigned c = xb_ld(&bar[XB_XCNT(j)]); sum += c; cnt += (c > 0u) ? 1u : 0u; mine = (j == x) ? c : mine; }
        if (sum == G) break;
        __builtin_amdgcn_s_sleep(1);
        if ((++sp & 255u) == 0u) { if (xb_ld(&bar[XB_TMO])) break; if (sp > XB_SPIN_CAP) { atomicAdd(&bar[XB_TMO], 1u); break; } }
    }
    nloc = mine > 0u ? mine : 1u; nx = cnt > 0u ? cnt : 1u;
}
DI void xcd_barrier(const XcdBarrier& b) {
    asm volatile("s_waitcnt vmcnt(0)" ::: "memory");
    __syncthreads();
    if (threadIdx.x == 0) {
        unsigned* bar = b.bar;
        __builtin_amdgcn_s_waitcnt(0);
        unsigned nloc = b.st[0], nx = b.st[1];
        if (nloc == 0u) { xcd_barrier_complete(bar, b.x, nloc, nx); b.st[0] = nloc; b.st[1] = nx; }
        const unsigned old = xb_add(&bar[XB_XSUB(b.x)], 1u);
        const unsigned gen = old / nloc;
        if (old + 1u == (gen + 1u) * nloc) {
            __builtin_amdgcn_fence(__ATOMIC_RELEASE, "agent");
            asm volatile("s_waitcnt vmcnt(0)" ::: "memory");
            const unsigned og = xb_add(&bar[XB_TOP], 1u);
            const unsigned tg = og / nx;
            if (og + 1u == (tg + 1u) * nx) xb_add(&bar[XB_TOPGEN], 1u);
            else XB_SPIN(xb_ld(&bar[XB_TOPGEN]) == tg, bar);
            __builtin_amdgcn_fence(__ATOMIC_ACQUIRE, "agent");
            xb_add(&bar[XB_XGEN(b.x)], 1u);
            asm volatile("s_waitcnt vmcnt(0)" ::: "memory");
        } else {
            XB_SPIN(xb_ld(&bar[XB_XGEN(b.x)]) == gen, bar);
            __builtin_amdgcn_fence(__ATOMIC_ACQUIRE, "agent");
            asm volatile("s_waitcnt vmcnt(0)" ::: "memory");
        }
    }
    __syncthreads();
}
#define GRID_SEAM(first) do { if (first) cg::this_grid().sync(); else { XcdBarrier xb_; xb_.bar = (unsigned*)(p.ws + WS_BAR); xb_.x = xb_xcc_id(); xb_.st = (volatile LAS unsigned*)(LAS unsigned char*)(lds + LDS_BYTES - 16); xcd_barrier(xb_); } } while (0)

template <int PHSEL, int MIX>
DI void run_phases(const Params& p, unsigned char* lds) {
#define PSEL(x) (PHSEL < 0 || PHSEL == (x))
    if (COOP) { volatile LAS unsigned* st_ = (volatile LAS unsigned*)(LAS unsigned char*)(lds + LDS_BYTES - 16); if (threadIdx.x < 2) st_[threadIdx.x] = 0u; __syncthreads(); xcd_barrier_post((unsigned*)(p.ws + WS_BAR)); }
#ifndef PROG
#define PROG 0x876543210ull
#define NPROG 9
#endif
    for (int pi = p.ph_lo; pi < p.ph_hi; ++pi) {
        const int ph = __builtin_amdgcn_readfirstlane((int)((PROG >> (4 * pi)) & 15ull));
#define PH_IDS int tid = threadIdx.x; OPQ(tid); const int w = __builtin_amdgcn_readfirstlane(tid >> 6), lane = tid & 63; const int gw = blockIdx.x * 8 + w, ngw = gridDim.x * 8; (void)gw; (void)ngw; (void)lane
        u16* proj = (u16*)(p.ws + WS_PROJ); u16* sproj = (u16*)(p.ws + WS_SPROJ);
        float* gates = (float*)(p.ws + WS_GATES); float* sgates = (float*)(p.ws + WS_SGATES);
        float* rstd = (float*)(p.ws + WS_RSTD); float* srstd = (float*)(p.ws + WS_SRSTD);
        u16* shi = (u16*)(p.ws + WS_SHI);
        u16* X = (u16*)(p.out + O_YP);
        float* ys = p.out + O_YS;
        if (PSEL(0) && ph == 0) {
            PH_IDS;
            convert_weights(p, (float*)lds, tid);
            build_wg(p, 0, (float*)lds, tid);
            __syncthreads();
            prep_rows<0>(p.x_prompt, nullptr, NTOK, X, 2048, true, rstd, gates, nullptr, (const float*)lds, gw, ngw, lane);
            prep_rows<0>(p.x_sample, nullptr, NSTOK, shi, 1024, true, srstd, sgates, ys, (const float*)lds, gw, ngw, lane);
        } else if (PSEL(4) && ph == 4) {
            PH_IDS;
            build_wg(p, 1, (float*)lds, tid);
            __syncthreads();
            prep_rows<1>(nullptr, X, NTOK, nullptr, 0, false, rstd, gates, nullptr, (const float*)lds, gw, ngw, lane);
            prep_rows<0>(ys, nullptr, NSTOK, shi, 1024, true, srstd, sgates, nullptr, (const float*)lds, gw, ngw, lane);
        } else if (PSEL(1) && (ph == 1 || ph == 5)) {
            PH_IDS;
            const int l = ph == 1 ? 0 : 1;
            const u16* wt = (const u16*)(p.ws + WS_WTIN) + (size_t)l * LDP * 1024;
            sample_gemm<0>(shi, 1024, wt, LDP, 1024, gw, ngw, lane, sproj, srstd, nullptr, nullptr);
            __syncthreads();
            pg8::Gemm g; g.A = X; g.Bt = wt; g.M = NTOK; g.N = LDP; g.K = 1024; g.lda = 2048;
            pg8::StaticOrder S; S.init(g.M, g.N, (int)gridDim.x, (int)blockIdx.x);
            pg8::EpiIn E; E.O = proj; E.rstd = rstd;
            pg8::gemm_phase<pg8::EpiIn>((LAS unsigned char*)lds, g, S, E, tid);
        } else if (PSEL(2) && (ph == 2 || ph == 6)) {
            mixer_phase<MIX>(p, ph == 2 ? 0 : 1, lds);
        } else if (PSEL(3) && (ph == 3 || ph == 7)) {
            PH_IDS;
            const int l = ph == 3 ? 0 : 1;
            const u16* wt = (const u16*)(p.ws + WS_WTOUT) + (size_t)l * 1024 * 2048;
            {
                const float* ssqb = (const float*)(p.ws + WS_SSQ);
                for (int r = gw; r < NTOK + NSTOK; r += ngw) {
                    u16* rowp = (r < NTOK ? proj + (size_t)r * LDP : sproj + (size_t)(r - NTOK) * LDP) + 1024 + lane * 8;
                    const float4 s4 = *(const float4*)(ssqb + (size_t)r * 4);
                    const float tot = (lane >> 5) ? s4.z + s4.w : s4.x + s4.y;
                    const float rs = rsqrtf(tot * (1.f / 256.f) + EPS);
                    float v[8]; unpack8(*(const uint4*)rowp, v);
#pragma unroll
                    for (int e = 0; e < 8; ++e) v[e] *= rs;
                    *(uint4*)rowp = pack8f(v);
                }
                GRID_SEAM(false);
            }
            {
                const int fr = lane & 15, fq = lane >> 4; float* red = (float*)lds;
                const float* resid = l == 0 ? p.x_sample : ys;
                for (int t = blockIdx.x; t < 512; t += gridDim.x) {
                    const int rt = t & 7, ct = t >> 3;
                    const u16* ap = sproj + (size_t)(rt * 16 + fr) * LDP + w * 256 + 8 * fq;
                    const u16* bp = wt + (size_t)(ct * 16 + fr) * 2048 + w * 256 + 8 * fq;
                    f32x4 acc = (f32x4){0.f, 0.f, 0.f, 0.f};
#pragma unroll
                    for (int k = 0; k < 256; k += 32) acc = MFMA16(as_frag(ldg16(ap + k)), as_frag(ldg16(bp + k)), acc);
                    *(f32x4*)(red + (w * 64 + lane) * 4) = acc;
                    __syncthreads();
                    if (w == 0) {
                        f32x4 tot = acc;
#pragma unroll
                        for (int ww = 1; ww < 8; ++ww) { const f32x4 o = *(const f32x4*)(red + (ww * 64 + lane) * 4); tot[0] += o[0]; tot[1] += o[1]; tot[2] += o[2]; tot[3] += o[3]; }
#pragma unroll
                        for (int j = 0; j < 4; ++j) { const size_t o = (size_t)(rt * 16 + 4 * fq + j) * 1024 + ct * 16 + fr; ys[o] = resid[o] + tot[j]; }
                    }
                    __syncthreads();
                }
            }
            pg8::Gemm g; g.A = proj; g.Bt = wt; g.M = NTOK; g.N = 1024; g.K = 2048; g.lda = LDP;
            pg8::StaticOrder S; S.init(g.M, g.N, (int)gridDim.x, (int)blockIdx.x);
            pg8::EpiOut E; E.Xhi = X; E.Xlo = X + 1024; E.xin = l == 0 ? p.x_prompt : nullptr; E.projdead = proj; E.last = (l == 1);
            pg8::gemm_phase<pg8::EpiOut>((LAS unsigned char*)lds, g, S, E, tid);
        } else if (PSEL(8) && ph == 8) {
            PH_IDS;
            final_norm(p, gw, ngw, lane);
        }
        if (pi + 1 < p.ph_hi) { GRID_SEAM(p.ph_hi > 64); }
    }
#undef PSEL
}
#if COOP
__global__ __launch_bounds__(512) void mega(Params p) {
    extern __shared__ __attribute__((aligned(16))) unsigned char lds[];
    run_phases<-1, -1>(p, lds);
}
#else
template <int PHSEL, int MIX>
__global__ __launch_bounds__(512) void phase_k(Params p) {
    extern __shared__ __attribute__((aligned(16))) unsigned char lds[];
    run_phases<PHSEL, MIX>(p, lds);
}
#endif

extern "C" void kernel_launch(void* const* d_in, const int* in_sizes, int n_in, void* d_out, int out_size, void* d_ws, size_t ws_size, hipStream_t stream) {
    static int grid = 0;
    if (grid == 0) {
        if (n_in != 23 || (size_t)out_size != O_END || ws_size < WS_END) { fprintf(stderr, "kernel_launch: unexpected shapes n_in %d out %d ws %zu (need %zu)\n", n_in, out_size, ws_size, (size_t)WS_END); grid = -1; return; }
        int dev = 0, cus = 0, per_cu = 0;
        (void)hipGetDevice(&dev); (void)hipDeviceGetAttribute(&cus, hipDeviceAttributeMultiprocessorCount, dev);
#if COOP
        if (hipFuncSetAttribute((const void*)mega, hipFuncAttributeMaxDynamicSharedMemorySize, LDS_BYTES) != hipSuccess) { fprintf(stderr, "hipFuncSetAttribute failed\n"); grid = -1; return; }
        (void)hipOccupancyMaxActiveBlocksPerMultiprocessor(&per_cu, (const void*)mega, 512, LDS_BYTES);
        (void)hipGetLastError();
#else
        hipError_t e = hipSuccess;
#define SETA(PH, MX) if (e == hipSuccess) e = hipFuncSetAttribute((const void*)phase_k<PH, MX>, hipFuncAttributeMaxDynamicSharedMemorySize, LDS_BYTES)
        SETA(0, -1); SETA(1, -1); SETA(2, 0); SETA(2, 1); SETA(2, 2); SETA(2, 3); SETA(3, -1); SETA(4, -1); SETA(8, -1);
#undef SETA
        if (e != hipSuccess) { fprintf(stderr, "hipFuncSetAttribute failed\n"); grid = -1; return; }
#endif
        if (per_cu < 1) per_cu = 1;
        grid = cus * per_cu; if (grid > 256) grid = 256;
    }
    if (grid < 0) return;
    Params p{};
    p.x_prompt = (const float*)d_in[0]; p.x_sample = (const float*)d_in[1];
    p.st_mc = (const float*)d_in[2]; p.st_mn = (const float*)d_in[3]; p.st_mm = (const float*)d_in[4]; p.st_ret = (const float*)d_in[5];
    p.st_ssd = (const float*)d_in[6]; p.st_conv = (const float*)d_in[7]; p.st_hg = (const float*)d_in[8];
    p.norm_w = (const float*)d_in[9]; p.w_in = (const float*)d_in[10]; p.gate_b = (const float*)d_in[11]; p.mnorm_w = (const float*)d_in[12];
    p.conv_w = (const float*)d_in[13]; p.conv_b = (const float*)d_in[14]; p.dt_bias = (const float*)d_in[15]; p.a_log = (const float*)d_in[16];
    p.d_skip = (const float*)d_in[17]; p.snorm_w = (const float*)d_in[18]; p.lbraw = (const float*)d_in[19]; p.hnorm_w = (const float*)d_in[20];
    p.w_out = (const float*)d_in[21]; p.fnorm_w = (const float*)d_in[22];
    p.out = (float*)d_out; p.ws = (unsigned char*)d_ws;
#if COOP
    p.ph_lo = 0; p.ph_hi = NPROG;
    if (hipMemsetAsync((char*)d_ws + WS_BAR, 0, 16384, stream) != hipSuccess) { fprintf(stderr, "hipMemsetAsync failed\n"); return; }
    void* args[] = {&p};
    hipError_t e = hipLaunchCooperativeKernel((const void*)mega, dim3(grid), dim3(512), args, LDS_BYTES, stream);
    if (e != hipSuccess) fprintf(stderr, "cooperative launch failed: %s (grid %d)\n", hipGetErrorString(e), grid);
#else
#ifndef MAXL
#define MAXL 99
#endif
    int nl_ = 0;
#define LAUNCH(PH, MX, ph_) do { if (nl_++ >= MAXL) break; p.ph_lo = (ph_); p.ph_hi = (ph_) + 1; hipLaunchKernelGGL((phase_k<PH, MX>), dim3(grid), dim3(512), LDS_BYTES, stream, p); } while (0)
    LAUNCH(0, -1, 0); LAUNCH(1, -1, 1);
    LAUNCH(2, 0, 2); LAUNCH(2, 1, 2); LAUNCH(2, 2, 2); LAUNCH(2, 3, 2);
    LAUNCH(3, -1, 3); LAUNCH(4, -1, 4); LAUNCH(1, -1, 5);
    LAUNCH(2, 0, 6); LAUNCH(2, 1, 6); LAUNCH(2, 2, 6); LAUNCH(2, 3, 6);
    LAUNCH(3, -1, 7); LAUNCH(8, -1, 8);
#undef LAUNCH
#endif
}
```

```cpp
#include <hip/hip_runtime.h>
#include <hip/hip_cooperative_groups.h>
#include <cstdio>
namespace cg = cooperative_groups;

#define DI __device__ __forceinline__
#define OPQ(x) asm volatile("" : "+v"(x))
#define LBAR() asm volatile("s_waitcnt lgkmcnt(0)\n\ts_barrier" ::: "memory")
#define OPQS(x) asm volatile("" : "+s"(x))
typedef unsigned short u16;
typedef short bf16x8 __attribute__((ext_vector_type(8)));
typedef short bf16x4 __attribute__((ext_vector_type(4)));
typedef float f32x4 __attribute__((ext_vector_type(4)));
typedef unsigned u32x4 __attribute__((ext_vector_type(4)));
#define LAS __attribute__((address_space(3)))

#ifndef COOP
#define COOP 1
#endif
#ifndef ONLYPH
#define ONLYPH -1
#endif
#ifndef ONLYMIX
#define ONLYMIX -1
#endif
#define MIXON(x) ((MIX < 0 || MIX == (x)) && (ONLYMIX < 0 || ONLYMIX == (x)))
#define PHON(x) (ONLYPH < 0 || ONLYPH == (x))

constexpr int D_MODEL = 1024, BATCH = 16, SEQ = 2048, DEC_BATCH = 8, DEC_SEQ = 16, PAST_LEN = 1024;
constexpr int NTOK = BATCH * SEQ;
constexpr int NSTOK = DEC_BATCH * DEC_SEQ;
constexpr int IN_COLS = 7184;
constexpr int LDP = 7168;
constexpr float EPS = 1e-6f;
constexpr int LDS_BYTES = 147456;
constexpr int NPHASE = 9;

constexpr size_t WS_PROJ = 0;
constexpr size_t WS_WTIN = WS_PROJ + (size_t)NTOK * LDP * 2;
constexpr size_t WS_WTOUT = WS_WTIN + (size_t)2 * LDP * 1024 * 2;
constexpr size_t WS_GATES = WS_WTOUT + (size_t)2 * 1024 * 2048 * 2;
constexpr size_t WS_RSTD = WS_GATES + (size_t)NTOK * 16 * 4;
constexpr size_t WS_SPROJ = WS_RSTD + (size_t)NTOK * 4;
constexpr size_t WS_SGATES = WS_SPROJ + (size_t)NSTOK * LDP * 2;
constexpr size_t WS_SRSTD = WS_SGATES + (size_t)NSTOK * 16 * 4;
constexpr size_t WS_SHI = WS_SRSTD + 512;
constexpr size_t WS_SSQ = WS_SHI + (size_t)NSTOK * 1024 * 2;
constexpr size_t WS_BAR = WS_SSQ + (size_t)(NTOK + NSTOK) * 4 * 4;
constexpr size_t WS_END = WS_BAR + 16384;

constexpr size_t O_YP = 0;
constexpr size_t O_YS = O_YP + (size_t)NTOK * 1024;
constexpr size_t O_PMC = O_YS + (size_t)NSTOK * 1024;
constexpr size_t O_PMN = O_PMC + (size_t)2 * 16 * 4 * 64 * 128;
constexpr size_t O_PMM = O_PMN + (size_t)2 * 16 * 4 * 64;
constexpr size_t O_PRET = O_PMM + (size_t)2 * 16 * 4;
constexpr size_t O_PSSD = O_PRET + (size_t)2 * 16 * 4 * 64 * 128;
constexpr size_t O_PCONV = O_PSSD + (size_t)2 * 16 * 8 * 128 * 64;
constexpr size_t O_PHG = O_PCONV + (size_t)2 * 16 * 3 * 1024;
constexpr size_t O_SMC = O_PHG + (size_t)2 * 16 * 4 * 128 * 128;
constexpr size_t O_SMN = O_SMC + (size_t)2 * 8 * 4 * 64 * 128;
constexpr size_t O_SMM = O_SMN + (size_t)2 * 8 * 4 * 64;
constexpr size_t O_SRET = O_SMM + (size_t)2 * 8 * 4;
constexpr size_t O_SSSD = O_SRET + (size_t)2 * 8 * 4 * 64 * 128;
constexpr size_t O_SCONV = O_SSSD + (size_t)2 * 8 * 8 * 128 * 64;
constexpr size_t O_SHG = O_SCONV + (size_t)2 * 8 * 3 * 1024;
constexpr size_t O_END = O_SHG + (size_t)2 * 8 * 4 * 128 * 128;

struct Params {
    const float* x_prompt; const float* x_sample;
    const float* st_mc; const float* st_mn; const float* st_mm; const float* st_ret; const float* st_ssd; const float* st_conv; const float* st_hg;
    const float* norm_w; const float* w_in; const float* gate_b; const float* mnorm_w; const float* conv_w; const float* conv_b;
    const float* dt_bias; const float* a_log; const float* d_skip; const float* snorm_w; const float* lbraw; const float* hnorm_w;
    const float* w_out; const float* fnorm_w;
    float* out; unsigned char* ws;
    int ph_lo, ph_hi;
};

DI float bf2f(u16 v) { return __uint_as_float(((unsigned)v) << 16); }
typedef __bf16 bf2_t __attribute__((ext_vector_type(2)));
typedef float f2_t __attribute__((ext_vector_type(2)));
DI unsigned pk2(float a, float b) { const f2_t v = {a, b}; const bf2_t r = __builtin_convertvector(v, bf2_t); return __builtin_bit_cast(unsigned, r); }
DI u16 f2bf(float a) { return (u16)(pk2(a, 0.f) & 0xffffu); }
DI float lo16(unsigned w) { return __uint_as_float(w << 16); }
DI float hi16(unsigned w) { return __uint_as_float(w & 0xffff0000u); }
DI void unpack8(const uint4 v, float* f) {
    f[0] = lo16(v.x); f[1] = hi16(v.x); f[2] = lo16(v.y); f[3] = hi16(v.y); f[4] = lo16(v.z); f[5] = hi16(v.z); f[6] = lo16(v.w); f[7] = hi16(v.w);
}
DI uint4 pack8f(const float* f) { uint4 r; r.x = pk2(f[0], f[1]); r.y = pk2(f[2], f[3]); r.z = pk2(f[4], f[5]); r.w = pk2(f[6], f[7]); return r; }
DI bf16x8 as_frag(uint4 v) { return __builtin_bit_cast(bf16x8, v); }
DI bf16x8 pack_acc2(const f32x4 a, const f32x4 b) { uint4 r; r.x = pk2(a[0], a[1]); r.y = pk2(a[2], a[3]); r.z = pk2(b[0], b[1]); r.w = pk2(b[2], b[3]); return __builtin_bit_cast(bf16x8, r); }
DI bf16x8 ldfrag(const u16* p) { return *(const bf16x8*)p; }
DI bf16x8 ldfrag2(const u16* p) { uint2 a = *(const uint2*)p; uint2 b = *(const uint2*)(p + 16); uint4 r; r.x = a.x; r.y = a.y; r.z = b.x; r.w = b.y; return __builtin_bit_cast(bf16x8, r); }
typedef short v4s_t __attribute__((ext_vector_type(4)));
DI bf16x8 ldfrag_tr(const u16* p, const int RS) {
    const v4s_t lo = __builtin_amdgcn_ds_read_tr16_b64_v4i16((LAS v4s_t*)p);
    const v4s_t hi = __builtin_amdgcn_ds_read_tr16_b64_v4i16((LAS v4s_t*)(p + 4 * RS));
    return __builtin_shufflevector(lo, hi, 0, 1, 2, 3, 4, 5, 6, 7);
}
DI v4s_t ld_tr4(const u16* p) { return __builtin_amdgcn_ds_read_tr16_b64_v4i16((LAS v4s_t*)p); }
#define MFMA16(a, b, c) __builtin_amdgcn_mfma_f32_16x16x32_bf16((a), (b), (c), 0, 0, 0)
DI float sigmoidf_(float x) { return __builtin_amdgcn_rcpf(1.f + __expf(-x)); }
DI float siluf_(float x) { return x * __builtin_amdgcn_rcpf(1.f + __expf(-x)); }
DI float softplusf_(float x) { return fmaxf(x, 0.f) + log1pf(__expf(-fabsf(x))); }
DI float logsigf_(float x) { return fminf(x, 0.f) - log1pf(__expf(-fabsf(x))); }
DI float wscan_sum(float x, int lane) {
#pragma unroll
    for (int o = 1; o < 64; o <<= 1) { float t = __shfl_up(x, o); if (lane >= o) x += t; }
    return x;
}
DI float wscan_max(float x, int lane) {
#pragma unroll
    for (int o = 1; o < 64; o <<= 1) { float t = __shfl_up(x, o); if (lane >= o) x = fmaxf(x, t); }
    return x;
}
template <int CTRL> DI float dppf(float x) { return __builtin_bit_cast(float, __builtin_amdgcn_update_dpp(0, __builtin_bit_cast(int, x), CTRL, 0xF, 0xF, true)); }
DI float red16(float x) { x += dppf<0xB1>(x); x += dppf<0x4E>(x); x += dppf<0x141>(x); x += dppf<0x140>(x); return x; }
DI float wsum(float x) { x = red16(x); x += __shfl_xor(x, 16); x += __shfl_xor(x, 32); return x; }
DI uint4 ldg16(const u16* p) { return *(const uint4*)p; }
DI uint4 ldsel(const u16* base, unsigned off, bool ok) { const uint4 v = *(const uint4*)(base + (size_t)off); return ok ? v : make_uint4(0u, 0u, 0u, 0u); }
DI uint4 zero4() { uint4 z; z.x = z.y = z.z = z.w = 0u; return z; }

DI int src_col(int n) {
    if (n < 512) return 512 + n;
    if (n < 1024) return 2568 + (n - 512);
    if (n < 1536) return 3592 + (n - 1024);
    if (n < 2048) return 6672 + (n - 1536);
    if (n < 2304) return 0 + (n - 2048);
    if (n < 2560) return 256 + (n - 2304);
    if (n < 3072) return 1024 + (n - 2560);
    if (n < 3584) return 1536 + (n - 3072);
    if (n < 3840) return 2056 + (n - 3584);
    if (n < 4096) return 2312 + (n - 3840);
    if (n < 4608) return 3080 + (n - 4096);
    if (n < 5632) return 4104 + (n - 4608);
    if (n < 6144) return 5136 + (n - 5632);
    if (n < 6656) return 5648 + (n - 6144);
    return 6160 + (n - 6656);
}

namespace pg8 {
constexpr int BM = 256, BK = 64, HALF = 128, HTB = HALF * BK * 2, NXCD = 8, WGM = 8;
DI int lds_byte(int r, int c) { const int st = (r >> 4) * 2 + (c >> 5), rr = r & 15, cc = c & 31, ob = rr * 64 + cc * 2; return st * 1024 + (ob ^ (((ob >> 9) & 1) << 5)); }
DI void stage_rc(int b, int& R, int& C) { const int st = b / 1024, sb = b % 1024, swz = sb ^ (((sb >> 9) & 1) << 5); R = (st >> 1) * 16 + swz / 64; C = (st & 1) * 32 + (swz % 64) / 2; }
DI int perm32(int rho) { const int n = rho >> 4, i = rho & 15; return 8 * (i >> 2) + 4 * n + (i & 3); }
struct Unit { int pm, pn; };
struct Gemm { const u16* A; const u16* Bt; int M, N, K, lda; };
struct StaticOrder {
    int nM, nN, nwg, G, c;
    DI void init(int M, int N, int G_, int c_) { nM = M / BM; nN = N / BM; nwg = nM * nN; G = G_; c = c_; }
    DI bool next(int i, Unit& u) const {
        const long L = (long)i * G + c; if (L >= nwg) return false;
        int wgid = (int)L; { const int q = nwg / NXCD, r = nwg % NXCD, xcd = wgid % NXCD, off = wgid / NXCD; wgid = (xcd < r ? xcd * (q + 1) : r * (q + 1) + (xcd - r) * q) + off; }
        const int nig = WGM * nN, gid = wgid / nig, fm = gid * WGM, gsz = (nM - fm) < WGM ? (nM - fm) : WGM;
        u.pm = fm + ((wgid % nig) % gsz); u.pn = (wgid % nig) / gsz; return true;
    }
};
template <class Epi>
DI void gemm_phase(LAS unsigned char* lds, const Gemm g, const StaticOrder& S, const Epi& E, const int tid) {
    const int wid = __builtin_amdgcn_readfirstlane(tid >> 6), lane = tid & 63, wr = wid >> 2, wc = wid & 3, fr = lane & 15, fq = lane >> 4;
    const int K = g.K, nt = K / BK, lda = g.lda;
    unsigned voffA[2], voffB[2];
#pragma unroll
    for (int i = 0; i < 2; ++i) { int R, C; stage_rc(tid * 16 + i * 8192, R, C); const int Rb = (R & ~31) + perm32(R & 31);
        voffA[i] = (unsigned)(R * lda + C) * 2u; voffB[i] = (unsigned)(Rb * K + C) * 2u; }
    const size_t kstep = (size_t)(BK * 2);
    const size_t hstepA = (size_t)HALF * lda * 2, hstepB = (size_t)HALF * K * 2;
    const size_t tstepA = 2 * hstepA, tstepB = 2 * hstepB;
    const unsigned ldsw = (unsigned)wid * 1024u;
    const int aoff = lds_byte(wr * 64 + fr, fq * 8), boff = lds_byte(wc * 32 + fr, fq * 8);
#define PG8_SA(b, h) (((b) * 2 + (h)) * HTB)
#define PG8_SB(b, h) ((4 + (b) * 2 + (h)) * HTB)
#define PG8_STAGE(bufoff, gbase, voff) do { _Pragma("unroll") for (int _i = 0; _i < 2; ++_i) \
        __builtin_amdgcn_global_load_lds((const unsigned*)((const char*)(gbase) + (voff)[_i]), (LAS unsigned*)(lds + (bufoff) + ldsw + _i * 8192), 16, 0, 0); } while (0)
#define PG8_LDA(dst, b, h) do { _Pragma("unroll") for (int m = 0; m < 4; ++m) _Pragma("unroll") for (int k = 0; k < 2; ++k) dst[m][k] = *(const LAS bf16x8*)(lds + PG8_SA(b, h) + aoff + m * 2048 + k * 1024); } while (0)
#define PG8_LDB(dst, b, h) do { _Pragma("unroll") for (int n = 0; n < 2; ++n) _Pragma("unroll") for (int k = 0; k < 2; ++k) dst[n][k] = *(const LAS bf16x8*)(lds + PG8_SB(b, h) + boff + n * 2048 + k * 1024); } while (0)
#define PG8_MMA(ai, bj, At, Bt) do { __builtin_amdgcn_s_setprio(1); _Pragma("unroll") for (int m = 0; m < 4; ++m) _Pragma("unroll") for (int n = 0; n < 2; ++n) _Pragma("unroll") for (int k = 0; k < 2; ++k) \
        acc[ai][bj][m][n] = __builtin_amdgcn_mfma_f32_16x16x32_bf16(Bt[n][k], At[m][k], acc[ai][bj][m][n], 0, 0, 0); __builtin_amdgcn_s_setprio(0); } while (0)
#define PG8_WAIT_V(n) asm volatile("s_waitcnt vmcnt(" #n ")" ::: "memory")
#define PG8_WAIT_L(n) asm volatile("s_waitcnt lgkmcnt(" #n ")" ::: "memory")
#define PG8_BAR __builtin_amdgcn_s_barrier()
#define PG8_SCHED __builtin_amdgcn_sched_barrier(0)
    Unit cur, nxt; int ui = 0;
    if (!S.next(0, cur)) return;
    f32x4 acc[2][2][4][2];
#pragma unroll
    for (int a = 0; a < 2; ++a)
#pragma unroll
        for (int b = 0; b < 2; ++b)
#pragma unroll
            for (int m = 0; m < 4; ++m)
#pragma unroll
                for (int n = 0; n < 2; ++n) acc[a][b][m][n] = (f32x4){0.f, 0.f, 0.f, 0.f};
    bf16x8 At[4][2], B0[2][2], B1[2][2];
    const char* cA = (const char*)g.A + (size_t)cur.pm * tstepA; const char* cB = (const char*)g.Bt + (size_t)cur.pn * tstepB;
    PG8_STAGE(PG8_SB(0, 0), cB, voffB); PG8_STAGE(PG8_SA(0, 0), cA, voffA); PG8_STAGE(PG8_SB(0, 1), cB + hstepB, voffB); PG8_STAGE(PG8_SA(0, 1), cA + hstepA, voffA);
    if (wr == 1) PG8_BAR;
    PG8_WAIT_V(4); PG8_BAR;
    PG8_STAGE(PG8_SB(1, 0), cB + kstep, voffB); PG8_STAGE(PG8_SA(1, 0), cA + kstep, voffA); PG8_STAGE(PG8_SB(1, 1), cB + hstepB + kstep, voffB);
    PG8_WAIT_V(6); PG8_BAR;
    for (;;) {
        const bool has_next = S.next(ui + 1, nxt);
        const char* nA = has_next ? (const char*)g.A + (size_t)nxt.pm * tstepA : cA; const char* nB = has_next ? (const char*)g.Bt + (size_t)nxt.pn * tstepB : cB;
        for (int t = 0; t < nt; t += 2) {
            const bool last = (t == nt - 2);
            const char* a1 = cA + (size_t)(t + 1) * kstep;
            const char* a2 = last ? nA : cA + (size_t)(t + 2) * kstep; const char* b2 = last ? nB : cB + (size_t)(t + 2) * kstep;
            const char* a3 = a2 + kstep; const char* b3 = b2 + kstep;
            PG8_LDB(B0, 0, 0); PG8_SCHED; PG8_LDA(At, 0, 0); PG8_STAGE(PG8_SA(1, 1), a1 + hstepA, voffA);
            PG8_WAIT_L(8); PG8_BAR; PG8_WAIT_L(0); PG8_MMA(0, 0, At, B0); PG8_BAR; PG8_SCHED;
            PG8_LDB(B1, 0, 1); PG8_STAGE(PG8_SB(0, 0), b2, voffB);
            PG8_BAR; PG8_WAIT_L(0); PG8_MMA(0, 1, At, B1); PG8_BAR;
            PG8_LDA(At, 0, 1); PG8_STAGE(PG8_SA(0, 0), a2, voffA);
            PG8_BAR; PG8_WAIT_L(0); PG8_MMA(1, 0, At, B0); PG8_BAR; PG8_SCHED;
            PG8_STAGE(PG8_SB(0, 1), b2 + hstepB, voffB);
            PG8_WAIT_V(6); PG8_BAR; PG8_MMA(1, 1, At, B1); PG8_BAR;
            PG8_LDB(B0, 1, 0); PG8_SCHED; PG8_LDA(At, 1, 0); PG8_STAGE(PG8_SA(0, 1), a2 + hstepA, voffA);
            PG8_WAIT_L(8); PG8_BAR; PG8_WAIT_L(0); PG8_MMA(0, 0, At, B0); PG8_BAR; PG8_SCHED;
            PG8_LDB(B1, 1, 1); PG8_STAGE(PG8_SB(1, 0), b3, voffB);
            PG8_BAR; PG8_WAIT_L(0); PG8_MMA(0, 1, At, B1); PG8_BAR;
            PG8_LDA(At, 1, 1); PG8_STAGE(PG8_SA(1, 0), a3, voffA);
            PG8_BAR; PG8_WAIT_L(0); PG8_MMA(1, 0, At, B0); PG8_BAR; PG8_SCHED;
            PG8_STAGE(PG8_SB(1, 1), b3 + hstepB, voffB);
            PG8_WAIT_V(6); PG8_BAR; PG8_MMA(1, 1, At, B1); PG8_BAR;
        }
        E(acc, cur, wr, wc, fr, fq);
        if (!has_next) break;
#pragma unroll
        for (int a = 0; a < 2; ++a)
#pragma unroll
            for (int b = 0; b < 2; ++b)
#pragma unroll
                for (int m = 0; m < 4; ++m)
#pragma unroll
                    for (int n = 0; n < 2; ++n) acc[a][b][m][n] = (f32x4){0.f, 0.f, 0.f, 0.f};
        cur = nxt; cA = nA; cB = nB; ++ui;
    }
    PG8_WAIT_V(0);
    if (wr == 0) PG8_BAR;
    PG8_BAR;
#undef PG8_SA
#undef PG8_SB
#undef PG8_STAGE
#undef PG8_LDA
#undef PG8_LDB
#undef PG8_MMA
#undef PG8_WAIT_V
#undef PG8_WAIT_L
#undef PG8_BAR
#undef PG8_SCHED
}
struct EpiIn {
    u16* O; const float* rstd;
    DI void operator()(const f32x4 (&acc)[2][2][4][2], const Unit& u, int wr, int wc, int fr, int fq) const {
        const int row0 = u.pm * BM + wr * 64 + fr, col0 = u.pn * BM + wc * 32 + 8 * fq;
#pragma unroll
        for (int ai = 0; ai < 2; ++ai)
#pragma unroll
            for (int m = 0; m < 4; ++m) {
                const int r = row0 + ai * HALF + m * 16; const float rs = rstd[r];
                u16* rowp = O + (size_t)r * LDP + col0;
#pragma unroll
                for (int bj = 0; bj < 2; ++bj) {
                    const f32x4 a0 = acc[ai][bj][m][0], a1 = acc[ai][bj][m][1];
                    uint4 v; v.x = pk2(a0[0] * rs, a0[1] * rs); v.y = pk2(a0[2] * rs, a0[3] * rs); v.z = pk2(a1[0] * rs, a1[1] * rs); v.w = pk2(a1[2] * rs, a1[3] * rs);
                    *(uint4*)(rowp + bj * HALF) = v;
                }
            }
    }
};
struct EpiOut {
    u16* Xhi; u16* Xlo; const float* xin; u16* projdead; bool last;
    DI void operator()(const f32x4 (&acc)[2][2][4][2], const Unit& u, int wr, int wc, int fr, int fq) const {
        const int row0 = u.pm * BM + wr * 64 + fr, col0 = u.pn * BM + wc * 32 + 8 * fq;
#pragma unroll
        for (int ai = 0; ai < 2; ++ai)
#pragma unroll
            for (int m = 0; m < 4; ++m) {
                const int r = row0 + ai * HALF + m * 16;
#pragma unroll
                for (int bj = 0; bj < 2; ++bj) {
                    const size_t o = (size_t)r * 2048 + col0 + bj * HALF; const size_t oi = (size_t)r * 1024 + col0 + bj * HALF;
                    float res[8];
                    if (xin) { const float4 x0 = *(const float4*)(xin + oi), x1 = *(const float4*)(xin + oi + 4);
                        res[0] = x0.x; res[1] = x0.y; res[2] = x0.z; res[3] = x0.w; res[4] = x1.x; res[5] = x1.y; res[6] = x1.z; res[7] = x1.w; }
                    else { float h8[8], l8[8]; unpack8(*(const uint4*)(Xhi + o), h8); unpack8(*(const uint4*)(Xlo + o), l8);
#pragma unroll
                        for (int e = 0; e < 8; ++e) res[e] = h8[e] + l8[e]; }
                    const f32x4 a0 = acc[ai][bj][m][0], a1 = acc[ai][bj][m][1];
                    float xn[8], lo[8];
#pragma unroll
                    for (int e = 0; e < 4; ++e) { xn[e] = res[e] + a0[e]; xn[4 + e] = res[4 + e] + a1[e]; }
                    if (last) {
                        float* dp = (float*)(projdead + (size_t)r * LDP + 2048) + col0 + bj * HALF;
                        *(float4*)dp = make_float4(xn[0], xn[1], xn[2], xn[3]); *(float4*)(dp + 4) = make_float4(xn[4], xn[5], xn[6], xn[7]);
                    } else {
                        const uint4 hv = pack8f(xn); float hb[8]; unpack8(hv, hb);
#pragma unroll
                        for (int e = 0; e < 8; ++e) lo[e] = xn[e] - hb[e];
                        *(uint4*)(Xhi + o) = hv; *(uint4*)(Xlo + o) = pack8f(lo);
                    }
                }
            }
    }
};
}

DI void convert_weights(const Params& p, float* sm, const int tid) {
    const int NT_IN = 112 * 16, NT_OUT = 16 * 32;
    const int total = 2 * (NT_IN + NT_OUT);
    for (int t = blockIdx.x; t < total; t += gridDim.x) {
        const int l = t / (NT_IN + NT_OUT); int tt = t % (NT_IN + NT_OUT);
        const float* W; u16* Wt; int Ksz, ldw, n0, k0, s0; const float* sc;
        if (tt < NT_IN) { const int nt_ = tt / 16, kt = tt % 16; n0 = nt_ * 64; k0 = kt * 64; W = p.w_in + (size_t)l * 1024 * IN_COLS; ldw = IN_COLS; s0 = src_col(n0);
            Wt = (u16*)(p.ws + WS_WTIN) + (size_t)l * LDP * 1024; Ksz = 1024; sc = p.norm_w + l * 1024; }
        else { tt -= NT_IN; const int nt_ = tt / 32, kt = tt % 32; n0 = nt_ * 64; k0 = kt * 64; W = p.w_out + (size_t)l * 2048 * 1024; ldw = 1024; s0 = n0;
            Wt = (u16*)(p.ws + WS_WTOUT) + (size_t)l * 1024 * 2048; Ksz = 2048; sc = nullptr; }
        {
            const int kr = tid >> 3, c8 = (tid & 7) * 8;
            const float* src = W + (size_t)(k0 + kr) * ldw + s0 + c8;
            const float s = sc ? sc[k0 + kr] : 1.f;
#pragma unroll
            for (int e = 0; e < 8; ++e) sm[kr * 65 + c8 + e] = src[e] * s;
        }
        __syncthreads();
        {
            const int nr = tid >> 3, k8 = (tid & 7) * 8; float f[8];
#pragma unroll
            for (int e = 0; e < 8; ++e) f[e] = sm[(k8 + e) * 65 + nr];
            *(uint4*)(Wt + (size_t)(n0 + nr) * Ksz + k0 + k8) = pack8f(f);
        }
        __syncthreads();
    }
}

template <int MODE>
DI void prep_rows(const float* xf, u16* xh, int nrows, u16* hi, int hstride, bool whi, float* rstd, float* gates, float* copyf, const float* wg  , int gw, int ngw, int lane) {
    for (int r = gw; r < nrows; r += ngw) {
        float x[16];
#pragma unroll
        for (int i = 0; i < 4; ++i) {
            const int k = i * 256 + lane * 4;
            if (MODE == 0) { const float4 v = *(const float4*)(xf + (size_t)r * 1024 + k); x[4 * i] = v.x; x[4 * i + 1] = v.y; x[4 * i + 2] = v.z; x[4 * i + 3] = v.w;
                if (copyf) *(float4*)(copyf + (size_t)r * 1024 + k) = v; }
            else { const uint2 h = *(const uint2*)(xh + (size_t)r * 2048 + k), lo = *(const uint2*)(xh + (size_t)r * 2048 + 1024 + k);
                x[4 * i] = lo16(h.x) + lo16(lo.x); x[4 * i + 1] = hi16(h.x) + hi16(lo.x); x[4 * i + 2] = lo16(h.y) + lo16(lo.y); x[4 * i + 3] = hi16(h.y) + hi16(lo.y); }
        }
        float ss = 0.f;
#pragma unroll
        for (int i = 0; i < 16; ++i) ss += x[i] * x[i];
        ss = wsum(ss);
        const float rs = rsqrtf(ss * (1.f / 1024.f) + EPS);
        if (whi) {
#pragma unroll
            for (int i = 0; i < 4; ++i) { uint2 v; v.x = pk2(x[4 * i], x[4 * i + 1]); v.y = pk2(x[4 * i + 2], x[4 * i + 3]); *(uint2*)(hi + (size_t)r * hstride + i * 256 + lane * 4) = v; }
        }
        float acc[16];
        {
            int ln = lane; OPQ(ln);
#pragma unroll
            for (int j = 0; j < 16; ++j) {
                float a = 0.f;
#pragma unroll
                for (int i = 0; i < 4; ++i) { const f32x4 w = *(const f32x4*)(wg + j * 1024 + i * 256 + ln * 4); a += x[4 * i] * w[0] + x[4 * i + 1] * w[1] + x[4 * i + 2] * w[2] + x[4 * i + 3] * w[3]; }
                acc[j] = a;
            }
        }
        float b8[8], b4[4], b2[2], b1;
        { const bool h = (lane & 1) != 0;
#pragma unroll
          for (int i = 0; i < 8; ++i) { const float snd = h ? acc[i] : acc[i + 8], kp = h ? acc[i + 8] : acc[i]; b8[i] = kp + __shfl_xor(snd, 1); } }
        { const bool h = (lane & 2) != 0;
#pragma unroll
          for (int i = 0; i < 4; ++i) { const float snd = h ? b8[i] : b8[i + 4], kp = h ? b8[i + 4] : b8[i]; b4[i] = kp + __shfl_xor(snd, 2); } }
        { const bool h = (lane & 4) != 0;
#pragma unroll
          for (int i = 0; i < 2; ++i) { const float snd = h ? b4[i] : b4[i + 2], kp = h ? b4[i + 2] : b4[i]; b2[i] = kp + __shfl_xor(snd, 4); } }
        { const bool h = (lane & 8) != 0; const float snd = h ? b2[0] : b2[1], kp = h ? b2[1] : b2[0]; b1 = kp + __shfl_xor(snd, 8); }
        b1 += __shfl_xor(b1, 16); b1 += __shfl_xor(b1, 32);
        const int jg = ((lane & 1) << 3) | ((lane & 2) << 1) | ((lane & 4) >> 1) | ((lane & 8) >> 3);
        if (lane < 16) gates[(size_t)r * 16 + jg] = b1 * rs;
        if (lane == 0) rstd[r] = rs;
    }
}
DI void build_wg(const Params& p, int l, float* wg, const int tid) {
    for (int idx = tid; idx < 16 * 1024; idx += 512) {
        const int k = idx >> 4, j = idx & 15;
        const int col = j < 8 ? 2048 + j : 5128 + (j - 8);
        wg[j * 1024 + k] = p.norm_w[l * 1024 + k] * p.w_in[((size_t)l * 1024 + k) * IN_COLS + col];
    }
}

template <int MODE>
DI void sample_gemm(const u16* A, int lda, const u16* Bt, int N, int K, int gw, int ngw, int lane, u16* sproj, const float* srstd, const float* resid, float* ys) {
    const int fr = lane & 15, fq = lane >> 4;
    const int ntasks = 8 * (N / 16);
    for (int t = gw; t < ntasks; t += ngw) {
        const int rt = t & 7, ct = t >> 3;
        const u16* ap = A + (size_t)(rt * 16 + fr) * lda + 8 * fq;
        const u16* bp = Bt + (size_t)(ct * 16 + fr) * K + 8 * fq;
        f32x4 acc = (f32x4){0.f, 0.f, 0.f, 0.f};
#pragma unroll 16
        for (int k = 0; k < K; k += 32) acc = MFMA16(as_frag(ldg16(ap + k)), as_frag(ldg16(bp + k)), acc);
#pragma unroll
        for (int j = 0; j < 4; ++j) {
            const int r = rt * 16 + 4 * fq + j, c = ct * 16 + fr;
            if (MODE == 0) sproj[(size_t)r * LDP + c] = f2bf(acc[j] * srstd[r]);
            else ys[(size_t)r * 1024 + c] = resid[(size_t)r * 1024 + c] + acc[j];
        }
    }
}

template <int MODE, int NV>
DI void chain_mr(unsigned char* sm, const int ht_o, const int hw, const int lane_o, u16* seq, const float* gates,
                 const int nch, const int pos0, const int h,
                 const float* initC, const float* initN, const float* initM, float* outC, float* outN, float* outM,
                 const float* normw, const float gbi, const float gbf) {
    constexpr int nvalid = NV;
    const int fr_o = lane_o & 15, fq_o = lane_o >> 4;
    const int fr = fr_o, fq = fq_o, ht = ht_o, lane = lane_o;
    u16* sQ = (u16*)sm; u16* sK = (u16*)(sm + 9216); u16* sKW = (u16*)(sm + 18432); u16* sV = (u16*)(sm + 27648); u16* sP = (u16*)(sm + 45056);
    u16* sH = (u16*)sm;
    float* fb = (float*)(sm + 54272);
    float* sCV = fb; float* sMV = fb + 64; float* sWI = fb + 128; float* sEMT = fb + 192; float* sDA = fb + 256; float* sDB = fb + 320; float* sN = fb + 384;
    float* sSQ = fb + 448; float* sSM = fb + 704;
    const int qoff = MODE == 0 ? 2048 + h * 64 : 3584 + h * 64;
    const int koff = MODE == 0 ? 2304 + h * 64 : 3840 + h * 64;
    const int voff = MODE == 0 ? h * 128 : 512 + h * 128;
    const int g1off = MODE == 0 ? 2560 + h * 128 : 4096 + h * 128;
    const int g2off = 3072 + h * 128;
    const float lg = log1pf(-exp2f(-5.f - (float)h));

    f32x4 Cacc[4][2];
#pragma unroll
    for (int m = 0; m < 4; ++m)
#pragma unroll
        for (int n = 0; n < 2; ++n)
#pragma unroll
            for (int j = 0; j < 4; ++j) { const int k = 16 * m + 4 * fq + j, v = 32 * hw + 16 * n + fr; Cacc[m][n][j] = initC ? initC[k * 128 + v] : 0.f; }
    if (MODE == 0 && ht < 64) sN[ht] = initN ? initN[ht] : 0.f;
    float mprev = (MODE == 0) ? (initM ? initM[0] : -1e30f) : 0.f;
    float frq[8];
    if (MODE == 1) {
#pragma unroll
        for (int e = 0; e < 8; ++e) { const int j = (lane & 3) * 8 + e; frq[e] = exp2f(-(float)j * (13.287712379549449f / 32.f)) * 0.15915494309189535f; }
    }
    const int qrow = ht >> 3, qcol = (ht & 7) * 8;
    uint4 pq[2], pk[2], pv[4], pg1[4], pg2[4]; float gi = 0.f, gf = 0.f;
#define MR_OFFQ(i) ((unsigned)((((i) * 32 + (ht >> 3)) < nvalid ? ((i) * 32 + (ht >> 3)) : 0) * LDP + qoff + (ht & 7) * 8))
#define MR_OKQ(i) (((i) * 32 + (ht >> 3)) < nvalid)
#define MR_OFFV(i) ((unsigned)((((i) * 16 + (ht >> 4)) < nvalid ? ((i) * 16 + (ht >> 4)) : 0) * LDP + voff + (ht & 15) * 8))
#define MR_OKV(i) (((i) * 16 + (ht >> 4)) < nvalid)
#define MR_LOAD(c) do { const u16* cb_ = seq + (size_t)(c) * 64 * LDP; \
        _Pragma("unroll") for (int i = 0; i < 2; ++i) { pq[i] = ldsel(cb_, MR_OFFQ(i), MR_OKQ(i)); pk[i] = ldsel(cb_ + (koff - qoff), MR_OFFQ(i), MR_OKQ(i)); } \
        _Pragma("unroll") for (int i = 0; i < 4; ++i) pv[i] = ldsel(cb_, MR_OFFV(i), MR_OKV(i)); \
        if (MODE == 0) { const float* gp = gates + (size_t)(c) * 64 * 16; const unsigned og_ = (unsigned)((lane < nvalid ? lane : 0) * 16 + h); gi = gp[og_]; gf = gp[og_ + 4]; } } while (0)
    MR_LOAD(0);
    __syncthreads();
    for (int c = 0; c < nch; ++c) {
        int fr = fr_o, fq = fq_o, ht = ht_o, lane = lane_o; OPQ(fr); OPQ(fq); OPQ(ht); OPQ(lane);
        const int qrow = ht >> 3, qcol = (ht & 7) * 8;
        float wk_l, wc, mnew = 0.f;
        if (MODE == 0) {
            const float ig = (lane < nvalid) ? gi + gbi : -1e30f;
            const float lf = (lane < nvalid) ? logsigf_(gf + gbf) : 0.f;
            const float b = wscan_sum(lf, lane);
            const float cval = ig - b;
            const float pm = wscan_max(cval, lane);
            const float Ml = fmaxf(mprev, pm);
            const float blast = __shfl(b, 63), M63 = __shfl(Ml, 63);
            wk_l = __expf(cval - M63); wc = __expf(mprev - M63); mnew = blast + M63;
            if (hw == 0) { sCV[lane] = cval; sMV[lane] = Ml; sWI[lane] = __expf(mprev - Ml); sEMT[lane] = __expf(-(b + Ml)); }
        } else {
            wk_l = (lane < nvalid) ? __expf((float)(nvalid - 1 - lane) * lg) : 0.f; wc = __expf((float)nvalid * lg);
            if (hw == 0) sWI[lane] = __expf((float)(lane + 1) * lg);
        }
#pragma unroll
        for (int i = 0; i < 2; ++i) {
            const int row = i * 32 + qrow;
            float kf[8];
            if (MODE == 1) {
                float qf[8], qp[8], kp[8];
                uint4 qv = pq[i], kv = pk[i], qo, ko;
                qo.x = __shfl_xor(qv.x, 4); qo.y = __shfl_xor(qv.y, 4); qo.z = __shfl_xor(qv.z, 4); qo.w = __shfl_xor(qv.w, 4);
                ko.x = __shfl_xor(kv.x, 4); ko.y = __shfl_xor(kv.y, 4); ko.z = __shfl_xor(kv.z, 4); ko.w = __shfl_xor(kv.w, 4);
                unpack8(qv, qf); unpack8(kv, kf); unpack8(qo, qp); unpack8(ko, kp);
                const float sgn = (lane & 4) ? 1.f : -1.f;
                const float pos = (float)(pos0 + c * 64 + row);
#pragma unroll
                for (int e = 0; e < 8; ++e) {
                    float t = pos * frq[e]; t = t - rintf(t);
                    const float cs = __builtin_amdgcn_cosf(t), sn = __builtin_amdgcn_sinf(t);
                    qf[e] = qf[e] * cs + sgn * qp[e] * sn; kf[e] = kf[e] * cs + sgn * kp[e] * sn;
                }
                *(uint4*)(sQ + row * 72 + qcol) = pack8f(qf); *(uint4*)(sK + row * 72 + qcol) = pack8f(kf);
            } else {
                *(uint4*)(sQ + row * 72 + qcol) = pq[i]; *(uint4*)(sK + row * 72 + qcol) = pk[i];
                unpack8(pk[i], kf);
            }
            const float wkr = __shfl(wk_l, row);
#pragma unroll
            for (int e = 0; e < 8; ++e) kf[e] *= wkr;
            *(uint4*)(sKW + row * 72 + qcol) = pack8f(kf);
            __builtin_amdgcn_sched_barrier(0);
        }
#pragma unroll
        for (int i = 0; i < 4; ++i) {
            const int id = i * 256 + ht, row = id >> 4, col = (id & 15) * 8;
            *(uint4*)(sV + row * 136 + col) = pv[i];
        }
        LBAR(); OPQ(fr); OPQ(fq); OPQ(ht); OPQ(lane);
        if (c + 1 < nch) MR_LOAD(c + 1);
        { const u16* cb_ = seq + (size_t)c * 64 * LDP;
#pragma unroll
        for (int i = 0; i < 4; ++i) { pg1[i] = ldsel(cb_ + (g1off - voff), MR_OFFV(i), MR_OKV(i)); if (MODE == 0) pg2[i] = ldsel(cb_ + (g2off - voff), MR_OFFV(i), MR_OKV(i)); } }
        f32x4 O[4][2];
#pragma unroll
        for (int m = 0; m < 4; ++m)
#pragma unroll
            for (int n = 0; n < 2; ++n) O[m][n] = (f32x4){0.f, 0.f, 0.f, 0.f};
#pragma unroll
        for (int t = 0; t < 2; ++t) {
            bf16x8 Bf[2];
#pragma unroll
            for (int n = 0; n < 2; ++n) Bf[n] = pack_acc2(Cacc[2 * t][n], Cacc[2 * t + 1][n]);
#pragma unroll
            for (int m = 0; m < 4; ++m) { const bf16x8 A = ldfrag2(sQ + (16 * m + fr) * 72 + 32 * t + 4 * fq);
#pragma unroll
                for (int n = 0; n < 2; ++n) O[m][n] = MFMA16(A, Bf[n], O[m][n]); }
        }
#pragma unroll
        for (int m = 0; m < 4; ++m) { const f32x4 w4 = *(const f32x4*)(sWI + 16 * m + 4 * fq);
#pragma unroll
            for (int n = 0; n < 2; ++n)
#pragma unroll
                for (int j = 0; j < 4; ++j) O[m][n][j] *= 0.125f * w4[j]; }
        {
            const f32x4 M4 = (MODE == 0) ? *(const f32x4*)(sMV + 16 * hw + 4 * fq) : (f32x4){0.f, 0.f, 0.f, 0.f};
            float rsum[4] = {0.f, 0.f, 0.f, 0.f};
#pragma unroll
            for (int n = 0; n < 4; ++n) {
                if (n <= hw) {
                    f32x4 S = (f32x4){0.f, 0.f, 0.f, 0.f};
#pragma unroll
                    for (int t = 0; t < 2; ++t) S = MFMA16(ldfrag(sQ + (16 * hw + fr) * 72 + 32 * t + 8 * fq), ldfrag(sK + (16 * n + fr) * 72 + 32 * t + 8 * fq), S);
                    const int s = 16 * n + fr; const float cs = (MODE == 0) ? sCV[s] : 0.f;
#pragma unroll
                    for (int j = 0; j < 4; ++j) {
                        const int l = 16 * hw + 4 * fq + j;
                        float w;
                        if (MODE == 0) w = (s <= l) ? 0.125f * __expf(cs - M4[j]) : 0.f; else w = (s <= l) ? 0.125f * __expf((float)(l - s) * lg) : 0.f;
                        const float pp = S[j] * w; rsum[j] += pp; sP[l * 72 + s] = f2bf(pp);
                    }
                } else {
#pragma unroll
                    for (int j = 0; j < 4; ++j) sP[(16 * hw + 4 * fq + j) * 72 + 16 * n + fr] = 0;
                }
            }
            if (MODE == 0) {
#pragma unroll
                for (int j = 0; j < 4; ++j) { const float r = red16(rsum[j]); if (fr == 0) sDA[16 * hw + 4 * fq + j] = r; }
            }
        }
        float nn = 0.f;
        if (MODE == 0) {
            const int l = ht >> 2, part = ht & 3; float a = 0.f, b2 = 0.f;
#pragma unroll
            for (int e = 0; e < 16; ++e) { a += bf2f(sQ[l * 72 + part * 16 + e]) * sN[part * 16 + e]; b2 += bf2f(sKW[(part * 16 + e) * 72 + l]); }
            a += __shfl_xor(a, 1); a += __shfl_xor(a, 2); b2 += __shfl_xor(b2, 1); b2 += __shfl_xor(b2, 2);
            if (part == 0) sDB[l] = 0.125f * a;
            nn = wc * sN[l] + b2;
        }
        LBAR(); OPQ(fr); OPQ(fq); OPQ(ht); OPQ(lane);
        if (MODE == 0 && (ht & 3) == 0) sN[ht >> 2] = nn;
#pragma unroll
        for (int m = 0; m < 4; ++m)
#pragma unroll
            for (int n = 0; n < 2; ++n)
#pragma unroll
                for (int j = 0; j < 4; ++j) Cacc[m][n][j] *= wc;
#pragma unroll
        for (int t = 0; t < 2; ++t) {
            bf16x8 Bv[2];
#pragma unroll
            for (int n = 0; n < 2; ++n) Bv[n] = ldfrag_tr(sV + (32 * t + 8 * fq + ((fr >> 2) & 3)) * 136 + 32 * hw + 16 * n + 4 * (fr & 3), 136);
#pragma unroll
            for (int m = 0; m < 4; ++m) { const bf16x8 Ap = ldfrag(sP + (16 * m + fr) * 72 + 32 * t + 8 * fq); const bf16x8 Ak = ldfrag_tr(sKW + (32 * t + 8 * fq + ((fr >> 2) & 3)) * 72 + 16 * m + 4 * (fr & 3), 72);
#pragma unroll
                for (int n = 0; n < 2; ++n) { O[m][n] = MFMA16(Ap, Bv[n], O[m][n]); Cacc[m][n] = MFMA16(Ak, Bv[n], Cacc[m][n]); } }
        }
#pragma unroll
        for (int m = 0; m < 4; ++m) {
            f32x4 dn = (f32x4){1.f, 1.f, 1.f, 1.f};
            if (MODE == 0) { const f32x4 da = *(const f32x4*)(sDA + 16 * m + 4 * fq), db = *(const f32x4*)(sDB + 16 * m + 4 * fq), wi = *(const f32x4*)(sWI + 16 * m + 4 * fq), em = *(const f32x4*)(sEMT + 16 * m + 4 * fq);
#pragma unroll
                for (int j = 0; j < 4; ++j) dn[j] = __builtin_amdgcn_rcpf(fmaxf(fabsf(da[j] + wi[j] * db[j]), em[j])); }
#pragma unroll
            for (int j = 0; j < 4; ++j) {
                const int l = 16 * m + 4 * fq + j;
                const float h0 = O[m][0][j] * dn[j], h1 = O[m][1][j] * dn[j];
                float sq = h0 * h0 + h1 * h1, su = h0 + h1;
                sq = red16(sq); if (MODE == 1) su = red16(su);
                if (fr == 0) { sSQ[hw * 64 + l] = sq; if (MODE == 1) sSM[hw * 64 + l] = su; }
                sH[l * 136 + 32 * hw + fr] = f2bf(h0); sH[l * 136 + 32 * hw + 16 + fr] = f2bf(h1);
            }
        }
        LBAR(); OPQ(fr); OPQ(fq); OPQ(ht); OPQ(lane);
#pragma unroll
        for (int i = 0; i < 4; ++i) {
            const int id = i * 256 + ht, row = id >> 4, col = (id & 15) * 8;
            if (row < nvalid) {
                const float ssq = sSQ[row] + sSQ[64 + row] + sSQ[128 + row] + sSQ[192 + row];
                float hv[8], g1[8], o[8]; unpack8(*(const uint4*)(sH + row * 136 + col), hv); unpack8(pg1[i], g1);
                if (MODE == 0) {
                    float g2[8]; unpack8(pg2[i], g2);
                    const float rs = rsqrtf(ssq * (1.f / 128.f) + EPS);
#pragma unroll
                    for (int e = 0; e < 8; ++e) o[e] = hv[e] * rs * normw[col + e] * sigmoidf_(g1[e]) * siluf_(g2[e]);
                } else {
                    const float mean = (sSM[row] + sSM[64 + row] + sSM[128 + row] + sSM[192 + row]) * (1.f / 128.f);
                    const float var = fmaxf(ssq * (1.f / 128.f) - mean * mean, 0.f);
                    const float rs = rsqrtf(var + EPS);
#pragma unroll
                    for (int e = 0; e < 8; ++e) o[e] = (hv[e] - mean) * rs * siluf_(g1[e]);
                }
                *(uint4*)(seq + (size_t)c * 64 * LDP + (size_t)MR_OFFV(i)) = pack8f(o);
            }
            __builtin_amdgcn_sched_barrier(0);
        }
        mprev = mnew;
        LBAR(); OPQ(fr); OPQ(fq); OPQ(ht); OPQ(lane);
    }
#undef MR_LOAD
#undef MR_OFFQ
#undef MR_OKQ
#undef MR_OFFV
#undef MR_OKV
    OPQS(outC); OPQS(outN); OPQS(outM);
#pragma unroll
    for (int m = 0; m < 4; ++m)
#pragma unroll
        for (int n = 0; n < 2; ++n)
#pragma unroll
            for (int j = 0; j < 4; ++j) { const int k = 16 * m + 4 * fq + j, v = 32 * hw + 16 * n + fr; outC[k * 128 + v] = Cacc[m][n][j]; }
    if (MODE == 0) { if (ht < 64) outN[ht] = sN[ht]; if (ht == 0) outM[0] = mprev; }
}

template <int NV>
DI void chain_hgrn(unsigned char* sm, const int tid_o, const int w, const int lane_o, u16* seq, const int nch, const int h,
                   const float* lbraw, const int layer, const float* initS, float* outS, const float* normw) {
    constexpr int nvalid = NV;
    const int fr_o = lane_o & 15, fq_o = lane_o >> 4;
    const int fr = fr_o, fq = fq_o, tid = tid_o;
    float* LFB = (float*)sm;
    u16* sQ = (u16*)(sm + 33792); u16* sK = (u16*)(sm + 51200); u16* sKW = (u16*)(sm + 68608); u16* sV = (u16*)(sm + 86016); u16* sP = (u16*)(sm + 103424);
    u16* sH = sQ;
    float* TOT = (float*)(sm + 112640); float* BLAST = (float*)(sm + 114688); float* DEC = (float*)(sm + 115200); float* SSQ = (float*)(sm + 115712);
    const int qoff = 5632 + h * 128, foff = 6144 + h * 128, ioff = 6656 + h * 128, goff = 1536 + h * 128;
    const int k0 = (tid & 15) * 8;
    float lbv[8];
#pragma unroll
    for (int e = 0; e < 8; ++e) { const int cidx = h * 128 + k0 + e; lbv[e] = (float)layer * sigmoidf_(lbraw[512 + cidx] - lbraw[cidx]); }
    f32x4 Sacc[8];
#pragma unroll
    for (int m = 0; m < 8; ++m)
#pragma unroll
        for (int j = 0; j < 4; ++j) Sacc[m][j] = initS ? initS[(16 * m + 4 * fq + j) * 128 + 16 * w + fr] : 0.f;
    uint4 phq[2], phf[2], phi[2], pg[2];
#define HG_OFF(i) ((unsigned)((((i) * 32 + (tid >> 4)) < nvalid ? ((i) * 32 + (tid >> 4)) : 0) * LDP + qoff + (tid & 15) * 8))
#define HG_OK(i) (((i) * 32 + (tid >> 4)) < nvalid)
#define HG_LOAD(c) do { const u16* cb_ = seq + (size_t)(c) * 64 * LDP; _Pragma("unroll") for (int i = 0; i < 2; ++i) { \
        phq[i] = ldsel(cb_, HG_OFF(i), HG_OK(i)); phf[i] = ldsel(cb_ + (foff - qoff), HG_OFF(i), HG_OK(i)); phi[i] = ldsel(cb_ + (ioff - qoff), HG_OFF(i), HG_OK(i)); } } while (0)
    HG_LOAD(0);
    __syncthreads();
    for (int c = 0; c < nch; ++c) {
        int fr = fr_o, fq = fq_o, tid = tid_o; OPQ(fr); OPQ(fq); OPQ(tid);
        const int k0 = (tid & 15) * 8;
        float qf[2][8], kk[2][8];
#pragma unroll
        for (int i = 0; i < 2; ++i) {
            const int row = (i * 512 + tid) >> 4;
            float hf[8], lf[8]; unpack8(phq[i], qf[i]); unpack8(phf[i], hf);
#pragma unroll
            for (int e = 0; e < 8; ++e) {
                const float sg = sigmoidf_(hf[e]);
                if (row < nvalid) { lf[e] = __logf(lbv[e] + (1.f - lbv[e]) * sg); kk[i][e] = (1.f - lbv[e]) * (1.f - sg); } else { lf[e] = 0.f; kk[i][e] = 0.f; }
            }
            *(f32x4*)(LFB + row * 132 + k0) = (f32x4){lf[0], lf[1], lf[2], lf[3]}; *(f32x4*)(LFB + row * 132 + k0 + 4) = (f32x4){lf[4], lf[5], lf[6], lf[7]};
            *(uint4*)(sV + row * 136 + k0) = phi[i];
        }
        LBAR(); OPQ(fr); OPQ(fq); OPQ(tid);
        {
            const int k = tid & 127, seg = tid >> 7; float loc[16], run = 0.f;
#pragma unroll
            for (int i = 0; i < 16; ++i) { run += LFB[(16 * seg + i) * 132 + k]; loc[i] = run; }
            TOT[seg * 128 + k] = run;
            LBAR(); OPQ(fr); OPQ(fq); OPQ(tid);
            float off = 0.f;
#pragma unroll
            for (int s2 = 0; s2 < 3; ++s2) if (s2 < seg) off += TOT[s2 * 128 + k];
#pragma unroll
            for (int i = 0; i < 16; ++i) LFB[(16 * seg + i) * 132 + k] = loc[i] + off;
            if (seg == 3) { const float bl = off + run; BLAST[k] = bl; DEC[k] = __expf(bl); }
        }
        LBAR(); OPQ(fr); OPQ(fq); OPQ(tid);
#pragma unroll
        for (int i = 0; i < 2; ++i) {
            const int row = (i * 512 + tid) >> 4;
            const f32x4 b0 = *(const f32x4*)(LFB + row * 132 + k0), b1 = *(const f32x4*)(LFB + row * 132 + k0 + 4);
            const f32x4 l0 = *(const f32x4*)(BLAST + k0), l1 = *(const f32x4*)(BLAST + k0 + 4);
            float qt[8], kt[8], kw[8];
#pragma unroll
            for (int e = 0; e < 8; ++e) {
                const float b = e < 4 ? b0[e & 3] : b1[e & 3], bl = e < 4 ? l0[e & 3] : l1[e & 3];
                qt[e] = qf[i][e] * __expf(b); kt[e] = kk[i][e] * __expf(fminf(-b, 80.f));
                kw[e] = kk[i][e] * __expf(bl - b);
            }
            *(uint4*)(sQ + row * 136 + k0) = pack8f(qt); *(uint4*)(sK + row * 136 + k0) = pack8f(kt); *(uint4*)(sKW + row * 136 + k0) = pack8f(kw);
        }
        LBAR(); OPQ(fr); OPQ(fq); OPQ(tid);
        if (c + 1 < nch) HG_LOAD(c + 1);
#pragma unroll
        for (int i = 0; i < 2; ++i) pg[i] = ldsel(seq + (size_t)c * 64 * LDP + goff - qoff, HG_OFF(i), HG_OK(i));
        f32x4 O[4];
#pragma unroll
        for (int m = 0; m < 4; ++m) O[m] = (f32x4){0.f, 0.f, 0.f, 0.f};
#pragma unroll
        for (int t = 0; t < 4; ++t) {
            const bf16x8 Bf = pack_acc2(Sacc[2 * t], Sacc[2 * t + 1]);
#pragma unroll
            for (int m = 0; m < 4; ++m) O[m] = MFMA16(ldfrag2(sQ + (16 * m + fr) * 136 + 32 * t + 4 * fq), Bf, O[m]);
        }
        {
            const int mt = w >> 1;
#pragma unroll
            for (int nn = 0; nn < 2; ++nn) {
                const int n = (w & 1) * 2 + nn;
                if (n <= mt) {
                    f32x4 S = (f32x4){0.f, 0.f, 0.f, 0.f};
#pragma unroll
                    for (int t = 0; t < 4; ++t) S = MFMA16(ldfrag(sQ + (16 * mt + fr) * 136 + 32 * t + 8 * fq), ldfrag(sK + (16 * n + fr) * 136 + 32 * t + 8 * fq), S);
#pragma unroll
                    for (int j = 0; j < 4; ++j) { const int l = 16 * mt + 4 * fq + j, s = 16 * n + fr; sP[l * 72 + s] = (s <= l) ? f2bf(S[j]) : (u16)0; }
                } else {
#pragma unroll
                    for (int j = 0; j < 4; ++j) sP[(16 * mt + 4 * fq + j) * 72 + 16 * n + fr] = 0;
                }
            }
        }
        LBAR(); OPQ(fr); OPQ(fq); OPQ(tid);
#pragma unroll
        for (int m = 0; m < 8; ++m) { const f32x4 d4 = *(const f32x4*)(DEC + 16 * m + 4 * fq);
#pragma unroll
            for (int j = 0; j < 4; ++j) Sacc[m][j] *= d4[j]; }
#pragma unroll
        for (int t = 0; t < 2; ++t) {
            const bf16x8 Bv = ldfrag_tr(sV + (32 * t + 8 * fq + ((fr >> 2) & 3)) * 136 + 16 * w + 4 * (fr & 3), 136);
#pragma unroll
            for (int m = 0; m < 4; ++m) O[m] = MFMA16(ldfrag(sP + (16 * m + fr) * 72 + 32 * t + 8 * fq), Bv, O[m]);
#pragma unroll
            for (int m = 0; m < 8; ++m) Sacc[m] = MFMA16(ldfrag_tr(sKW + (32 * t + 8 * fq + ((fr >> 2) & 3)) * 136 + 16 * m + 4 * (fr & 3), 136), Bv, Sacc[m]);
        }
#pragma unroll
        for (int m = 0; m < 4; ++m)
#pragma unroll
            for (int j = 0; j < 4; ++j) {
                const int l = 16 * m + 4 * fq + j; const float o = O[m][j] * 0.08838834764831845f;
                const float sq = red16(o * o);
                if (fr == 0) SSQ[w * 64 + l] = sq;
                sH[l * 136 + 16 * w + fr] = f2bf(o);
            }
        LBAR(); OPQ(fr); OPQ(fq); OPQ(tid);
#pragma unroll
        for (int i = 0; i < 2; ++i) {
            const int row = (i * 512 + tid) >> 4;
            if (row < nvalid) {
                float ssq = 0.f;
#pragma unroll
                for (int ww = 0; ww < 8; ++ww) ssq += SSQ[ww * 64 + row];
                const float rs = rsqrtf(ssq * (1.f / 128.f) + EPS);
                float hv[8], g[8], o[8]; unpack8(*(const uint4*)(sH + row * 136 + k0), hv); unpack8(pg[i], g);
#pragma unroll
                for (int e = 0; e < 8; ++e) o[e] = hv[e] * rs * normw[k0 + e] * siluf_(g[e]);
                *(uint4*)(seq + (size_t)c * 64 * LDP + goff - qoff + (size_t)HG_OFF(i)) = pack8f(o);
            }
            __builtin_amdgcn_sched_barrier(0);
        }
        LBAR(); OPQ(fr); OPQ(fq); OPQ(tid);
    }
#undef HG_LOAD
#undef HG_OFF
#undef HG_OK
    OPQS(outS);
#pragma unroll
    for (int m = 0; m < 8; ++m)
#pragma unroll
        for (int j = 0; j < 4; ++j) outS[(16 * m + 4 * fq + j) * 128 + 16 * w + fr] = Sacc[m][j];
}

template <int NV>
DI void block_ssd(unsigned char* sm, const int tid_o, const int w, const int lane_o, u16* seq, const float* gates, const int nch, const int g, const int hp,
                  const float* convw, const float* convb, const float* dtb, const float* alog, const float* dsk, const float* snw,
                  const float* initH, const float* initConv, float* outH, float* outConv, float* ssq) {
    constexpr int nvalid = NV;
    const int fr_o = lane_o & 15, fq_o = lane_o >> 4, hh = w >> 2, jw = w & 3, head = g * 4 + hp * 2 + hh;
    const int fr = fr_o, fq = fq_o, lane = lane_o, tid = tid_o;
    u16* sC = (u16*)sm; u16* sB = (u16*)(sm + 17408); u16* sX = (u16*)(sm + 34816);
    u16* sP = (u16*)(sm + 52224 + hh * 9216);
    u16* OB = (u16*)sm;
    float* TAB = (float*)(sm + 70656);
    float* BV = (float*)(sm + 78336); float* DTV = BV + 128; float* WV = BV + 256;
    const int rs8 = w;
    for (int idx = tid; idx < 5 * 384; idx += 512) {
        const int tap = idx / 384, lc = idx - tap * 384, c8 = lc >> 3, e = lc & 7;
        const int ch = (c8 < 16 ? g * 256 + hp * 128 + c8 * 8 : (c8 < 32 ? 512 + g * 128 + (c8 - 16) * 8 : 768 + g * 128 + (c8 - 32) * 8)) + e;
        TAB[idx] = tap < 4 ? convw[tap * 1024 + ch] : convb[ch];
    }
    f32x4 hacc[8];
#pragma unroll
    for (int m = 0; m < 8; ++m)
#pragma unroll
        for (int j = 0; j < 4; ++j) hacc[m][j] = initH ? initH[((size_t)head * 128 + 16 * m + 4 * fq + j) * 64 + 16 * jw + fr] : 0.f;
    const float dtbias = dtb[head], Aneg = -__expf(alog[head]), Dsk = dsk[head];
    uint4 pr[11]; float sdt = 0.f;
#define SSD_CP (lane < 48 ? lane : 47)
#define SSD_GCOL (SSD_CP < 16 ? 4608 + g * 256 + hp * 128 + SSD_CP * 8 : (SSD_CP < 32 ? 4608 + 512 + g * 128 + (SSD_CP - 16) * 8 : 4608 + 768 + g * 128 + (SSD_CP - 32) * 8))
#define SSD_OFFZ(i) ((unsigned)((((i) * 32 + (tid >> 4)) < nvalid ? ((i) * 32 + (tid >> 4)) : 0) * LDP + 1024 + g * 256 + hp * 128 + (tid & 15) * 8))
#define SSD_OKZ(i) (((i) * 32 + (tid >> 4)) < nvalid)
#define SSD_LOAD(c) do { const u16* cb_ = seq + (size_t)(c) * 64 * LDP; const unsigned gc_ = (unsigned)SSD_GCOL; _Pragma("unroll") for (int i = 0; i < 11; ++i) { const int row = 8 * rs8 - 3 + i; \
        const bool ok_ = row < nvalid && ((c) * 64 + row) >= 0; pr[i] = ldsel(cb_ + (ok_ ? row * LDP : 0), gc_, ok_); } \
        sdt = (lane < nvalid) ? gates[(size_t)(c) * 64 * 16 + (unsigned)((lane < nvalid ? lane : 0) * 16 + 8 + head)] : 0.f; } while (0)
    SSD_LOAD(0);
    __syncthreads();
    for (int c = 0; c < nch; ++c) {
        int fr = fr_o, fq = fq_o, lane = lane_o, tid = tid_o; OPQ(fr); OPQ(fq); OPQ(lane); OPQ(tid);
        const int cp = SSD_CP; const bool act = lane < 48; const int gcol = SSD_GCOL;
        {
            const bool useinit = (c == 0 && rs8 == 0 && initConv != nullptr);
            u16* dstp = cp < 16 ? sX + cp * 8 : (cp < 32 ? sB + (cp - 16) * 8 : sC + (cp - 32) * 8);
            uint2 ylo[8];
#pragma unroll 1
            for (int half = 0; half < 2; ++half) {
                f32x4 tw[5];
#pragma unroll
                for (int tp = 0; tp < 5; ++tp) tw[tp] = *(const f32x4*)(TAB + tp * 384 + cp * 8 + half * 4);
                f32x4 acc[8];
#pragma unroll
                for (int i = 0; i < 8; ++i) acc[i] = tw[4];
#pragma unroll
                for (int k = 0; k < 11; ++k) {
                    const unsigned w0 = half ? pr[k].z : pr[k].x, w1 = half ? pr[k].w : pr[k].y;
                    f32x4 cur = (f32x4){lo16(w0), hi16(w0), lo16(w1), hi16(w1)};
                    if (k < 3 && useinit) cur = *(const f32x4*)(initConv + k * 1024 + (gcol - 4608) + half * 4);
#pragma unroll
                    for (int i = 0; i < 8; ++i) {
                        if (k - i >= 0 && k - i <= 3) {
#pragma unroll
                            for (int e = 0; e < 4; ++e) acc[i][e] += tw[k - i][e] * cur[e];
                        }
                    }
                }
#pragma unroll
                for (int i = 0; i < 8; ++i) {
                    const int row = 8 * rs8 + i;
                    float y[4];
#pragma unroll
                    for (int e = 0; e < 4; ++e) y[e] = (row < nvalid) ? siluf_(acc[i][e]) : 0.f;
                    uint2 pk; pk.x = pk2(y[0], y[1]); pk.y = pk2(y[2], y[3]);
                    if (half == 0) ylo[i] = pk;
                    else if (act) { uint4 v; v.x = ylo[i].x; v.y = ylo[i].y; v.z = pk.x; v.w = pk.y; *(uint4*)(dstp + row * 136) = v; }
                }
            }
        }
        float blast;
        {
            const float dt = (lane < nvalid) ? softplusf_(sdt + dtbias) : 0.f;
            const float la = dt * Aneg;
            const float b = wscan_sum(la, lane);
            blast = __shfl(b, 63);
            if (jw == 0) { BV[hh * 64 + lane] = b; DTV[hh * 64 + lane] = dt; WV[hh * 64 + lane] = __expf(blast - b) * dt; }
        }
        LBAR(); OPQ(fr); OPQ(fq); OPQ(lane); OPQ(tid);
        f32x4 O[4];
#pragma unroll
        for (int m = 0; m < 4; ++m) O[m] = (f32x4){0.f, 0.f, 0.f, 0.f};
#pragma unroll
        for (int t = 0; t < 4; ++t) {
            const bf16x8 Bf = pack_acc2(hacc[2 * t], hacc[2 * t + 1]);
#pragma unroll
            for (int m = 0; m < 4; ++m) O[m] = MFMA16(ldfrag2(sC + (16 * m + fr) * 136 + 32 * t + 4 * fq), Bf, O[m]);
        }
#pragma unroll
        for (int m = 0; m < 4; ++m) { const f32x4 b4 = *(const f32x4*)(BV + hh * 64 + 16 * m + 4 * fq);
#pragma unroll
            for (int j = 0; j < 4; ++j) O[m][j] *= __expf(b4[j]); }
        {
            const int mt = jw;
            const f32x4 bl4 = *(const f32x4*)(BV + hh * 64 + 16 * mt + 4 * fq);
#pragma unroll
            for (int n = 0; n < 4; ++n) {
                if (n <= mt) {
                    f32x4 S = (f32x4){0.f, 0.f, 0.f, 0.f};
#pragma unroll
                    for (int t = 0; t < 4; ++t) S = MFMA16(ldfrag(sC + (16 * mt + fr) * 136 + 32 * t + 8 * fq), ldfrag(sB + (16 * n + fr) * 136 + 32 * t + 8 * fq), S);
                    const int s = 16 * n + fr; const float bs = BV[hh * 64 + s], ds = DTV[hh * 64 + s];
#pragma unroll
                    for (int j = 0; j < 4; ++j) { const int l = 16 * mt + 4 * fq + j; sP[l * 72 + s] = (s <= l) ? f2bf(S[j] * __expf(bl4[j] - bs) * ds) : (u16)0; }
                } else {
#pragma unroll
                    for (int j = 0; j < 4; ++j) sP[(16 * mt + 4 * fq + j) * 72 + 16 * n + fr] = 0;
                }
            }
        }
        LBAR(); OPQ(fr); OPQ(fq); OPQ(lane); OPQ(tid);
        {
            const float eb = __expf(blast);
#pragma unroll
            for (int m = 0; m < 8; ++m)
#pragma unroll
                for (int j = 0; j < 4; ++j) hacc[m][j] *= eb;
        }
#pragma unroll
        for (int t = 0; t < 2; ++t) {
            const f32x4 w0 = *(const f32x4*)(WV + hh * 64 + 32 * t + 8 * fq), w1 = *(const f32x4*)(WV + hh * 64 + 32 * t + 8 * fq + 4);
            const bf16x8 Bv = ldfrag_tr(sX + (32 * t + 8 * fq + ((fr >> 2) & 3)) * 136 + hh * 64 + 16 * jw + 4 * (fr & 3), 136);
            float x[8]; unpack8(__builtin_bit_cast(uint4, Bv), x);
#pragma unroll
            for (int e = 0; e < 4; ++e) { x[e] *= w0[e]; x[4 + e] *= w1[e]; }
            const bf16x8 Bw = as_frag(pack8f(x));
#pragma unroll
            for (int m = 0; m < 4; ++m) O[m] = MFMA16(ldfrag(sP + (16 * m + fr) * 72 + 32 * t + 8 * fq), Bv, O[m]);
#pragma unroll
            for (int m = 0; m < 8; ++m) hacc[m] = MFMA16(ldfrag_tr(sB + (32 * t + 8 * fq + ((fr >> 2) & 3)) * 136 + 16 * m + 4 * (fr & 3), 136), Bw, hacc[m]);
        }
#pragma unroll
        for (int m = 0; m < 4; ++m) {
            const int pcol = hh * 64 + 16 * jw + fr;
            const uint2 xr = __builtin_bit_cast(uint2, ld_tr4(sX + (16 * m + 4 * fq + ((fr >> 2) & 3)) * 136 + hh * 64 + 16 * jw + 4 * (fr & 3)));
            const float xs0 = lo16(xr.x), xs1 = hi16(xr.x), xs2 = lo16(xr.y), xs3 = hi16(xr.y);
            const int l0 = 16 * m + 4 * fq;
            OB[(l0 + 0) * 136 + pcol] = f2bf(O[m][0] + Dsk * xs0);
            OB[(l0 + 1) * 136 + pcol] = f2bf(O[m][1] + Dsk * xs1);
            OB[(l0 + 2) * 136 + pcol] = f2bf(O[m][2] + Dsk * xs2);
            OB[(l0 + 3) * 136 + pcol] = f2bf(O[m][3] + Dsk * xs3);
        }
        LBAR(); OPQ(fr); OPQ(fq); OPQ(lane); OPQ(tid);
        if (c + 1 < nch) SSD_LOAD(c + 1);
#pragma unroll
        for (int i = 0; i < 2; ++i) {
            const int id = i * 512 + tid, row = id >> 4, col = (id & 15) * 8;
            float yv[8], z[8], val[8]; unpack8(*(const uint4*)(OB + row * 136 + col), yv); unpack8(ldsel(seq + (size_t)c * 64 * LDP, SSD_OFFZ(i), SSD_OKZ(i)), z);
            float ss = 0.f;
#pragma unroll
            for (int e = 0; e < 8; ++e) { val[e] = yv[e] * siluf_(z[e]); ss += val[e] * val[e]; }
            ss = red16(ss);
            if (row < nvalid) {
                if ((tid & 15) == 0) ssq[(size_t)(c * 64 + row) * 4 + g * 2 + hp] = ss;
                float o[8];
#pragma unroll
                for (int e = 0; e < 8; ++e) o[e] = val[e] * snw[g * 256 + hp * 128 + col + e];
                *(uint4*)(seq + (size_t)c * 64 * LDP + (size_t)SSD_OFFZ(i)) = pack8f(o);
            }
            __builtin_amdgcn_sched_barrier(0);
        }
        LBAR(); OPQ(fr); OPQ(fq); OPQ(lane); OPQ(tid);
    }
#undef SSD_LOAD
#undef SSD_GCOL
#undef SSD_CP
#undef SSD_OFFZ
#undef SSD_OKZ
    OPQS(outH); OPQS(outConv);
#pragma unroll
    for (int m = 0; m < 8; ++m)
#pragma unroll
        for (int j = 0; j < 4; ++j) outH[((size_t)head * 128 + 16 * m + 4 * fq + j) * 64 + 16 * jw + fr] = hacc[m][j];
    if (hp == 0) {
        const int T = (nch - 1) * 64 + nvalid;
        for (int idx = tid; idx < 3 * 512; idx += 512) { const int rr = idx >> 9, ch = g * 512 + (idx & 511);
            outConv[rr * 1024 + ch] = bf2f(seq[(size_t)(T - 3 + rr) * LDP + 4608 + ch]); }
    }
}

template <int MIX>
DI void mixer_phase(const Params& p, int l_in, unsigned char* sm) {
    const int l = __builtin_amdgcn_readfirstlane(l_in);
    u16* proj = (u16*)(p.ws + WS_PROJ); u16* sproj = (u16*)(p.ws + WS_SPROJ);
    const float* gates = (const float*)(p.ws + WS_GATES); const float* sgates = (const float*)(p.ws + WS_SGATES);
    float* out = p.out;
    float* ssqb = (float*)(p.ws + WS_SSQ);
    for (int task = blockIdx.x; task < 288; task += gridDim.x) {
        int tid = threadIdx.x; OPQ(tid);
        const int w = __builtin_amdgcn_readfirstlane(tid >> 6), lane = tid & 63;
        const int tk = __builtin_amdgcn_readfirstlane(task);
        if (MIXON(0) && (tk < 32 || (tk >= 96 && tk < 160))) {
            const bool smp = tk < 32; const int t2 = smp ? tk : tk - 96; const int b = t2 >> 2, g = (t2 >> 1) & 1, hp = t2 & 1;
            u16* seq = smp ? sproj + (size_t)b * 16 * LDP : proj + (size_t)b * SEQ * LDP;
            const float* gt = smp ? sgates + (size_t)b * 16 * 16 : gates + (size_t)b * SEQ * 16;
            const int nb = smp ? DEC_BATCH : BATCH;
            float* oH = out + (smp ? O_SSSD : O_PSSD) + ((size_t)l * nb + b) * 8 * 128 * 64;
            float* oC = out + (smp ? O_SCONV : O_PCONV) + ((size_t)l * nb + b) * 3 * 1024;
            float* sq = ssqb + (smp ? (size_t)(NTOK + b * 16) * 4 : (size_t)b * SEQ * 4);
            if (smp) block_ssd<16>(sm, tid, w, lane, seq, gt, 1, g, hp,
                      p.conv_w + (size_t)l * 4 * 1024, p.conv_b + l * 1024, p.dt_bias + l * 8, p.a_log + l * 8, p.d_skip + l * 8, p.snorm_w + l * 512,
                      smp ? p.st_ssd + ((size_t)l * DEC_BATCH + b) * 8 * 128 * 64 : nullptr, smp ? p.st_conv + ((size_t)l * DEC_BATCH + b) * 3 * 1024 : nullptr, oH, oC, sq);
            else block_ssd<64>(sm, tid, w, lane, seq, gt, 32, g, hp,
                      p.conv_w + (size_t)l * 4 * 1024, p.conv_b + l * 1024, p.dt_bias + l * 8, p.a_log + l * 8, p.d_skip + l * 8, p.snorm_w + l * 512,
                      smp ? p.st_ssd + ((size_t)l * DEC_BATCH + b) * 8 * 128 * 64 : nullptr, smp ? p.st_conv + ((size_t)l * DEC_BATCH + b) * 3 * 1024 : nullptr, oH, oC, sq);
        } else if (MIXON(1) && ((tk >= 32 && tk < 64) || tk >= 224)) {
            const bool smp = tk < 64; const int t2 = smp ? tk - 32 : tk - 224; const int b = t2 >> 2, h = t2 & 3;
            u16* seq = smp ? sproj + (size_t)b * 16 * LDP : proj + (size_t)b * SEQ * LDP;
            const int nb = smp ? DEC_BATCH : BATCH;
            float* oS = out + (smp ? O_SHG : O_PHG) + (((size_t)l * nb + b) * 4 + h) * 128 * 128;
            if (smp) chain_hgrn<16>(sm, tid, w, lane, seq, 1, h, p.lbraw, l,
                       smp ? p.st_hg + (((size_t)l * DEC_BATCH + b) * 4 + h) * 128 * 128 : nullptr, oS, p.hnorm_w + l * 512 + h * 128);
            else chain_hgrn<64>(sm, tid, w, lane, seq, 32, h, p.lbraw, l,
                       smp ? p.st_hg + (((size_t)l * DEC_BATCH + b) * 4 + h) * 128 * 128 : nullptr, oS, p.hnorm_w + l * 512 + h * 128);
        } else if ((tk >= 64 && tk < 96) || (tk >= 160 && tk < 224)) {
            int t2; bool smp, ret;
            if (tk < 80) { smp = true; ret = false; t2 = tk - 64; }
            else if (tk < 96) { smp = true; ret = true; t2 = tk - 80; }
            else if (tk < 192) { smp = false; ret = false; t2 = tk - 160; }
            else { smp = false; ret = true; t2 = tk - 192; }
            const int chain = t2 * 2 + (w >> 2); const int b = chain >> 2, h = chain & 3;
            u16* seq = smp ? sproj + (size_t)b * 16 * LDP : proj + (size_t)b * SEQ * LDP;
            const float* gt = smp ? sgates + (size_t)b * 16 * 16 : gates + (size_t)b * SEQ * 16;
            const int nb = smp ? DEC_BATCH : BATCH;
            const size_t si = ((size_t)l * nb + b) * 4 + h;
            unsigned char* csm = sm + (w >> 2) * 65536;
            if (MIXON(2) && !ret) {
                if (smp) chain_mr<0, 16>(csm, tid & 255, w & 3, lane, seq, gt, 1, 0, h,
                            smp ? p.st_mc + si * 64 * 128 : nullptr, smp ? p.st_mn + si * 64 : nullptr, smp ? p.st_mm + si : nullptr,
                            out + (smp ? O_SMC : O_PMC) + si * 64 * 128, out + (smp ? O_SMN : O_PMN) + si * 64, out + (smp ? O_SMM : O_PMM) + si,
                            p.mnorm_w + l * 512 + h * 128, p.gate_b[l * 8 + h], p.gate_b[l * 8 + 4 + h]);
                else chain_mr<0, 64>(csm, tid & 255, w & 3, lane, seq, gt, 32, 0, h,
                            smp ? p.st_mc + si * 64 * 128 : nullptr, smp ? p.st_mn + si * 64 : nullptr, smp ? p.st_mm + si : nullptr,
                            out + (smp ? O_SMC : O_PMC) + si * 64 * 128, out + (smp ? O_SMN : O_PMN) + si * 64, out + (smp ? O_SMM : O_PMM) + si,
                            p.mnorm_w + l * 512 + h * 128, p.gate_b[l * 8 + h], p.gate_b[l * 8 + 4 + h]);
            } else if (MIXON(3) && ret) {
                if (smp) chain_mr<1, 16>(csm, tid & 255, w & 3, lane, seq, gt, 1, PAST_LEN, h,
                            smp ? p.st_ret + si * 64 * 128 : nullptr, nullptr, nullptr,
                            out + (smp ? O_SRET : O_PRET) + si * 64 * 128, nullptr, nullptr, nullptr, 0.f, 0.f);
                else chain_mr<1, 64>(csm, tid & 255, w & 3, lane, seq, gt, 32, 0, h,
                            smp ? p.st_ret + si * 64 * 128 : nullptr, nullptr, nullptr,
                            out + (smp ? O_SRET : O_PRET) + si * 64 * 128, nullptr, nullptr, nullptr, 0.f, 0.f);
            }
        }
        __syncthreads();
    }
}

DI void final_norm(const Params& p, int gw, int ngw, int lane) {
    const u16* X = (const u16*)(p.ws + WS_PROJ);
    for (int r = gw; r < NTOK + NSTOK; r += ngw) {
        float x[16];
        if (r < NTOK) {
#pragma unroll
            for (int i = 0; i < 4; ++i) { const float4 v = *(const float4*)((const float*)(X + (size_t)r * LDP + 2048) + i * 256 + lane * 4); x[4 * i] = v.x; x[4 * i + 1] = v.y; x[4 * i + 2] = v.z; x[4 * i + 3] = v.w; }
        } else {
#pragma unroll
            for (int i = 0; i < 4; ++i) { const float4 v = *(const float4*)(p.out + O_YS + (size_t)(r - NTOK) * 1024 + i * 256 + lane * 4); x[4 * i] = v.x; x[4 * i + 1] = v.y; x[4 * i + 2] = v.z; x[4 * i + 3] = v.w; }
        }
        float ss = 0.f;
#pragma unroll
        for (int i = 0; i < 16; ++i) ss += x[i] * x[i];
        ss = wsum(ss);
        const float rs = rsqrtf(ss * (1.f / 1024.f) + EPS);
        float* dst = (r < NTOK) ? p.out + O_YP + (size_t)r * 1024 : p.out + O_YS + (size_t)(r - NTOK) * 1024;
#pragma unroll
        for (int i = 0; i < 4; ++i) { const int k = i * 256 + lane * 4; const float4 wv = *(const float4*)(p.fnorm_w + k);
            float4 o; o.x = x[4 * i] * rs * wv.x; o.y = x[4 * i + 1] * rs * wv.y; o.z = x[4 * i + 2] * rs * wv.z; o.w = x[4 * i + 3] * rs * wv.w;
            *(float4*)(dst + k) = o; }
    }
}


#define XB_TMO      128
#define XB_XCNT(j)  (256  + 64 * (j))
#define XB_XSUB(j)  (1280 + 64 * (j))
#define XB_XGEN(j)  (2304 + 64 * (j))
#define XB_TOP      3328
#define XB_TOPGEN   3392
#define XCD_BAR_WORDS 3456
#define XB_SPIN_CAP (1u << 18)
DI unsigned xb_ld(unsigned* p)              { return __hip_atomic_load(p, __ATOMIC_RELAXED, __HIP_MEMORY_SCOPE_AGENT); }
DI unsigned xb_add(unsigned* p, unsigned v) { return __hip_atomic_fetch_add(p, v, __ATOMIC_RELAXED, __HIP_MEMORY_SCOPE_AGENT); }
DI unsigned xb_xcc_id() { return (unsigned)__builtin_amdgcn_s_getreg((3 << 11) | 20) & 0xFu; }
#define XB_SPIN(cond, bar) do { unsigned _sp = 0; while (cond) { __builtin_amdgcn_s_sleep(1); \
    if ((++_sp & 255u) == 0u) { if (xb_ld(&(bar)[XB_TMO])) break; if (_sp > XB_SPIN_CAP) { atomicAdd(&(bar)[XB_TMO], 1u); break; } } } } while (0)
struct XcdBarrier { unsigned* bar; unsigned x; volatile LAS unsigned* st; };
DI void xcd_barrier_post(unsigned* bar) { if (threadIdx.x == 0) (void)xb_add(&bar[XB_XCNT(xb_xcc_id())], 1u); }
DI void xcd_barrier_complete(unsigned* bar, unsigned x, unsigned& nloc, unsigned& nx) {
    const unsigned G = gridDim.x * gridDim.y * gridDim.z;
    unsigned sum, cnt, mine, sp = 0u;
    for (;;) {
        sum = 0u; cnt = 0u; mine = 0u;
#pragma unroll
        for (unsigned j = 0; j < 16; ++j) { const unsigned c = xb_ld(&bar[XB_XCNT(j)]); sum += c; cnt += (c > 0u) ? 1u : 0u; mine = (j == x) ? c : mine; }
        if (sum == G) break;
        __builtin_amdgcn_s_sleep(1);
        if ((++sp & 255u) == 0u) { if (xb_ld(&bar[XB_TMO])) break; if (sp > XB_SPIN_CAP) { atomicAdd(&bar[XB_TMO], 1u); break; } }
    }
    nloc = mine > 0u ? mine : 1u; nx = cnt > 0u ? cnt : 1u;
}
DI void xcd_barrier(const XcdBarrier& b) {
    asm volatile("s_waitcnt vmcnt(0)" ::: "memory");
    __syncthreads();
    if (threadIdx.x == 0) {
        unsigned* bar = b.bar;
        __builtin_amdgcn_s_waitcnt(0);
        unsigned nloc = b.st[0], nx = b.st[1];
        if (nloc == 0u) { xcd_barrier_complete(bar, b.x, nloc, nx); b.st[0] = nloc; b.st[1] = nx; }
        const unsigned old = xb_add(&bar[XB_XSUB(b.x)], 1u);
        const unsigned gen = old / nloc;
        if (old + 1u == (gen + 1u) * nloc) {
            __builtin_amdgcn_fence(__ATOMIC_RELEASE, "agent");
            asm volatile("s_waitcnt vmcnt(0)" ::: "memory");
            const unsigned og = xb_add(&bar[XB_TOP], 1u);
            const unsigned tg = og / nx;
            if (og + 1u == (tg + 1u) * nx) xb_add(&bar[XB_TOPGEN], 1u);
            else XB_SPIN(xb_ld(&bar[XB_TOPGEN]) == tg, bar);
            __builtin_amdgcn_fence(__ATOMIC_ACQUIRE, "agent");
            xb_add(&bar[XB_XGEN(b.x)], 1u);
            asm volatile("s_waitcnt vmcnt(0)" ::: "memory");
        } else {
            XB_SPIN(xb_ld(&bar[XB_XGEN(b.x)]) == gen, bar);
            __builtin_amdgcn_fence(__ATOMIC_ACQUIRE, "agent");
            asm volatile("s_waitcnt vmcnt(0)" ::: "memory");
        }
    }
    __syncthreads();
}
#define GRID_SEAM(first) do { if (first) cg::this_grid().sync(); else { XcdBarrier xb_; xb_.bar = (unsigned*)(p.ws + WS_BAR); xb_.x = xb_xcc_id(); xb_.st = (volatile LAS unsigned*)(LAS unsigned char*)(lds + LDS_BYTES - 16); xcd_barrier(xb_); } } while (0)

template <int PHSEL, int MIX>
DI void run_phases(const Params& p, unsigned char* lds) {
#define PSEL(x) (PHSEL < 0 || PHSEL == (x))
    if (COOP) { volatile LAS unsigned* st_ = (volatile LAS unsigned*)(LAS unsigned char*)(lds + LDS_BYTES - 16); if (threadIdx.x < 2) st_[threadIdx.x] = 0u; __syncthreads(); xcd_barrier_post((unsigned*)(p.ws + WS_BAR)); }
#ifndef PROG
#define PROG 0x876543210ull
#define NPROG 9
#endif
    for (int pi = p.ph_lo; pi < p.ph_hi; ++pi) {
        const int ph = __builtin_amdgcn_readfirstlane((int)((PROG >> (4 * pi)) & 15ull));
#define PH_IDS int tid = threadIdx.x; OPQ(tid); const int w = __builtin_amdgcn_readfirstlane(tid >> 6), lane = tid & 63; const int gw = blockIdx.x * 8 + w, ngw = gridDim.x * 8; (void)gw; (void)ngw; (void)lane
        u16* proj = (u16*)(p.ws + WS_PROJ); u16* sproj = (u16*)(p.ws + WS_SPROJ);
        float* gates = (float*)(p.ws + WS_GATES); float* sgates = (float*)(p.ws + WS_SGATES);
        float* rstd = (float*)(p.ws + WS_RSTD); float* srstd = (float*)(p.ws + WS_SRSTD);
        u16* shi = (u16*)(p.ws + WS_SHI);
        u16* X = (u16*)(p.out + O_YP);
        float* ys = p.out + O_YS;
        if (PSEL(0) && ph == 0) {
            PH_IDS;
            convert_weights(p, (float*)lds, tid);
            build_wg(p, 0, (float*)lds, tid);
            __syncthreads();
            prep_rows<0>(p.x_prompt, nullptr, NTOK, X, 2048, true, rstd, gates, nullptr, (const float*)lds, gw, ngw, lane);
            prep_rows<0>(p.x_sample, nullptr, NSTOK, shi, 1024, true, srstd, sgates, ys, (const float*)lds, gw, ngw, lane);
        } else if (PSEL(4) && ph == 4) {
            PH_IDS;
            build_wg(p, 1, (float*)lds, tid);
            __syncthreads();
            prep_rows<1>(nullptr, X, NTOK, nullptr, 0, false, rstd, gates, nullptr, (const float*)lds, gw, ngw, lane);
            prep_rows<0>(ys, nullptr, NSTOK, shi, 1024, true, srstd, sgates, nullptr, (const float*)lds, gw, ngw, lane);
        } else if (PSEL(1) && (ph == 1 || ph == 5)) {
            PH_IDS;
            const int l = ph == 1 ? 0 : 1;
            const u16* wt = (const u16*)(p.ws + WS_WTIN) + (size_t)l * LDP * 1024;
            sample_gemm<0>(shi, 1024, wt, LDP, 1024, gw, ngw, lane, sproj, srstd, nullptr, nullptr);
            __syncthreads();
            pg8::Gemm g; g.A = X; g.Bt = wt; g.M = NTOK; g.N = LDP; g.K = 1024; g.lda = 2048;
            pg8::StaticOrder S; S.init(g.M, g.N, (int)gridDim.x, (int)blockIdx.x);
            pg8::EpiIn E; E.O = proj; E.rstd = rstd;
            pg8::gemm_phase<pg8::EpiIn>((LAS unsigned char*)lds, g, S, E, tid);
        } else if (PSEL(2) && (ph == 2 || ph == 6)) {
            mixer_phase<MIX>(p, ph == 2 ? 0 : 1, lds);
        } else if (PSEL(3) && (ph == 3 || ph == 7)) {
            PH_IDS;
            const int l = ph == 3 ? 0 : 1;
            const u16* wt = (const u16*)(p.ws + WS_WTOUT) + (size_t)l * 1024 * 2048;
            {
                const float* ssqb = (const float*)(p.ws + WS_SSQ);
                for (int r = gw; r < NTOK + NSTOK; r += ngw) {
                    u16* rowp = (r < NTOK ? proj + (size_t)r * LDP : sproj + (size_t)(r - NTOK) * LDP) + 1024 + lane * 8;
                    const float4 s4 = *(const float4*)(ssqb + (size_t)r * 4);
                    const float tot = (lane >> 5) ? s4.z + s4.w : s4.x + s4.y;
                    const float rs = rsqrtf(tot * (1.f / 256.f) + EPS);
                    float v[8]; unpack8(*(const uint4*)rowp, v);
#pragma unroll
                    for (int e = 0; e < 8; ++e) v[e] *= rs;
                    *(uint4*)rowp = pack8f(v);
                }
                GRID_SEAM(false);
            }
            {
                const int fr = lane & 15, fq = lane >> 4; float* red = (float*)lds;
                const float* resid = l == 0 ? p.x_sample : ys;
                for (int t = blockIdx.x; t < 512; t += gridDim.x) {
                    const int rt = t & 7, ct = t >> 3;
                    const u16* ap = sproj + (size_t)(rt * 16 + fr) * LDP + w * 256 + 8 * fq;
                    const u16* bp = wt + (size_t)(ct * 16 + fr) * 2048 + w * 256 + 8 * fq;
                    f32x4 acc = (f32x4){0.f, 0.f, 0.f, 0.f};
#pragma unroll
                    for (int k = 0; k < 256; k += 32) acc = MFMA16(as_frag(ldg16(ap + k)), as_frag(ldg16(bp + k)), acc);
                    *(f32x4*)(red + (w * 64 + lane) * 4) = acc;
                    __syncthreads();
                    if (w == 0) {
                        f32x4 tot = acc;
#pragma unroll
                        for (int ww = 1; ww < 8; ++ww) { const f32x4 o = *(const f32x4*)(red + (ww * 64 + lane) * 4); tot[0] += o[0]; tot[1] += o[1]; tot[2] += o[2]; tot[3] += o[3]; }
#pragma unroll
                        for (int j = 0; j < 4; ++j) { const size_t o = (size_t)(rt * 16 + 4 * fq + j) * 1024 + ct * 16 + fr; ys[o] = resid[o] + tot[j]; }
                    }
                    __syncthreads();
                }
            }
            pg8::Gemm g; g.A = proj; g.Bt = wt; g.M = NTOK; g.N = 1024; g.K = 2048; g.lda = LDP;
            pg8::StaticOrder S; S.init(g.M, g.N, (int)gridDim.x, (int)blockIdx.x);
            pg8::EpiOut E; E.Xhi = X; E.Xlo = X + 1024; E.xin = l == 0 ? p.x_prompt : nullptr; E.projdead = proj; E.last = (l == 1);
            pg8::gemm_phase<pg8::EpiOut>((LAS unsigned char*)lds, g, S, E, tid);
        } else if (PSEL(8) && ph == 8) {
            PH_IDS;
            final_norm(p, gw, ngw, lane);
        }
        if (pi + 1 < p.ph_hi) { GRID_SEAM(p.ph_hi > 64); }
    }
#undef PSEL
}
#if COOP
__global__ __launch_bounds__(512) void mega(Params p) {
    extern __shared__ __attribute__((aligned(16))) unsigned char lds[];
    run_phases<-1, -1>(p, lds);
}
#else
template <int PHSEL, int MIX>
__global__ __launch_bounds__(512) void phase_k(Params p) {
    extern __shared__ __attribute__((aligned(16))) unsigned char lds[];
    run_phases<PHSEL, MIX>(p, lds);
}
#endif

extern "C" void kernel_launch(void* const* d_in, const int* in_sizes, int n_in, void* d_out, int out_size, void* d_ws, size_t ws_size, hipStream_t stream) {
    static int grid = 0;
    if (grid == 0) {
        if (n_in != 23 || (size_t)out_size != O_END || ws_size < WS_END) { fprintf(stderr, "kernel_launch: unexpected shapes n_in %d out %d ws %zu (need %zu)\n", n_in, out_size, ws_size, (size_t)WS_END); grid = -1; return; }
        int dev = 0, cus = 0, per_cu = 0;
        (void)hipGetDevice(&dev); (void)hipDeviceGetAttribute(&cus, hipDeviceAttributeMultiprocessorCount, dev);
#if COOP
        if (hipFuncSetAttribute((const void*)mega, hipFuncAttributeMaxDynamicSharedMemorySize, LDS_BYTES) != hipSuccess) { fprintf(stderr, "hipFuncSetAttribute failed\n"); grid = -1; return; }
        (void)hipOccupancyMaxActiveBlocksPerMultiprocessor(&per_cu, (const void*)mega, 512, LDS_BYTES);
        (void)hipGetLastError();
#else
        hipError_t e = hipSuccess;
#define SETA(PH, MX) if (e == hipSuccess) e = hipFuncSetAttribute((const void*)phase_k<PH, MX>, hipFuncAttributeMaxDynamicSharedMemorySize, LDS_BYTES)
        SETA(0, -1); SETA(1, -1); SETA(2, 0); SETA(2, 1); SETA(2, 2); SETA(2, 3); SETA(3, -1); SETA(4, -1); SETA(8, -1);
#undef SETA
        if (e != hipSuccess) { fprintf(stderr, "hipFuncSetAttribute failed\n"); grid = -1; return; }
#endif
        if (per_cu < 1) per_cu = 1;
        grid = cus * per_cu; if (grid > 256) grid = 256;
    }
    if (grid < 0) return;
    Params p{};
    p.x_prompt = (const float*)d_in[0]; p.x_sample = (const float*)d_in[1];
    p.st_mc = (const float*)d_in[2]; p.st_mn = (const float*)d_in[3]; p.st_mm = (const float*)d_in[4]; p.st_ret = (const float*)d_in[5];
    p.st_ssd = (const float*)d_in[6]; p.st_conv = (const float*)d_in[7]; p.st_hg = (const float*)d_in[8];
    p.norm_w = (const float*)d_in[9]; p.w_in = (const float*)d_in[10]; p.gate_b = (const float*)d_in[11]; p.mnorm_w = (const float*)d_in[12];
    p.conv_w = (const float*)d_in[13]; p.conv_b = (const float*)d_in[14]; p.dt_bias = (const float*)d_in[15]; p.a_log = (const float*)d_in[16];
    p.d_skip = (const float*)d_in[17]; p.snorm_w = (const float*)d_in[18]; p.lbraw = (const float*)d_in[19]; p.hnorm_w = (const float*)d_in[20];
    p.w_out = (const float*)d_in[21]; p.fnorm_w = (const float*)d_in[22];
    p.out = (float*)d_out; p.ws = (unsigned char*)d_ws;
#if COOP
    p.ph_lo = 0; p.ph_hi = NPROG;
    if (hipMemsetAsync((char*)d_ws + WS_BAR, 0, 16384, stream) != hipSuccess) { fprintf(stderr, "hipMemsetAsync failed\n"); return; }
    void* args[] = {&p};
    hipError_t e = hipLaunchCooperativeKernel((const void*)mega, dim3(grid), dim3(512), args, LDS_BYTES, stream);
    if (e != hipSuccess) fprintf(stderr, "cooperative launch failed: %s (grid %d)\n", hipGetErrorString(e), grid);
#else
#ifndef MAXL
#define MAXL 99
#endif
    int nl_ = 0;
#define LAUNCH(PH, MX, ph_) do { if (nl_++ >= MAXL) break; p.ph_lo = (ph_); p.ph_hi = (ph_) + 1; hipLaunchKernelGGL((phase_k<PH, MX>), dim3(grid), dim3(512), LDS_BYTES, stream, p); } while (0)
    LAUNCH(0, -1, 0); LAUNCH(1, -1, 1);
    LAUNCH(2, 0, 2); LAUNCH(2, 1, 2); LAUNCH(2, 2, 2); LAUNCH(2, 3, 2);
    LAUNCH(3, -1, 3); LAUNCH(4, -1, 4); LAUNCH(1, -1, 5);
    LAUNCH(2, 0, 6); LAUNCH(2, 1, 6); LAUNCH(2, 2, 6); LAUNCH(2, 3, 6);
    LAUNCH(3, -1, 7); LAUNCH(8, -1, 8);
#undef LAUNCH
#endif
}
```

```cpp
#include <hip/hip_runtime.h>
#include <hip/hip_cooperative_groups.h>
#include <cstdio>
namespace cg = cooperative_groups;

#define DI __device__ __forceinline__
#define OPQ(x) asm volatile("" : "+v"(x))
#define LBAR() asm volatile("s_waitcnt lgkmcnt(0)\n\ts_barrier" ::: "memory")
#define OPQS(x) asm volatile("" : "+s"(x))
typedef unsigned short u16;
typedef short bf16x8 __attribute__((ext_vector_type(8)));
typedef short bf16x4 __attribute__((ext_vector_type(4)));
typedef float f32x4 __attribute__((ext_vector_type(4)));
typedef unsigned u32x4 __attribute__((ext_vector_type(4)));
#define LAS __attribute__((address_space(3)))

#ifndef COOP
#define COOP 1
#endif
#ifndef ONLYPH
#define ONLYPH -1
#endif
#ifndef ONLYMIX
#define ONLYMIX -1
#endif
#define MIXON(x) ((MIX < 0 || MIX == (x)) && (ONLYMIX < 0 || ONLYMIX == (x)))
#define PHON(x) (ONLYPH < 0 || ONLYPH == (x))

constexpr int D_MODEL = 1024, BATCH = 16, SEQ = 2048, DEC_BATCH = 8, DEC_SEQ = 16, PAST_LEN = 1024;
constexpr int NTOK = BATCH * SEQ;
constexpr int NSTOK = DEC_BATCH * DEC_SEQ;
constexpr int IN_COLS = 7184;
constexpr int LDP = 7168;
constexpr float EPS = 1e-6f;
constexpr int LDS_BYTES = 147456;
constexpr int NPHASE = 9;

constexpr size_t WS_PROJ = 0;
constexpr size_t WS_WTIN = WS_PROJ + (size_t)NTOK * LDP * 2;
constexpr size_t WS_WTOUT = WS_WTIN + (size_t)2 * LDP * 1024 * 2;
constexpr size_t WS_GATES = WS_WTOUT + (size_t)2 * 1024 * 2048 * 2;
constexpr size_t WS_RSTD = WS_GATES + (size_t)NTOK * 16 * 4;
constexpr size_t WS_SPROJ = WS_RSTD + (size_t)NTOK * 4;
constexpr size_t WS_SGATES = WS_SPROJ + (size_t)NSTOK * LDP * 2;
constexpr size_t WS_SRSTD = WS_SGATES + (size_t)NSTOK * 16 * 4;
constexpr size_t WS_SHI = WS_SRSTD + 512;
constexpr size_t WS_SSQ = WS_SHI + (size_t)NSTOK * 1024 * 2;
constexpr size_t WS_BAR = WS_SSQ + (size_t)(NTOK + NSTOK) * 4 * 4;
constexpr size_t WS_END = WS_BAR + 16384;

constexpr size_t O_YP = 0;
constexpr size_t O_YS = O_YP + (size_t)NTOK * 1024;
constexpr size_t O_PMC = O_YS + (size_t)NSTOK * 1024;
constexpr size_t O_PMN = O_PMC + (size_t)2 * 16 * 4 * 64 * 128;
constexpr size_t O_PMM = O_PMN + (size_t)2 * 16 * 4 * 64;
constexpr size_t O_PRET = O_PMM + (size_t)2 * 16 * 4;
constexpr size_t O_PSSD = O_PRET + (size_t)2 * 16 * 4 * 64 * 128;
constexpr size_t O_PCONV = O_PSSD + (size_t)2 * 16 * 8 * 128 * 64;
constexpr size_t O_PHG = O_PCONV + (size_t)2 * 16 * 3 * 1024;
constexpr size_t O_SMC = O_PHG + (size_t)2 * 16 * 4 * 128 * 128;
constexpr size_t O_SMN = O_SMC + (size_t)2 * 8 * 4 * 64 * 128;
constexpr size_t O_SMM = O_SMN + (size_t)2 * 8 * 4 * 64;
constexpr size_t O_SRET = O_SMM + (size_t)2 * 8 * 4;
constexpr size_t O_SSSD = O_SRET + (size_t)2 * 8 * 4 * 64 * 128;
constexpr size_t O_SCONV = O_SSSD + (size_t)2 * 8 * 8 * 128 * 64;
constexpr size_t O_SHG = O_SCONV + (size_t)2 * 8 * 3 * 1024;
constexpr size_t O_END = O_SHG + (size_t)2 * 8 * 4 * 128 * 128;

struct Params {
    const float* x_prompt; const float* x_sample;
    const float* st_mc; const float* st_mn; const float* st_mm; const float* st_ret; const float* st_ssd; const float* st_conv; const float* st_hg;
    const float* norm_w; const float* w_in; const float* gate_b; const float* mnorm_w; const float* conv_w; const float* conv_b;
    const float* dt_bias; const float* a_log; const float* d_skip; const float* snorm_w; const float* lbraw; const float* hnorm_w;
    const float* w_out; const float* fnorm_w;
    float* out; unsigned char* ws;
    int ph_lo, ph_hi;
};

DI float bf2f(u16 v) { return __uint_as_float(((unsigned)v) << 16); }
typedef __bf16 bf2_t __attribute__((ext_vector_type(2)));
typedef float f2_t __attribute__((ext_vector_type(2)));
DI unsigned pk2(float a, float b) { const f2_t v = {a, b}; const bf2_t r = __builtin_convertvector(v, bf2_t); return __builtin_bit_cast(unsigned, r); }
DI u16 f2bf(float a) { return (u16)(pk2(a, 0.f) & 0xffffu); }
DI float lo16(unsigned w) { return __uint_as_float(w << 16); }
DI float hi16(unsigned w) { return __uint_as_float(w & 0xffff0000u); }
DI void unpack8(const uint4 v, float* f) {
    f[0] = lo16(v.x); f[1] = hi16(v.x); f[2] = lo16(v.y); f[3] = hi16(v.y); f[4] = lo16(v.z); f[5] = hi16(v.z); f[6] = lo16(v.w); f[7] = hi16(v.w);
}
DI uint4 pack8f(const float* f) { uint4 r; r.x = pk2(f[0], f[1]); r.y = pk2(f[2], f[3]); r.z = pk2(f[4], f[5]); r.w = pk2(f[6], f[7]); return r; }
DI bf16x8 as_frag(uint4 v) { return __builtin_bit_cast(bf16x8, v); }
DI bf16x8 pack_acc2(const f32x4 a, const f32x4 b) { uint4 r; r.x = pk2(a[0], a[1]); r.y = pk2(a[2], a[3]); r.z = pk2(b[0], b[1]); r.w = pk2(b[2], b[3]); return __builtin_bit_cast(bf16x8, r); }
DI bf16x8 ldfrag(const u16* p) { return *(const bf16x8*)p; }
DI bf16x8 ldfrag2(const u16* p) { uint2 a = *(const uint2*)p; uint2 b = *(const uint2*)(p + 16); uint4 r; r.x = a.x; r.y = a.y; r.z = b.x; r.w = b.y; return __builtin_bit_cast(bf16x8, r); }
typedef short v4s_t __attribute__((ext_vector_type(4)));
DI bf16x8 ldfrag_tr(const u16* p, const int RS) {
    const v4s_t lo = __builtin_amdgcn_ds_read_tr16_b64_v4i16((LAS v4s_t*)p);
    const v4s_t hi = __builtin_amdgcn_ds_read_tr16_b64_v4i16((LAS v4s_t*)(p + 4 * RS));
    return __builtin_shufflevector(lo, hi, 0, 1, 2, 3, 4, 5, 6, 7);
}
DI v4s_t ld_tr4(const u16* p) { return __builtin_amdgcn_ds_read_tr16_b64_v4i16((LAS v4s_t*)p); }
#define MFMA16(a, b, c) __builtin_amdgcn_mfma_f32_16x16x32_bf16((a), (b), (c), 0, 0, 0)
DI float sigmoidf_(float x) { return __builtin_amdgcn_rcpf(1.f + __expf(-x)); }
DI float siluf_(float x) { return x * __builtin_amdgcn_rcpf(1.f + __expf(-x)); }
DI float softplusf_(float x) { return fmaxf(x, 0.f) + log1pf(__expf(-fabsf(x))); }
DI float logsigf_(float x) { return fminf(x, 0.f) - log1pf(__expf(-fabsf(x))); }
DI float wscan_sum(float x, int lane) {
#pragma unroll
    for (int o = 1; o < 64; o <<= 1) { float t = __shfl_up(x, o); if (lane >= o) x += t; }
    return x;
}
DI float wscan_max(float x, int lane) {
#pragma unroll
    for (int o = 1; o < 64; o <<= 1) { float t = __shfl_up(x, o); if (lane >= o) x = fmaxf(x, t); }
    return x;
}
template <int CTRL> DI float dppf(float x) { return __builtin_bit_cast(float, __builtin_amdgcn_update_dpp(0, __builtin_bit_cast(int, x), CTRL, 0xF, 0xF, true)); }
DI float red16(float x) { x += dppf<0xB1>(x); x += dppf<0x4E>(x); x += dppf<0x141>(x); x += dppf<0x140>(x); return x; }
DI float wsum(float x) { x = red16(x); x += __shfl_xor(x, 16); x += __shfl_xor(x, 32); return x; }
DI uint4 ldg16(const u16* p) { return *(const uint4*)p; }
DI uint4 ldsel(const u16* base, unsigned off, bool ok) { const uint4 v = *(const uint4*)(base + (size_t)off); return ok ? v : make_uint4(0u, 0u, 0u, 0u); }
DI uint4 zero4() { uint4 z; z.x = z.y = z.z = z.w = 0u; return z; }

DI int src_col(int n) {
    if (n < 512) return 512 + n;
    if (n < 1024) return 2568 + (n - 512);
    if (n < 1536) return 3592 + (n - 1024);
    if (n < 2048) return 6672 + (n - 1536);
    if (n < 2304) return 0 + (n - 2048);
    if (n < 2560) return 256 + (n - 2304);
    if (n < 3072) return 1024 + (n - 2560);
    if (n < 3584) return 1536 + (n - 3072);
    if (n < 3840) return 2056 + (n - 3584);
    if (n < 4096) return 2312 + (n - 3840);
    if (n < 4608) return 3080 + (n - 4096);
    if (n < 5632) return 4104 + (n - 4608);
    if (n < 6144) return 5136 + (n - 5632);
    if (n < 6656) return 5648 + (n - 6144);
    return 6160 + (n - 6656);
}

namespace pg8 {
constexpr int BM = 256, BK = 64, HALF = 128, HTB = HALF * BK * 2, NXCD = 8, WGM = 8;
DI int lds_byte(int r, int c) { const int st = (r >> 4) * 2 + (c >> 5), rr = r & 15, cc = c & 31, ob = rr * 64 + cc * 2; return st * 1024 + (ob ^ (((ob >> 9) & 1) << 5)); }
DI void stage_rc(int b, int& R, int& C) { const int st = b / 1024, sb = b % 1024, swz = sb ^ (((sb >> 9) & 1) << 5); R = (st >> 1) * 16 + swz / 64; C = (st & 1) * 32 + (swz % 64) / 2; }
DI int perm32(int rho) { const int n = rho >> 4, i = rho & 15; return 8 * (i >> 2) + 4 * n + (i & 3); }
struct Unit { int pm, pn; };
struct Gemm { const u16* A; const u16* Bt; int M, N, K, lda; };
struct StaticOrder {
    int nM, nN, nwg, G, c;
    DI void init(int M, int N, int G_, int c_) { nM = M / BM; nN = N / BM; nwg = nM * nN; G = G_; c = c_; }
    DI bool next(int i, Unit& u) const {
        const long L = (long)i * G + c; if (L >= nwg) return false;
        int wgid = (int)L; { const int q = nwg / NXCD, r = nwg % NXCD, xcd = wgid % NXCD, off = wgid / NXCD; wgid = (xcd < r ? xcd * (q + 1) : r * (q + 1) + (xcd - r) * q) + off; }
        const int nig = WGM * nN, gid = wgid / nig, fm = gid * WGM, gsz = (nM - fm) < WGM ? (nM - fm) : WGM;
        u.pm = fm + ((wgid % nig) % gsz); u.pn = (wgid % nig) / gsz; return true;
    }
};
template <class Epi>
DI void gemm_phase(LAS unsigned char* lds, const Gemm g, const StaticOrder& S, const Epi& E, const int tid) {
    const int wid = __builtin_amdgcn_readfirstlane(tid >> 6), lane = tid & 63, wr = wid >> 2, wc = wid & 3, fr = lane & 15, fq = lane >> 4;
    const int K = g.K, nt = K / BK, lda = g.lda;
    unsigned voffA[2], voffB[2];
#pragma unroll
    for (int i = 0; i < 2; ++i) { int R, C; stage_rc(tid * 16 + i * 8192, R, C); const int Rb = (R & ~31) + perm32(R & 31);
        voffA[i] = (unsigned)(R * lda + C) * 2u; voffB[i] = (unsigned)(Rb * K + C) * 2u; }
    const size_t kstep = (size_t)(BK * 2);
    const size_t hstepA = (size_t)HALF * lda * 2, hstepB = (size_t)HALF * K * 2;
    const size_t tstepA = 2 * hstepA, tstepB = 2 * hstepB;
    const unsigned ldsw = (unsigned)wid * 1024u;
    const int aoff = lds_byte(wr * 64 + fr, fq * 8), boff = lds_byte(wc * 32 + fr, fq * 8);
#define PG8_SA(b, h) (((b) * 2 + (h)) * HTB)
#define PG8_SB(b, h) ((4 + (b) * 2 + (h)) * HTB)
#define PG8_STAGE(bufoff, gbase, voff) do { _Pragma("unroll") for (int _i = 0; _i < 2; ++_i) \
        __builtin_amdgcn_global_load_lds((const unsigned*)((const char*)(gbase) + (voff)[_i]), (LAS unsigned*)(lds + (bufoff) + ldsw + _i * 8192), 16, 0, 0); } while (0)
#define PG8_LDA(dst, b, h) do { _Pragma("unroll") for (int m = 0; m < 4; ++m) _Pragma("unroll") for (int k = 0; k < 2; ++k) dst[m][k] = *(const LAS bf16x8*)(lds + PG8_SA(b, h) + aoff + m * 2048 + k * 1024); } while (0)
#define PG8_LDB(dst, b, h) do { _Pragma("unroll") for (int n = 0; n < 2; ++n) _Pragma("unroll") for (int k = 0; k < 2; ++k) dst[n][k] = *(const LAS bf16x8*)(lds + PG8_SB(b, h) + boff + n * 2048 + k * 1024); } while (0)
#define PG8_MMA(ai, bj, At, Bt) do { __builtin_amdgcn_s_setprio(1); _Pragma("unroll") for (int m = 0; m < 4; ++m) _Pragma("unroll") for (int n = 0; n < 2; ++n) _Pragma("unroll") for (int k = 0; k < 2; ++k) \
        acc[ai][bj][m][n] = __builtin_amdgcn_mfma_f32_16x16x32_bf16(Bt[n][k], At[m][k], acc[ai][bj][m][n], 0, 0, 0); __builtin_amdgcn_s_setprio(0); } while (0)
#define PG8_WAIT_V(n) asm volatile("s_waitcnt vmcnt(" #n ")" ::: "memory")
#define PG8_WAIT_L(n) asm volatile("s_waitcnt lgkmcnt(" #n ")" ::: "memory")
#define PG8_BAR __builtin_amdgcn_s_barrier()
#define PG8_SCHED __builtin_amdgcn_sched_barrier(0)
    Unit cur, nxt; int ui = 0;
    if (!S.next(0, cur)) return;
    f32x4 acc[2][2][4][2];
#pragma unroll
    for (int a = 0; a < 2; ++a)
#pragma unroll
        for (int b = 0; b < 2; ++b)
#pragma unroll
            for (int m = 0; m < 4; ++m)
#pragma unroll
                for (int n = 0; n < 2; ++n) acc[a][b][m][n] = (f32x4){0.f, 0.f, 0.f, 0.f};
    bf16x8 At[4][2], B0[2][2], B1[2][2];
    const char* cA = (const char*)g.A + (size_t)cur.pm * tstepA; const char* cB = (const char*)g.Bt + (size_t)cur.pn * tstepB;
    PG8_STAGE(PG8_SB(0, 0), cB, voffB); PG8_STAGE(PG8_SA(0, 0), cA, voffA); PG8_STAGE(PG8_SB(0, 1), cB + hstepB, voffB); PG8_STAGE(PG8_SA(0, 1), cA + hstepA, voffA);
    if (wr == 1) PG8_BAR;
    PG8_WAIT_V(4); PG8_BAR;
    PG8_STAGE(PG8_SB(1, 0), cB + kstep, voffB); PG8_STAGE(PG8_SA(1, 0), cA + kstep, voffA); PG8_STAGE(PG8_SB(1, 1), cB + hstepB + kstep, voffB);
    PG8_WAIT_V(6); PG8_BAR;
    for (;;) {
        const bool has_next = S.next(ui + 1, nxt);
        const char* nA = has_next ? (const char*)g.A + (size_t)nxt.pm * tstepA : cA; const char* nB = has_next ? (const char*)g.Bt + (size_t)nxt.pn * tstepB : cB;
        for (int t = 0; t < nt; t += 2) {
            const bool last = (t == nt - 2);
            const char* a1 = cA + (size_t)(t + 1) * kstep;
            const char* a2 = last ? nA : cA + (size_t)(t + 2) * kstep; const char* b2 = last ? nB : cB + (size_t)(t + 2) * kstep;
            const char* a3 = a2 + kstep; const char* b3 = b2 + kstep;
            PG8_LDB(B0, 0, 0); PG8_SCHED; PG8_LDA(At, 0, 0); PG8_STAGE(PG8_SA(1, 1), a1 + hstepA, voffA);
            PG8_WAIT_L(8); PG8_BAR; PG8_WAIT_L(0); PG8_MMA(0, 0, At, B0); PG8_BAR; PG8_SCHED;
            PG8_LDB(B1, 0, 1); PG8_STAGE(PG8_SB(0, 0), b2, voffB);
            PG8_BAR; PG8_WAIT_L(0); PG8_MMA(0, 1, At, B1); PG8_BAR;
            PG8_LDA(At, 0, 1); PG8_STAGE(PG8_SA(0, 0), a2, voffA);
            PG8_BAR; PG8_WAIT_L(0); PG8_MMA(1, 0, At, B0); PG8_BAR; PG8_SCHED;
            PG8_STAGE(PG8_SB(0, 1), b2 + hstepB, voffB);
            PG8_WAIT_V(6); PG8_BAR; PG8_MMA(1, 1, At, B1); PG8_BAR;
            PG8_LDB(B0, 1, 0); PG8_SCHED; PG8_LDA(At, 1, 0); PG8_STAGE(PG8_SA(0, 1), a2 + hstepA, voffA);
            PG8_WAIT_L(8); PG8_BAR; PG8_WAIT_L(0); PG8_MMA(0, 0, At, B0); PG8_BAR; PG8_SCHED;
            PG8_LDB(B1, 1, 1); PG8_STAGE(PG8_SB(1, 0), b3, voffB);
            PG8_BAR; PG8_WAIT_L(0); PG8_MMA(0, 1, At, B1); PG8_BAR;
            PG8_LDA(At, 1, 1); PG8_STAGE(PG8_SA(1, 0), a3, voffA);
            PG8_BAR; PG8_WAIT_L(0); PG8_MMA(1, 0, At, B0); PG8_BAR; PG8_SCHED;
            PG8_STAGE(PG8_SB(1, 1), b3 + hstepB, voffB);
            PG8_WAIT_V(6); PG8_BAR; PG8_MMA(1, 1, At, B1); PG8_BAR;
        }
        E(acc, cur, wr, wc, fr, fq);
        if (!has_next) break;
#pragma unroll
        for (int a = 0; a < 2; ++a)
#pragma unroll
            for (int b = 0; b < 2; ++b)
#pragma unroll
                for (int m = 0; m < 4; ++m)
#pragma unroll
                    for (int n = 0; n < 2; ++n) acc[a][b][m][n] = (f32x4){0.f, 0.f, 0.f, 0.f};
        cur = nxt; cA = nA; cB = nB; ++ui;
    }
    PG8_WAIT_V(0);
    if (wr == 0) PG8_BAR;
    PG8_BAR;
#undef PG8_SA
#undef PG8_SB
#undef PG8_STAGE
#undef PG8_LDA
#undef PG8_LDB
#undef PG8_MMA
#undef PG8_WAIT_V
#undef PG8_WAIT_L
#undef PG8_BAR
#undef PG8_SCHED
}
struct EpiIn {
    u16* O; const float* rstd;
    DI void operator()(const f32x4 (&acc)[2][2][4][2], const Unit& u, int wr, int wc, int fr, int fq) const {
        const int row0 = u.pm * BM + wr * 64 + fr, col0 = u.pn * BM + wc * 32 + 8 * fq;
#pragma unroll
        for (int ai = 0; ai < 2; ++ai)
#pragma unroll
            for (int m = 0; m < 4; ++m) {
                const int r = row0 + ai * HALF + m * 16; const float rs = rstd[r];
                u16* rowp = O + (size_t)r * LDP + col0;
#pragma unroll
                for (int bj = 0; bj < 2; ++bj) {
                    const f32x4 a0 = acc[ai][bj][m][0], a1 = acc[ai][bj][m][1];
                    uint4 v; v.x = pk2(a0[0] * rs, a0[1] * rs); v.y = pk2(a0[2] * rs, a0[3] * rs); v.z = pk2(a1[0] * rs, a1[1] * rs); v.w = pk2(a1[2] * rs, a1[3] * rs);
                    *(uint4*)(rowp + bj * HALF) = v;
                }
            }
    }
};
struct EpiOut {
    u16* Xhi; u16* Xlo; const float* xin; u16* projdead; bool last;
    DI void operator()(const f32x4 (&acc)[2][2][4][2], const Unit& u, int wr, int wc, int fr, int fq) const {
        const int row0 = u.pm * BM + wr * 64 + fr, col0 = u.pn * BM + wc * 32 + 8 * fq;
#pragma unroll
        for (int ai = 0; ai < 2; ++ai)
#pragma unroll
            for (int m = 0; m < 4; ++m) {
                const int r = row0 + ai * HALF + m * 16;
#pragma unroll
                for (int bj = 0; bj < 2; ++bj) {
                    const size_t o = (size_t)r * 2048 + col0 + bj * HALF; const size_t oi = (size_t)r * 1024 + col0 + bj * HALF;
                    float res[8];
                    if (xin) { const float4 x0 = *(const float4*)(xin + oi), x1 = *(const float4*)(xin + oi + 4);
                        res[0] = x0.x; res[1] = x0.y; res[2] = x0.z; res[3] = x0.w; res[4] = x1.x; res[5] = x1.y; res[6] = x1.z; res[7] = x1.w; }
                    else unpack8(*(const uint4*)(Xhi + o), res);
                    const f32x4 a0 = acc[ai][bj][m][0], a1 = acc[ai][bj][m][1];
                    float xn[8];
#pragma unroll
                    for (int e = 0; e < 4; ++e) { xn[e] = res[e] + a0[e]; xn[4 + e] = res[4 + e] + a1[e]; }
                    if (last) {
                        float* dp = (float*)(projdead + (size_t)r * LDP + 2048) + col0 + bj * HALF;
                        *(float4*)dp = make_float4(xn[0], xn[1], xn[2], xn[3]); *(float4*)(dp + 4) = make_float4(xn[4], xn[5], xn[6], xn[7]);
                    } else {
                        *(uint4*)(Xhi + o) = pack8f(xn);
                    }
                }
            }
    }
};
}

DI void convert_weights(const Params& p, float* sm, const int tid) {
    const int NT_IN = 112 * 16, NT_OUT = 16 * 32;
    const int total = 2 * (NT_IN + NT_OUT);
    for (int t = blockIdx.x; t < total; t += gridDim.x) {
        const int l = t / (NT_IN + NT_OUT); int tt = t % (NT_IN + NT_OUT);
        const float* W; u16* Wt; int Ksz, ldw, n0, k0, s0; const float* sc;
        if (tt < NT_IN) { const int nt_ = tt / 16, kt = tt % 16; n0 = nt_ * 64; k0 = kt * 64; W = p.w_in + (size_t)l * 1024 * IN_COLS; ldw = IN_COLS; s0 = src_col(n0);
            Wt = (u16*)(p.ws + WS_WTIN) + (size_t)l * LDP * 1024; Ksz = 1024; sc = p.norm_w + l * 1024; }
        else { tt -= NT_IN; const int nt_ = tt / 32, kt = tt % 32; n0 = nt_ * 64; k0 = kt * 64; W = p.w_out + (size_t)l * 2048 * 1024; ldw = 1024; s0 = n0;
            Wt = (u16*)(p.ws + WS_WTOUT) + (size_t)l * 1024 * 2048; Ksz = 2048; sc = nullptr; }
        {
            const int kr = tid >> 3, c8 = (tid & 7) * 8;
            const float* src = W + (size_t)(k0 + kr) * ldw + s0 + c8;
            const float s = sc ? sc[k0 + kr] : 1.f;
#pragma unroll
            for (int e = 0; e < 8; ++e) sm[kr * 65 + c8 + e] = src[e] * s;
        }
        __syncthreads();
        {
            const int nr = tid >> 3, k8 = (tid & 7) * 8; float f[8];
#pragma unroll
            for (int e = 0; e < 8; ++e) f[e] = sm[(k8 + e) * 65 + nr];
            *(uint4*)(Wt + (size_t)(n0 + nr) * Ksz + k0 + k8) = pack8f(f);
        }
        __syncthreads();
    }
}

template <int MODE>
DI void prep_rows(const float* xf, u16* xh, int nrows, u16* hi, int hstride, bool whi, float* rstd, float* gates, float* copyf, const float* wg  , int gw, int ngw, int lane) {
    for (int r = gw; r < nrows; r += ngw) {
        float x[16];
#pragma unroll
        for (int i = 0; i < 4; ++i) {
            const int k = i * 256 + lane * 4;
            if (MODE == 0) { const float4 v = *(const float4*)(xf + (size_t)r * 1024 + k); x[4 * i] = v.x; x[4 * i + 1] = v.y; x[4 * i + 2] = v.z; x[4 * i + 3] = v.w;
                if (copyf) *(float4*)(copyf + (size_t)r * 1024 + k) = v; }
            else { const uint2 h = *(const uint2*)(xh + (size_t)r * 2048 + k);
                x[4 * i] = lo16(h.x); x[4 * i + 1] = hi16(h.x); x[4 * i + 2] = lo16(h.y); x[4 * i + 3] = hi16(h.y); }
        }
        float ss = 0.f;
#pragma unroll
        for (int i = 0; i < 16; ++i) ss += x[i] * x[i];
        ss = wsum(ss);
        const float rs = rsqrtf(ss * (1.f / 1024.f) + EPS);
        if (whi) {
#pragma unroll
            for (int i = 0; i < 4; ++i) { uint2 v; v.x = pk2(x[4 * i], x[4 * i + 1]); v.y = pk2(x[4 * i + 2], x[4 * i + 3]); *(uint2*)(hi + (size_t)r * hstride + i * 256 + lane * 4) = v; }
        }
        float acc[16];
        {
            int ln = lane; OPQ(ln);
#pragma unroll
            for (int j = 0; j < 16; ++j) {
                float a = 0.f;
#pragma unroll
                for (int i = 0; i < 4; ++i) { const f32x4 w = *(const f32x4*)(wg + j * 1024 + i * 256 + ln * 4); a += x[4 * i] * w[0] + x[4 * i + 1] * w[1] + x[4 * i + 2] * w[2] + x[4 * i + 3] * w[3]; }
                acc[j] = a;
            }
        }
        float b8[8], b4[4], b2[2], b1;
        { const bool h = (lane & 1) != 0;
#pragma unroll
          for (int i = 0; i < 8; ++i) { const float snd = h ? acc[i] : acc[i + 8], kp = h ? acc[i + 8] : acc[i]; b8[i] = kp + __shfl_xor(snd, 1); } }
        { const bool h = (lane & 2) != 0;
#pragma unroll
          for (int i = 0; i < 4; ++i) { const float snd = h ? b8[i] : b8[i + 4], kp = h ? b8[i + 4] : b8[i]; b4[i] = kp + __shfl_xor(snd, 2); } }
        { const bool h = (lane & 4) != 0;
#pragma unroll
          for (int i = 0; i < 2; ++i) { const float snd = h ? b4[i] : b4[i + 2], kp = h ? b4[i + 2] : b4[i]; b2[i] = kp + __shfl_xor(snd, 4); } }
        { const bool h = (lane & 8) != 0; const float snd = h ? b2[0] : b2[1], kp = h ? b2[1] : b2[0]; b1 = kp + __shfl_xor(snd, 8); }
        b1 += __shfl_xor(b1, 16); b1 += __shfl_xor(b1, 32);
        const int jg = ((lane & 1) << 3) | ((lane & 2) << 1) | ((lane & 4) >> 1) | ((lane & 8) >> 3);
        if (lane < 16) gates[(size_t)r * 16 + jg] = b1 * rs;
        if (lane == 0) rstd[r] = rs;
    }
}
DI void build_wg(const Params& p, int l, float* wg, const int tid) {
    for (int idx = tid; idx < 16 * 1024; idx += 512) {
        const int k = idx >> 4, j = idx & 15;
        const int col = j < 8 ? 2048 + j : 5128 + (j - 8);
        wg[j * 1024 + k] = p.norm_w[l * 1024 + k] * p.w_in[((size_t)l * 1024 + k) * IN_COLS + col];
    }
}

template <int MODE>
DI void sample_gemm(const u16* A, int lda, const u16* Bt, int N, int K, int gw, int ngw, int lane, u16* sproj, const float* srstd, const float* resid, float* ys) {
    const int fr = lane & 15, fq = lane >> 4;
    const int ntasks = 8 * (N / 16);
    for (int t = gw; t < ntasks; t += ngw) {
        const int rt = t & 7, ct = t >> 3;
        const u16* ap = A + (size_t)(rt * 16 + fr) * lda + 8 * fq;
        const u16* bp = Bt + (size_t)(ct * 16 + fr) * K + 8 * fq;
        f32x4 acc = (f32x4){0.f, 0.f, 0.f, 0.f};
#pragma unroll 16
        for (int k = 0; k < K; k += 32) acc = MFMA16(as_frag(ldg16(ap + k)), as_frag(ldg16(bp + k)), acc);
#pragma unroll
        for (int j = 0; j < 4; ++j) {
            const int r = rt * 16 + 4 * fq + j, c = ct * 16 + fr;
            if (MODE == 0) sproj[(size_t)r * LDP + c] = f2bf(acc[j] * srstd[r]);
            else ys[(size_t)r * 1024 + c] = resid[(size_t)r * 1024 + c] + acc[j];
        }
    }
}

template <int MODE, int NV>
DI void chain_mr(unsigned char* sm, const int ht_o, const int hw, const int lane_o, u16* seq, const float* gates,
                 const int nch, const int pos0, const int h,
                 const float* initC, const float* initN, const float* initM, float* outC, float* outN, float* outM,
                 const float* normw, const float gbi, const float gbf) {
    constexpr int nvalid = NV;
    const int fr_o = lane_o & 15, fq_o = lane_o >> 4;
    const int fr = fr_o, fq = fq_o, ht = ht_o, lane = lane_o;
    u16* sQ = (u16*)sm; u16* sK = (u16*)(sm + 9216); u16* sKW = (u16*)(sm + 18432); u16* sV = (u16*)(sm + 27648); u16* sP = (u16*)(sm + 45056);
    u16* sH = (u16*)sm;
    float* fb = (float*)(sm + 54272);
    float* sCV = fb; float* sMV = fb + 64; float* sWI = fb + 128; float* sEMT = fb + 192; float* sDA = fb + 256; float* sDB = fb + 320; float* sN = fb + 384;
    float* sSQ = fb + 448; float* sSM = fb + 704;
    const int qoff = MODE == 0 ? 2048 + h * 64 : 3584 + h * 64;
    const int koff = MODE == 0 ? 2304 + h * 64 : 3840 + h * 64;
    const int voff = MODE == 0 ? h * 128 : 512 + h * 128;
    const int g1off = MODE == 0 ? 2560 + h * 128 : 4096 + h * 128;
    const int g2off = 3072 + h * 128;
    const float lg = log1pf(-exp2f(-5.f - (float)h));

    f32x4 Cacc[4][2];
#pragma unroll
    for (int m = 0; m < 4; ++m)
#pragma unroll
        for (int n = 0; n < 2; ++n)
#pragma unroll
            for (int j = 0; j < 4; ++j) { const int k = 16 * m + 4 * fq + j, v = 32 * hw + 16 * n + fr; Cacc[m][n][j] = initC ? initC[k * 128 + v] : 0.f; }
    if (MODE == 0 && ht < 64) sN[ht] = initN ? initN[ht] : 0.f;
    float mprev = (MODE == 0) ? (initM ? initM[0] : -1e30f) : 0.f;
    float frq[8];
    if (MODE == 1) {
#pragma unroll
        for (int e = 0; e < 8; ++e) { const int j = (lane & 3) * 8 + e; frq[e] = exp2f(-(float)j * (13.287712379549449f / 32.f)) * 0.15915494309189535f; }
    }
    const int qrow = ht >> 3, qcol = (ht & 7) * 8;
    uint4 pq[2], pk[2], pv[4], pg1[4], pg2[4]; float gi = 0.f, gf = 0.f;
#define MR_OFFQ(i) ((unsigned)((((i) * 32 + (ht >> 3)) < nvalid ? ((i) * 32 + (ht >> 3)) : 0) * LDP + qoff + (ht & 7) * 8))
#define MR_OKQ(i) (((i) * 32 + (ht >> 3)) < nvalid)
#define MR_OFFV(i) ((unsigned)((((i) * 16 + (ht >> 4)) < nvalid ? ((i) * 16 + (ht >> 4)) : 0) * LDP + voff + (ht & 15) * 8))
#define MR_OKV(i) (((i) * 16 + (ht >> 4)) < nvalid)
#define MR_LOAD(c) do { const u16* cb_ = seq + (size_t)(c) * 64 * LDP; \
        _Pragma("unroll") for (int i = 0; i < 2; ++i) { pq[i] = ldsel(cb_, MR_OFFQ(i), MR_OKQ(i)); pk[i] = ldsel(cb_ + (koff - qoff), MR_OFFQ(i), MR_OKQ(i)); } \
        _Pragma("unroll") for (int i = 0; i < 4; ++i) pv[i] = ldsel(cb_, MR_OFFV(i), MR_OKV(i)); \
        if (MODE == 0) { const float* gp = gates + (size_t)(c) * 64 * 16; const unsigned og_ = (unsigned)((lane < nvalid ? lane : 0) * 16 + h); gi = gp[og_]; gf = gp[og_ + 4]; } } while (0)
    MR_LOAD(0);
    __syncthreads();
    for (int c = 0; c < nch; ++c) {
        int fr = fr_o, fq = fq_o, ht = ht_o, lane = lane_o; OPQ(fr); OPQ(fq); OPQ(ht); OPQ(lane);
        const int qrow = ht >> 3, qcol = (ht & 7) * 8;
        float wk_l, wc, mnew = 0.f;
        if (MODE == 0) {
            const float ig = (lane < nvalid) ? gi + gbi : -1e30f;
            const float lf = (lane < nvalid) ? logsigf_(gf + gbf) : 0.f;
            const float b = wscan_sum(lf, lane);
            const float cval = ig - b;
            const float pm = wscan_max(cval, lane);
            const float Ml = fmaxf(mprev, pm);
            const float blast = __shfl(b, 63), M63 = __shfl(Ml, 63);
            wk_l = __expf(cval - M63); wc = __expf(mprev - M63); mnew = blast + M63;
            if (hw == 0) { sCV[lane] = cval; sMV[lane] = Ml; sWI[lane] = __expf(mprev - Ml); sEMT[lane] = __expf(-(b + Ml)); }
        } else {
            wk_l = (lane < nvalid) ? __expf((float)(nvalid - 1 - lane) * lg) : 0.f; wc = __expf((float)nvalid * lg);
            if (hw == 0) sWI[lane] = __expf((float)(lane + 1) * lg);
        }
#pragma unroll
        for (int i = 0; i < 2; ++i) {
            const int row = i * 32 + qrow;
            float kf[8];
            if (MODE == 1) {
                float qf[8], qp[8], kp[8];
                uint4 qv = pq[i], kv = pk[i], qo, ko;
                qo.x = __shfl_xor(qv.x, 4); qo.y = __shfl_xor(qv.y, 4); qo.z = __shfl_xor(qv.z, 4); qo.w = __shfl_xor(qv.w, 4);
                ko.x = __shfl_xor(kv.x, 4); ko.y = __shfl_xor(kv.y, 4); ko.z = __shfl_xor(kv.z, 4); ko.w = __shfl_xor(kv.w, 4);
                unpack8(qv, qf); unpack8(kv, kf); unpack8(qo, qp); unpack8(ko, kp);
                const float sgn = (lane & 4) ? 1.f : -1.f;
                const float pos = (float)(pos0 + c * 64 + row);
#pragma unroll
                for (int e = 0; e < 8; ++e) {
                    float t = pos * frq[e]; t = t - rintf(t);
                    const float cs = __builtin_amdgcn_cosf(t), sn = __builtin_amdgcn_sinf(t);
                    qf[e] = qf[e] * cs + sgn * qp[e] * sn; kf[e] = kf[e] * cs + sgn * kp[e] * sn;
                }
                *(uint4*)(sQ + row * 72 + qcol) = pack8f(qf); *(uint4*)(sK + row * 72 + qcol) = pack8f(kf);
            } else {
                *(uint4*)(sQ + row * 72 + qcol) = pq[i]; *(uint4*)(sK + row * 72 + qcol) = pk[i];
                unpack8(pk[i], kf);
            }
            const float wkr = __shfl(wk_l, row);
#pragma unroll
            for (int e = 0; e < 8; ++e) kf[e] *= wkr;
            *(uint4*)(sKW + row * 72 + qcol) = pack8f(kf);
            __builtin_amdgcn_sched_barrier(0);
        }
#pragma unroll
        for (int i = 0; i < 4; ++i) {
            const int id = i * 256 + ht, row = id >> 4, col = (id & 15) * 8;
            *(uint4*)(sV + row * 136 + col) = pv[i];
        }
        LBAR(); OPQ(fr); OPQ(fq); OPQ(ht); OPQ(lane);
        if (c + 1 < nch) MR_LOAD(c + 1);
        { const u16* cb_ = seq + (size_t)c * 64 * LDP;
#pragma unroll
        for (int i = 0; i < 4; ++i) { pg1[i] = ldsel(cb_ + (g1off - voff), MR_OFFV(i), MR_OKV(i)); if (MODE == 0) pg2[i] = ldsel(cb_ + (g2off - voff), MR_OFFV(i), MR_OKV(i)); } }
        f32x4 O[4][2];
#pragma unroll
        for (int m = 0; m < 4; ++m)
#pragma unroll
            for (int n = 0; n < 2; ++n) O[m][n] = (f32x4){0.f, 0.f, 0.f, 0.f};
#pragma unroll
        for (int t = 0; t < 2; ++t) {
            bf16x8 Bf[2];
#pragma unroll
            for (int n = 0; n < 2; ++n) Bf[n] = pack_acc2(Cacc[2 * t][n], Cacc[2 * t + 1][n]);
#pragma unroll
            for (int m = 0; m < 4; ++m) { const bf16x8 A = ldfrag2(sQ + (16 * m + fr) * 72 + 32 * t + 4 * fq);
#pragma unroll
                for (int n = 0; n < 2; ++n) O[m][n] = MFMA16(A, Bf[n], O[m][n]); }
        }
#pragma unroll
        for (int m = 0; m < 4; ++m) { const f32x4 w4 = *(const f32x4*)(sWI + 16 * m + 4 * fq);
#pragma unroll
            for (int n = 0; n < 2; ++n)
#pragma unroll
                for (int j = 0; j < 4; ++j) O[m][n][j] *= 0.125f * w4[j]; }
        {
            const f32x4 M4 = (MODE == 0) ? *(const f32x4*)(sMV + 16 * hw + 4 * fq) : (f32x4){0.f, 0.f, 0.f, 0.f};
            float rsum[4] = {0.f, 0.f, 0.f, 0.f};
#pragma unroll
            for (int n = 0; n < 4; ++n) {
                if (n <= hw) {
                    f32x4 S = (f32x4){0.f, 0.f, 0.f, 0.f};
#pragma unroll
                    for (int t = 0; t < 2; ++t) S = MFMA16(ldfrag(sQ + (16 * hw + fr) * 72 + 32 * t + 8 * fq), ldfrag(sK + (16 * n + fr) * 72 + 32 * t + 8 * fq), S);
                    const int s = 16 * n + fr; const float cs = (MODE == 0) ? sCV[s] : 0.f;
#pragma unroll
                    for (int j = 0; j < 4; ++j) {
                        const int l = 16 * hw + 4 * fq + j;
                        float w;
                        if (MODE == 0) w = (s <= l) ? 0.125f * __expf(cs - M4[j]) : 0.f; else w = (s <= l) ? 0.125f * __expf((float)(l - s) * lg) : 0.f;
                        const float pp = S[j] * w; rsum[j] += pp; sP[l * 72 + s] = f2bf(pp);
                    }
                } else {
#pragma unroll
                    for (int j = 0; j < 4; ++j) sP[(16 * hw + 4 * fq + j) * 72 + 16 * n + fr] = 0;
                }
            }
            if (MODE == 0) {
#pragma unroll
                for (int j = 0; j < 4; ++j) { const float r = red16(rsum[j]); if (fr == 0) sDA[16 * hw + 4 * fq + j] = r; }
            }
        }
        float nn = 0.f;
        if (MODE == 0) {
            const int l = ht >> 2, part = ht & 3; float a = 0.f, b2 = 0.f;
#pragma unroll
            for (int e = 0; e < 16; ++e) { a += bf2f(sQ[l * 72 + part * 16 + e]) * sN[part * 16 + e]; b2 += bf2f(sKW[(part * 16 + e) * 72 + l]); }
            a += __shfl_xor(a, 1); a += __shfl_xor(a, 2); b2 += __shfl_xor(b2, 1); b2 += __shfl_xor(b2, 2);
            if (part == 0) sDB[l] = 0.125f * a;
            nn = wc * sN[l] + b2;
        }
        LBAR(); OPQ(fr); OPQ(fq); OPQ(ht); OPQ(lane);
        if (MODE == 0 && (ht & 3) == 0) sN[ht >> 2] = nn;
#pragma unroll
        for (int m = 0; m < 4; ++m)
#pragma unroll
            for (int n = 0; n < 2; ++n)
#pragma unroll
                for (int j = 0; j < 4; ++j) Cacc[m][n][j] *= wc;
#pragma unroll
        for (int t = 0; t < 2; ++t) {
            bf16x8 Bv[2];
#pragma unroll
            for (int n = 0; n < 2; ++n) Bv[n] = ldfrag_tr(sV + (32 * t + 8 * fq + ((fr >> 2) & 3)) * 136 + 32 * hw + 16 * n + 4 * (fr & 3), 136);
#pragma unroll
            for (int m = 0; m < 4; ++m) { const bf16x8 Ap = ldfrag(sP + (16 * m + fr) * 72 + 32 * t + 8 * fq); const bf16x8 Ak = ldfrag_tr(sKW + (32 * t + 8 * fq + ((fr >> 2) & 3)) * 72 + 16 * m + 4 * (fr & 3), 72);
#pragma unroll
                for (int n = 0; n < 2; ++n) { O[m][n] = MFMA16(Ap, Bv[n], O[m][n]); Cacc[m][n] = MFMA16(Ak, Bv[n], Cacc[m][n]); } }
        }
#pragma unroll
        for (int m = 0; m < 4; ++m) {
            f32x4 dn = (f32x4){1.f, 1.f, 1.f, 1.f};
            if (MODE == 0) { const f32x4 da = *(const f32x4*)(sDA + 16 * m + 4 * fq), db = *(const f32x4*)(sDB + 16 * m + 4 * fq), wi = *(const f32x4*)(sWI + 16 * m + 4 * fq), em = *(const f32x4*)(sEMT + 16 * m + 4 * fq);
#pragma unroll
                for (int j = 0; j < 4; ++j) dn[j] = __builtin_amdgcn_rcpf(fmaxf(fabsf(da[j] + wi[j] * db[j]), em[j])); }
#pragma unroll
            for (int j = 0; j < 4; ++j) {
                const int l = 16 * m + 4 * fq + j;
                const float h0 = O[m][0][j] * dn[j], h1 = O[m][1][j] * dn[j];
                float sq = h0 * h0 + h1 * h1, su = h0 + h1;
                sq = red16(sq); if (MODE == 1) su = red16(su);
                if (fr == 0) { sSQ[hw * 64 + l] = sq; if (MODE == 1) sSM[hw * 64 + l] = su; }
                sH[l * 136 + 32 * hw + fr] = f2bf(h0); sH[l * 136 + 32 * hw + 16 + fr] = f2bf(h1);
            }
        }
        LBAR(); OPQ(fr); OPQ(fq); OPQ(ht); OPQ(lane);
#pragma unroll
        for (int i = 0; i < 4; ++i) {
            const int id = i * 256 + ht, row = id >> 4, col = (id & 15) * 8;
            if (row < nvalid) {
                const float ssq = sSQ[row] + sSQ[64 + row] + sSQ[128 + row] + sSQ[192 + row];
                float hv[8], g1[8], o[8]; unpack8(*(const uint4*)(sH + row * 136 + col), hv); unpack8(pg1[i], g1);
                if (MODE == 0) {
                    float g2[8]; unpack8(pg2[i], g2);
                    const float rs = rsqrtf(ssq * (1.f / 128.f) + EPS);
#pragma unroll
                    for (int e = 0; e < 8; ++e) o[e] = hv[e] * rs * normw[col + e] * sigmoidf_(g1[e]) * siluf_(g2[e]);
                } else {
                    const float mean = (sSM[row] + sSM[64 + row] + sSM[128 + row] + sSM[192 + row]) * (1.f / 128.f);
                    const float var = fmaxf(ssq * (1.f / 128.f) - mean * mean, 0.f);
                    const float rs = rsqrtf(var + EPS);
#pragma unroll
                    for (int e = 0; e < 8; ++e) o[e] = (hv[e] - mean) * rs * siluf_(g1[e]);
                }
                *(uint4*)(seq + (size_t)c * 64 * LDP + (size_t)MR_OFFV(i)) = pack8f(o);
            }
            __builtin_amdgcn_sched_barrier(0);
        }
        mprev = mnew;
        LBAR(); OPQ(fr); OPQ(fq); OPQ(ht); OPQ(lane);
    }
#undef MR_LOAD
#undef MR_OFFQ
#undef MR_OKQ
#undef MR_OFFV
#undef MR_OKV
    OPQS(outC); OPQS(outN); OPQS(outM);
#pragma unroll
    for (int m = 0; m < 4; ++m)
#pragma unroll
        for (int n = 0; n < 2; ++n)
#pragma unroll
            for (int j = 0; j < 4; ++j) { const int k = 16 * m + 4 * fq + j, v = 32 * hw + 16 * n + fr; outC[k * 128 + v] = Cacc[m][n][j]; }
    if (MODE == 0) { if (ht < 64) outN[ht] = sN[ht]; if (ht == 0) outM[0] = mprev; }
}

template <int NV>
DI void chain_hgrn(unsigned char* sm, const int tid_o, const int w, const int lane_o, u16* seq, const int nch, const int h,
                   const float* lbraw, const int layer, const float* initS, float* outS, const float* normw) {
    constexpr int nvalid = NV;
    const int fr_o = lane_o & 15, fq_o = lane_o >> 4;
    const int fr = fr_o, fq = fq_o, tid = tid_o;
    float* LFB = (float*)sm;
    u16* sQ = (u16*)(sm + 33792); u16* sK = (u16*)(sm + 51200); u16* sKW = (u16*)(sm + 68608); u16* sV = (u16*)(sm + 86016); u16* sP = (u16*)(sm + 103424);
    u16* sH = sQ;
    float* TOT = (float*)(sm + 112640); float* BLAST = (float*)(sm + 114688); float* DEC = (float*)(sm + 115200); float* SSQ = (float*)(sm + 115712);
    const int qoff = 5632 + h * 128, foff = 6144 + h * 128, ioff = 6656 + h * 128, goff = 1536 + h * 128;
    const int k0 = (tid & 15) * 8;
    float lbv[8];
#pragma unroll
    for (int e = 0; e < 8; ++e) { const int cidx = h * 128 + k0 + e; lbv[e] = (float)layer * sigmoidf_(lbraw[512 + cidx] - lbraw[cidx]); }
    f32x4 Sacc[8];
#pragma unroll
    for (int m = 0; m < 8; ++m)
#pragma unroll
        for (int j = 0; j < 4; ++j) Sacc[m][j] = initS ? initS[(16 * m + 4 * fq + j) * 128 + 16 * w + fr] : 0.f;
    uint4 phq[2], phf[2], phi[2], pg[2];
#define HG_OFF(i) ((unsigned)((((i) * 32 + (tid >> 4)) < nvalid ? ((i) * 32 + (tid >> 4)) : 0) * LDP + qoff + (tid & 15) * 8))
#define HG_OK(i) (((i) * 32 + (tid >> 4)) < nvalid)
#define HG_LOAD(c) do { const u16* cb_ = seq + (size_t)(c) * 64 * LDP; _Pragma("unroll") for (int i = 0; i < 2; ++i) { \
        phq[i] = ldsel(cb_, HG_OFF(i), HG_OK(i)); phf[i] = ldsel(cb_ + (foff - qoff), HG_OFF(i), HG_OK(i)); phi[i] = ldsel(cb_ + (ioff - qoff), HG_OFF(i), HG_OK(i)); } } while (0)
    HG_LOAD(0);
    __syncthreads();
    for (int c = 0; c < nch; ++c) {
        int fr = fr_o, fq = fq_o, tid = tid_o; OPQ(fr); OPQ(fq); OPQ(tid);
        const int k0 = (tid & 15) * 8;
        float qf[2][8], kk[2][8];
#pragma unroll
        for (int i = 0; i < 2; ++i) {
            const int row = (i * 512 + tid) >> 4;
            float hf[8], lf[8]; unpack8(phq[i], qf[i]); unpack8(phf[i], hf);
#pragma unroll
            for (int e = 0; e < 8; ++e) {
                const float sg = sigmoidf_(hf[e]);
                if (row < nvalid) { lf[e] = __logf(lbv[e] + (1.f - lbv[e]) * sg); kk[i][e] = (1.f - lbv[e]) * (1.f - sg); } else { lf[e] = 0.f; kk[i][e] = 0.f; }
            }
            *(f32x4*)(LFB + row * 132 + k0) = (f32x4){lf[0], lf[1], lf[2], lf[3]}; *(f32x4*)(LFB + row * 132 + k0 + 4) = (f32x4){lf[4], lf[5], lf[6], lf[7]};
            *(uint4*)(sV + row * 136 + k0) = phi[i];
        }
        LBAR(); OPQ(fr); OPQ(fq); OPQ(tid);
        {
            const int k = tid & 127, seg = tid >> 7; float loc[16], run = 0.f;
#pragma unroll
            for (int i = 0; i < 16; ++i) { run += LFB[(16 * seg + i) * 132 + k]; loc[i] = run; }
            TOT[seg * 128 + k] = run;
            LBAR(); OPQ(fr); OPQ(fq); OPQ(tid);
            float off = 0.f;
#pragma unroll
            for (int s2 = 0; s2 < 3; ++s2) if (s2 < seg) off += TOT[s2 * 128 + k];
#pragma unroll
            for (int i = 0; i < 16; ++i) LFB[(16 * seg + i) * 132 + k] = loc[i] + off;
            if (seg == 3) { const float bl = off + run; BLAST[k] = bl; DEC[k] = __expf(bl); }
        }
        LBAR(); OPQ(fr); OPQ(fq); OPQ(tid);
#pragma unroll
        for (int i = 0; i < 2; ++i) {
            const int row = (i * 512 + tid) >> 4;
            const f32x4 b0 = *(const f32x4*)(LFB + row * 132 + k0), b1 = *(const f32x4*)(LFB + row * 132 + k0 + 4);
            const f32x4 l0 = *(const f32x4*)(BLAST + k0), l1 = *(const f32x4*)(BLAST + k0 + 4);
            float qt[8], kt[8], kw[8];
#pragma unroll
            for (int e = 0; e < 8; ++e) {
                const float b = e < 4 ? b0[e & 3] : b1[e & 3], bl = e < 4 ? l0[e & 3] : l1[e & 3];
                qt[e] = qf[i][e] * __expf(b); kt[e] = kk[i][e] * __expf(fminf(-b, 80.f));
                kw[e] = kk[i][e] * __expf(bl - b);
            }
            *(uint4*)(sQ + row * 136 + k0) = pack8f(qt); *(uint4*)(sK + row * 136 + k0) = pack8f(kt); *(uint4*)(sKW + row * 136 + k0) = pack8f(kw);
        }
        LBAR(); OPQ(fr); OPQ(fq); OPQ(tid);
        if (c + 1 < nch) HG_LOAD(c + 1);
#pragma unroll
        for (int i = 0; i < 2; ++i) pg[i] = ldsel(seq + (size_t)c * 64 * LDP + goff - qoff, HG_OFF(i), HG_OK(i));
        f32x4 O[4];
#pragma unroll
        for (int m = 0; m < 4; ++m) O[m] = (f32x4){0.f, 0.f, 0.f, 0.f};
#pragma unroll
        for (int t = 0; t < 4; ++t) {
            const bf16x8 Bf = pack_acc2(Sacc[2 * t], Sacc[2 * t + 1]);
#pragma unroll
            for (int m = 0; m < 4; ++m) O[m] = MFMA16(ldfrag2(sQ + (16 * m + fr) * 136 + 32 * t + 4 * fq), Bf, O[m]);
        }
        {
            const int mt = w >> 1;
#pragma unroll
            for (int nn = 0; nn < 2; ++nn) {
                const int n = (w & 1) * 2 + nn;
                if (n <= mt) {
                    f32x4 S = (f32x4){0.f, 0.f, 0.f, 0.f};
#pragma unroll
                    for (int t = 0; t < 4; ++t) S = MFMA16(ldfrag(sQ + (16 * mt + fr) * 136 + 32 * t + 8 * fq), ldfrag(sK + (16 * n + fr) * 136 + 32 * t + 8 * fq), S);
#pragma unroll
                    for (int j = 0; j < 4; ++j) { const int l = 16 * mt + 4 * fq + j, s = 16 * n + fr; sP[l * 72 + s] = (s <= l) ? f2bf(S[j]) : (u16)0; }
                } else {
#pragma unroll
                    for (int j = 0; j < 4; ++j) sP[(16 * mt + 4 * fq + j) * 72 + 16 * n + fr] = 0;
                }
            }
        }
        LBAR(); OPQ(fr); OPQ(fq); OPQ(tid);
#pragma unroll
        for (int m = 0; m < 8; ++m) { const f32x4 d4 = *(const f32x4*)(DEC + 16 * m + 4 * fq);
#pragma unroll
            for (int j = 0; j < 4; ++j) Sacc[m][j] *= d4[j]; }
#pragma unroll
        for (int t = 0; t < 2; ++t) {
            const bf16x8 Bv = ldfrag_tr(sV + (32 * t + 8 * fq + ((fr >> 2) & 3)) * 136 + 16 * w + 4 * (fr & 3), 136);
#pragma unroll
            for (int m = 0; m < 4; ++m) O[m] = MFMA16(ldfrag(sP + (16 * m + fr) * 72 + 32 * t + 8 * fq), Bv, O[m]);
#pragma unroll
            for (int m = 0; m < 8; ++m) Sacc[m] = MFMA16(ldfrag_tr(sKW + (32 * t + 8 * fq + ((fr >> 2) & 3)) * 136 + 16 * m + 4 * (fr & 3), 136), Bv, Sacc[m]);
        }
#pragma unroll
        for (int m = 0; m < 4; ++m)
#pragma unroll
            for (int j = 0; j < 4; ++j) {
                const int l = 16 * m + 4 * fq + j; const float o = O[m][j] * 0.08838834764831845f;
                const float sq = red16(o * o);
                if (fr == 0) SSQ[w * 64 + l] = sq;
                sH[l * 136 + 16 * w + fr] = f2bf(o);
            }
        LBAR(); OPQ(fr); OPQ(fq); OPQ(tid);
#pragma unroll
        for (int i = 0; i < 2; ++i) {
            const int row = (i * 512 + tid) >> 4;
            if (row < nvalid) {
                float ssq = 0.f;
#pragma unroll
                for (int ww = 0; ww < 8; ++ww) ssq += SSQ[ww * 64 + row];
                const float rs = rsqrtf(ssq * (1.f / 128.f) + EPS);
                float hv[8], g[8], o[8]; unpack8(*(const uint4*)(sH + row * 136 + k0), hv); unpack8(pg[i], g);
#pragma unroll
                for (int e = 0; e < 8; ++e) o[e] = hv[e] * rs * normw[k0 + e] * siluf_(g[e]);
                *(uint4*)(seq + (size_t)c * 64 * LDP + goff - qoff + (size_t)HG_OFF(i)) = pack8f(o);
            }
            __builtin_amdgcn_sched_barrier(0);
        }
        LBAR(); OPQ(fr); OPQ(fq); OPQ(tid);
    }
#undef HG_LOAD
#undef HG_OFF
#undef HG_OK
    OPQS(outS);
#pragma unroll
    for (int m = 0; m < 8; ++m)
#pragma unroll
        for (int j = 0; j < 4; ++j) outS[(16 * m + 4 * fq + j) * 128 + 16 * w + fr] = Sacc[m][j];
}

template <int NV>
DI void block_ssd(unsigned char* sm, const int tid_o, const int w, const int lane_o, u16* seq, const float* gates, const int nch, const int g, const int hp,
                  const float* convw, const float* convb, const float* dtb, const float* alog, const float* dsk, const float* snw,
                  const float* initH, const float* initConv, float* outH, float* outConv, float* ssq) {
    constexpr int nvalid = NV;
    const int fr_o = lane_o & 15, fq_o = lane_o >> 4, hh = w >> 2, jw = w & 3, head = g * 4 + hp * 2 + hh;
    const int fr = fr_o, fq = fq_o, lane = lane_o, tid = tid_o;
    u16* sC = (u16*)sm; u16* sB = (u16*)(sm + 17408); u16* sX = (u16*)(sm + 34816);
    u16* sP = (u16*)(sm + 52224 + hh * 9216);
    u16* OB = (u16*)sm;
    float* TAB = (float*)(sm + 70656);
    float* BV = (float*)(sm + 78336); float* DTV = BV + 128; float* WV = BV + 256;
    const int rs8 = w;
    for (int idx = tid; idx < 5 * 384; idx += 512) {
        const int tap = idx / 384, lc = idx - tap * 384, c8 = lc >> 3, e = lc & 7;
        const int ch = (c8 < 16 ? g * 256 + hp * 128 + c8 * 8 : (c8 < 32 ? 512 + g * 128 + (c8 - 16) * 8 : 768 + g * 128 + (c8 - 32) * 8)) + e;
        TAB[idx] = tap < 4 ? convw[tap * 1024 + ch] : convb[ch];
    }
    f32x4 hacc[8];
#pragma unroll
    for (int m = 0; m < 8; ++m)
#pragma unroll
        for (int j = 0; j < 4; ++j) hacc[m][j] = initH ? initH[((size_t)head * 128 + 16 * m + 4 * fq + j) * 64 + 16 * jw + fr] : 0.f;
    const float dtbias = dtb[head], Aneg = -__expf(alog[head]), Dsk = dsk[head];
    uint4 pr[11]; float sdt = 0.f;
#define SSD_CP (lane < 48 ? lane : 47)
#define SSD_GCOL (SSD_CP < 16 ? 4608 + g * 256 + hp * 128 + SSD_CP * 8 : (SSD_CP < 32 ? 4608 + 512 + g * 128 + (SSD_CP - 16) * 8 : 4608 + 768 + g * 128 + (SSD_CP - 32) * 8))
#define SSD_OFFZ(i) ((unsigned)((((i) * 32 + (tid >> 4)) < nvalid ? ((i) * 32 + (tid >> 4)) : 0) * LDP + 1024 + g * 256 + hp * 128 + (tid & 15) * 8))
#define SSD_OKZ(i) (((i) * 32 + (tid >> 4)) < nvalid)
#define SSD_LOAD(c) do { const u16* cb_ = seq + (size_t)(c) * 64 * LDP; const unsigned gc_ = (unsigned)SSD_GCOL; _Pragma("unroll") for (int i = 0; i < 11; ++i) { const int row = 8 * rs8 - 3 + i; \
        const bool ok_ = row < nvalid && ((c) * 64 + row) >= 0; pr[i] = ldsel(cb_ + (ok_ ? row * LDP : 0), gc_, ok_); } \
        sdt = (lane < nvalid) ? gates[(size_t)(c) * 64 * 16 + (unsigned)((lane < nvalid ? lane : 0) * 16 + 8 + head)] : 0.f; } while (0)
    SSD_LOAD(0);
    __syncthreads();
    for (int c = 0; c < nch; ++c) {
        int fr = fr_o, fq = fq_o, lane = lane_o, tid = tid_o; OPQ(fr); OPQ(fq); OPQ(lane); OPQ(tid);
        const int cp = SSD_CP; const bool act = lane < 48; const int gcol = SSD_GCOL;
        {
            const bool useinit = (c == 0 && rs8 == 0 && initConv != nullptr);
            u16* dstp = cp < 16 ? sX + cp * 8 : (cp < 32 ? sB + (cp - 16) * 8 : sC + (cp - 32) * 8);
            uint2 ylo[8];
#pragma unroll 1
            for (int half = 0; half < 2; ++half) {
                f32x4 tw[5];
#pragma unroll
                for (int tp = 0; tp < 5; ++tp) tw[tp] = *(const f32x4*)(TAB + tp * 384 + cp * 8 + half * 4);
                f32x4 acc[8];
#pragma unroll
                for (int i = 0; i < 8; ++i) acc[i] = tw[4];
#pragma unroll
                for (int k = 0; k < 11; ++k) {
                    const unsigned w0 = half ? pr[k].z : pr[k].x, w1 = half ? pr[k].w : pr[k].y;
                    f32x4 cur = (f32x4){lo16(w0), hi16(w0), lo16(w1), hi16(w1)};
                    if (k < 3 && useinit) cur = *(const f32x4*)(initConv + k * 1024 + (gcol - 4608) + half * 4);
#pragma unroll
                    for (int i = 0; i < 8; ++i) {
                        if (k - i >= 0 && k - i <= 3) {
#pragma unroll
                            for (int e = 0; e < 4; ++e) acc[i][e] += tw[k - i][e] * cur[e];
                        }
                    }
                }
#pragma unroll
                for (int i = 0; i < 8; ++i) {
                    const int row = 8 * rs8 + i;
                    float y[4];
#pragma unroll
                    for (int e = 0; e < 4; ++e) y[e] = (row < nvalid) ? siluf_(acc[i][e]) : 0.f;
                    uint2 pk; pk.x = pk2(y[0], y[1]); pk.y = pk2(y[2], y[3]);
                    if (half == 0) ylo[i] = pk;
                    else if (act) { uint4 v; v.x = ylo[i].x; v.y = ylo[i].y; v.z = pk.x; v.w = pk.y; *(uint4*)(dstp + row * 136) = v; }
                }
            }
        }
        float blast;
        {
            const float dt = (lane < nvalid) ? softplusf_(sdt + dtbias) : 0.f;
            const float la = dt * Aneg;
            const float b = wscan_sum(la, lane);
            blast = __shfl(b, 63);
            if (jw == 0) { BV[hh * 64 + lane] = b; DTV[hh * 64 + lane] = dt; WV[hh * 64 + lane] = __expf(blast - b) * dt; }
        }
        LBAR(); OPQ(fr); OPQ(fq); OPQ(lane); OPQ(tid);
        f32x4 O[4];
#pragma unroll
        for (int m = 0; m < 4; ++m) O[m] = (f32x4){0.f, 0.f, 0.f, 0.f};
#pragma unroll
        for (int t = 0; t < 4; ++t) {
            const bf16x8 Bf = pack_acc2(hacc[2 * t], hacc[2 * t + 1]);
#pragma unroll
            for (int m = 0; m < 4; ++m) O[m] = MFMA16(ldfrag2(sC + (16 * m + fr) * 136 + 32 * t + 4 * fq), Bf, O[m]);
        }
#pragma unroll
        for (int m = 0; m < 4; ++m) { const f32x4 b4 = *(const f32x4*)(BV + hh * 64 + 16 * m + 4 * fq);
#pragma unroll
            for (int j = 0; j < 4; ++j) O[m][j] *= __expf(b4[j]); }
        {
            const int mt = jw;
            const f32x4 bl4 = *(const f32x4*)(BV + hh * 64 + 16 * mt + 4 * fq);
#pragma unroll
            for (int n = 0; n < 4; ++n) {
                if (n <= mt) {
                    f32x4 S = (f32x4){0.f, 0.f, 0.f, 0.f};
#pragma unroll
                    for (int t = 0; t < 4; ++t) S = MFMA16(ldfrag(sC + (16 * mt + fr) * 136 + 32 * t + 8 * fq), ldfrag(sB + (16 * n + fr) * 136 + 32 * t + 8 * fq), S);
                    const int s = 16 * n + fr; const float bs = BV[hh * 64 + s], ds = DTV[hh * 64 + s];
#pragma unroll
                    for (int j = 0; j < 4; ++j) { const int l = 16 * mt + 4 * fq + j; sP[l * 72 + s] = (s <= l) ? f2bf(S[j] * __expf(bl4[j] - bs) * ds) : (u16)0; }
                } else {
#pragma unroll
                    for (int j = 0; j < 4; ++j) sP[(16 * mt + 4 * fq + j) * 72 + 16 * n + fr] = 0;
                }
            }
        }
        LBAR(); OPQ(fr); OPQ(fq); OPQ(lane); OPQ(tid);
        {
            const float eb = __expf(blast);
#pragma unroll
            for (int m = 0; m < 8; ++m)
#pragma unroll
                for (int j = 0; j < 4; ++j) hacc[m][j] *= eb;
        }
#pragma unroll
        for (int t = 0; t < 2; ++t) {
            const f32x4 w0 = *(const f32x4*)(WV + hh * 64 + 32 * t + 8 * fq), w1 = *(const f32x4*)(WV + hh * 64 + 32 * t + 8 * fq + 4);
            const bf16x8 Bv = ldfrag_tr(sX + (32 * t + 8 * fq + ((fr >> 2) & 3)) * 136 + hh * 64 + 16 * jw + 4 * (fr & 3), 136);
            float x[8]; unpack8(__builtin_bit_cast(uint4, Bv), x);
#pragma unroll
            for (int e = 0; e < 4; ++e) { x[e] *= w0[e]; x[4 + e] *= w1[e]; }
            const bf16x8 Bw = as_frag(pack8f(x));
#pragma unroll
            for (int m = 0; m < 4; ++m) O[m] = MFMA16(ldfrag(sP + (16 * m + fr) * 72 + 32 * t + 8 * fq), Bv, O[m]);
#pragma unroll
            for (int m = 0; m < 8; ++m) hacc[m] = MFMA16(ldfrag_tr(sB + (32 * t + 8 * fq + ((fr >> 2) & 3)) * 136 + 16 * m + 4 * (fr & 3), 136), Bw, hacc[m]);
        }
#pragma unroll
        for (int m = 0; m < 4; ++m) {
            const int pcol = hh * 64 + 16 * jw + fr;
            const uint2 xr = __builtin_bit_cast(uint2, ld_tr4(sX + (16 * m + 4 * fq + ((fr >> 2) & 3)) * 136 + hh * 64 + 16 * jw + 4 * (fr & 3)));
            const float xs0 = lo16(xr.x), xs1 = hi16(xr.x), xs2 = lo16(xr.y), xs3 = hi16(xr.y);
            const int l0 = 16 * m + 4 * fq;
            OB[(l0 + 0) * 136 + pcol] = f2bf(O[m][0] + Dsk * xs0);
            OB[(l0 + 1) * 136 + pcol] = f2bf(O[m][1] + Dsk * xs1);
            OB[(l0 + 2) * 136 + pcol] = f2bf(O[m][2] + Dsk * xs2);
            OB[(l0 + 3) * 136 + pcol] = f2bf(O[m][3] + Dsk * xs3);
        }
        LBAR(); OPQ(fr); OPQ(fq); OPQ(lane); OPQ(tid);
        if (c + 1 < nch) SSD_LOAD(c + 1);
#pragma unroll
        for (int i = 0; i < 2; ++i) {
            const int id = i * 512 + tid, row = id >> 4, col = (id & 15) * 8;
            float yv[8], z[8], val[8]; unpack8(*(const uint4*)(OB + row * 136 + col), yv); unpack8(ldsel(seq + (size_t)c * 64 * LDP, SSD_OFFZ(i), SSD_OKZ(i)), z);
            float ss = 0.f;
#pragma unroll
            for (int e = 0; e < 8; ++e) { val[e] = yv[e] * siluf_(z[e]); ss += val[e] * val[e]; }
            ss = red16(ss);
            if (row < nvalid) {
                if ((tid & 15) == 0) ssq[(size_t)(c * 64 + row) * 4 + g * 2 + hp] = ss;
                float o[8];
#pragma unroll
                for (int e = 0; e < 8; ++e) o[e] = val[e] * snw[g * 256 + hp * 128 + col + e];
                *(uint4*)(seq + (size_t)c * 64 * LDP + (size_t)SSD_OFFZ(i)) = pack8f(o);
            }
            __builtin_amdgcn_sched_barrier(0);
        }
        LBAR(); OPQ(fr); OPQ(fq); OPQ(lane); OPQ(tid);
    }
#undef SSD_LOAD
#undef SSD_GCOL
#undef SSD_CP
#undef SSD_OFFZ
#undef SSD_OKZ
    OPQS(outH); OPQS(outConv);
#pragma unroll
    for (int m = 0; m < 8; ++m)
#pragma unroll
        for (int j = 0; j < 4; ++j) outH[((size_t)head * 128 + 16 * m + 4 * fq + j) * 64 + 16 * jw + fr] = hacc[m][j];
    if (hp == 0) {
        const int T = (nch - 1) * 64 + nvalid;
        for (int idx = tid; idx < 3 * 512; idx += 512) { const int rr = idx >> 9, ch = g * 512 + (idx & 511);
            outConv[rr * 1024 + ch] = bf2f(seq[(size_t)(T - 3 + rr) * LDP + 4608 + ch]); }
    }
}

template <int MIX>
DI void mixer_phase(const Params& p, int l_in, unsigned char* sm) {
    const int l = __builtin_amdgcn_readfirstlane(l_in);
    u16* proj = (u16*)(p.ws + WS_PROJ); u16* sproj = (u16*)(p.ws + WS_SPROJ);
    const float* gates = (const float*)(p.ws + WS_GATES); const float* sgates = (const float*)(p.ws + WS_SGATES);
    float* out = p.out;
    float* ssqb = (float*)(p.ws + WS_SSQ);
    for (int task = blockIdx.x; task < 288; task += gridDim.x) {
        int tid = threadIdx.x; OPQ(tid);
        const int w = __builtin_amdgcn_readfirstlane(tid >> 6), lane = tid & 63;
        const int tk = __builtin_amdgcn_readfirstlane(task);
        if (MIXON(0) && (tk < 32 || (tk >= 96 && tk < 160))) {
            const bool smp = tk < 32; const int t2 = smp ? tk : tk - 96; const int b = t2 >> 2, g = (t2 >> 1) & 1, hp = t2 & 1;
            u16* seq = smp ? sproj + (size_t)b * 16 * LDP : proj + (size_t)b * SEQ * LDP;
            const float* gt = smp ? sgates + (size_t)b * 16 * 16 : gates + (size_t)b * SEQ * 16;
            const int nb = smp ? DEC_BATCH : BATCH;
            float* oH = out + (smp ? O_SSSD : O_PSSD) + ((size_t)l * nb + b) * 8 * 128 * 64;
            float* oC = out + (smp ? O_SCONV : O_PCONV) + ((size_t)l * nb + b) * 3 * 1024;
            float* sq = ssqb + (smp ? (size_t)(NTOK + b * 16) * 4 : (size_t)b * SEQ * 4);
            if (smp) block_ssd<16>(sm, tid, w, lane, seq, gt, 1, g, hp,
                      p.conv_w + (size_t)l * 4 * 1024, p.conv_b + l * 1024, p.dt_bias + l * 8, p.a_log + l * 8, p.d_skip + l * 8, p.snorm_w + l * 512,
                      smp ? p.st_ssd + ((size_t)l * DEC_BATCH + b) * 8 * 128 * 64 : nullptr, smp ? p.st_conv + ((size_t)l * DEC_BATCH + b) * 3 * 1024 : nullptr, oH, oC, sq);
            else block_ssd<64>(sm, tid, w, lane, seq, gt, 32, g, hp,
                      p.conv_w + (size_t)l * 4 * 1024, p.conv_b + l * 1024, p.dt_bias + l * 8, p.a_log + l * 8, p.d_skip + l * 8, p.snorm_w + l * 512,
                      smp ? p.st_ssd + ((size_t)l * DEC_BATCH + b) * 8 * 128 * 64 : nullptr, smp ? p.st_conv + ((size_t)l * DEC_BATCH + b) * 3 * 1024 : nullptr, oH, oC, sq);
        } else if (MIXON(1) && ((tk >= 32 && tk < 64) || tk >= 224)) {
            const bool smp = tk < 64; const int t2 = smp ? tk - 32 : tk - 224; const int b = t2 >> 2, h = t2 & 3;
            u16* seq = smp ? sproj + (size_t)b * 16 * LDP : proj + (size_t)b * SEQ * LDP;
            const int nb = smp ? DEC_BATCH : BATCH;
            float* oS = out + (smp ? O_SHG : O_PHG) + (((size_t)l * nb + b) * 4 + h) * 128 * 128;
            if (smp) chain_hgrn<16>(sm, tid, w, lane, seq, 1, h, p.lbraw, l,
                       smp ? p.st_hg + (((size_t)l * DEC_BATCH + b) * 4 + h) * 128 * 128 : nullptr, oS, p.hnorm_w + l * 512 + h * 128);
            else chain_hgrn<64>(sm, tid, w, lane, seq, 32, h, p.lbraw, l,
                       smp ? p.st_hg + (((size_t)l * DEC_BATCH + b) * 4 + h) * 128 * 128 : nullptr, oS, p.hnorm_w + l * 512 + h * 128);
        } else if ((tk >= 64 && tk < 96) || (tk >= 160 && tk < 224)) {
            int t2; bool smp, ret;
            if (tk < 80) { smp = true; ret = false; t2 = tk - 64; }
            else if (tk < 96) { smp = true; ret = true; t2 = tk - 80; }
            else if (tk < 192) { smp = false; ret = false; t2 = tk - 160; }
            else { smp = false; ret = true; t2 = tk - 192; }
            const int chain = t2 * 2 + (w >> 2); const int b = chain >> 2, h = chain & 3;
            u16* seq = smp ? sproj + (size_t)b * 16 * LDP : proj + (size_t)b * SEQ * LDP;
            const float* gt = smp ? sgates + (size_t)b * 16 * 16 : gates + (size_t)b * SEQ * 16;
            const int nb = smp ? DEC_BATCH : BATCH;
            const size_t si = ((size_t)l * nb + b) * 4 + h;
            unsigned char* csm = sm + (w >> 2) * 65536;
            if (MIXON(2) && !ret) {
                if (smp) chain_mr<0, 16>(csm, tid & 255, w & 3, lane, seq, gt, 1, 0, h,
                            smp ? p.st_mc + si * 64 * 128 : nullptr, smp ? p.st_mn + si * 64 : nullptr, smp ? p.st_mm + si : nullptr,
                            out + (smp ? O_SMC : O_PMC) + si * 64 * 128, out + (smp ? O_SMN : O_PMN) + si * 64, out + (smp ? O_SMM : O_PMM) + si,
                            p.mnorm_w + l * 512 + h * 128, p.gate_b[l * 8 + h], p.gate_b[l * 8 + 4 + h]);
                else chain_mr<0, 64>(csm, tid & 255, w & 3, lane, seq, gt, 32, 0, h,
                            smp ? p.st_mc + si * 64 * 128 : nullptr, smp ? p.st_mn + si * 64 : nullptr, smp ? p.st_mm + si : nullptr,
                            out + (smp ? O_SMC : O_PMC) + si * 64 * 128, out + (smp ? O_SMN : O_PMN) + si * 64, out + (smp ? O_SMM : O_PMM) + si,
                            p.mnorm_w + l * 512 + h * 128, p.gate_b[l * 8 + h], p.gate_b[l * 8 + 4 + h]);
            } else if (MIXON(3) && ret) {
                if (smp) chain_mr<1, 16>(csm, tid & 255, w & 3, lane, seq, gt, 1, PAST_LEN, h,
                            smp ? p.st_ret + si * 64 * 128 : nullptr, nullptr, nullptr,
                            out + (smp ? O_SRET : O_PRET) + si * 64 * 128, nullptr, nullptr, nullptr, 0.f, 0.f);
                else chain_mr<1, 64>(csm, tid & 255, w & 3, lane, seq, gt, 32, 0, h,
                            smp ? p.st_ret + si * 64 * 128 : nullptr, nullptr, nullptr,
                            out + (smp ? O_SRET : O_PRET) + si * 64 * 128, nullptr, nullptr, nullptr, 0.f, 0.f);
            }
        }
        __syncthreads();
    }
}

DI void final_norm(const Params& p, int gw, int ngw, int lane) {
    const u16* X = (const u16*)(p.ws + WS_PROJ);
    for (int r = gw; r < NTOK + NSTOK; r += ngw) {
        float x[16];
        if (r < NTOK) {
#pragma unroll
            for (int i = 0; i < 4; ++i) { const float4 v = *(const float4*)((const float*)(X + (size_t)r * LDP + 2048) + i * 256 + lane * 4); x[4 * i] = v.x; x[4 * i + 1] = v.y; x[4 * i + 2] = v.z; x[4 * i + 3] = v.w; }
        } else {
#pragma unroll
            for (int i = 0; i < 4; ++i) { const float4 v = *(const float4*)(p.out + O_YS + (size_t)(r - NTOK) * 1024 + i * 256 + lane * 4); x[4 * i] = v.x; x[4 * i + 1] = v.y; x[4 * i + 2] = v.z; x[4 * i + 3] = v.w; }
        }
        float ss = 0.f;
#pragma unroll
        for (int i = 0; i < 16; ++i) ss += x[i] * x[i];
        ss = wsum(ss);
        const float rs = rsqrtf(ss * (1.f / 1024.f) + EPS);
        float* dst = (r < NTOK) ? p.out + O_YP + (size_t)r * 1024 : p.out + O_YS + (size_t)(r - NTOK) * 1024;
#pragma unroll
        for (int i = 0; i < 4; ++i) { const int k = i * 256 + lane * 4; const float4 wv = *(const float4*)(p.fnorm_w + k);
            float4 o; o.x = x[4 * i] * rs * wv.x; o.y = x[4 * i + 1] * rs * wv.y; o.z = x[4 * i + 2] * rs * wv.z; o.w = x[4 * i + 3] * rs * wv.w;
            *(float4*)(dst + k) = o; }
    }
}


#define XB_TMO      128
#define XB_XCNT(j)  (256  + 64 * (j))
#define XB_XSUB(j)  (1280 + 64 * (j))
#define XB_XGEN(j)  (2304 + 64 * (j))
#define XB_TOP      3328
#define XB_TOPGEN   3392
#define XCD_BAR_WORDS 3456
#define XB_SPIN_CAP (1u << 18)
DI unsigned xb_ld(unsigned* p)              { return __hip_atomic_load(p, __ATOMIC_RELAXED, __HIP_MEMORY_SCOPE_AGENT); }
DI unsigned xb_add(unsigned* p, unsigned v) { return __hip_atomic_fetch_add(p, v, __ATOMIC_RELAXED, __HIP_MEMORY_SCOPE_AGENT); }
DI unsigned xb_xcc_id() { return (unsigned)__builtin_amdgcn_s_getreg((3 << 11) | 20) & 0xFu; }
#define XB_SPIN(cond, bar) do { unsigned _sp = 0; while (cond) { __builtin_amdgcn_s_sleep(1); \
    if ((++_sp & 255u) == 0u) { if (xb_ld(&(bar)[XB_TMO])) break; if (_sp > XB_SPIN_CAP) { atomicAdd(&(bar)[XB_TMO], 1u); break; } } } } while (0)
struct XcdBarrier { unsigned* bar; unsigned x; volatile LAS unsigned* st; };
DI void xcd_barrier_post(unsigned* bar) { if (threadIdx.x == 0) (void)xb_add(&bar[XB_XCNT(xb_xcc_id())], 1u); }
DI void xcd_barrier_complete(unsigned* bar, unsigned x, unsigned& nloc, unsigned& nx) {
    const unsigned G = gridDim.x * gridDim.y * gridDim.z;
    unsigned sum, cnt, mine, sp = 0u;
    for (;;) {
        sum = 0u; cnt = 0u; mine = 0u;
#pragma unroll
        for (unsigned j = 0; j < 16; ++j) { const unsigned c = xb_ld(&bar[XB_XCNT(j)]); sum += c; cnt += (c > 0u) ? 1u : 0u; mine = (j == x) ? c : mine; }
        if (sum == G) break;
        __builtin_amdgcn_s_sleep(1);
        if ((++sp & 255u) == 0u) { if (xb_ld(&bar[XB_TMO])) break; if (sp > XB_SPIN_CAP) { atomicAdd(&bar[XB_TMO], 1u); break; } }
    }
    nloc = mine > 0u ? mine : 1u; nx = cnt > 0u ? cnt : 1u;
}
DI void xcd_barrier(const XcdBarrier& b) {
    asm volatile("s_waitcnt vmcnt(0)" ::: "memory");
    __syncthreads();
    if (threadIdx.x == 0) {
        unsigned* bar = b.bar;
        __builtin_amdgcn_s_waitcnt(0);
        unsigned nloc = b.st[0], nx = b.st[1];
        if (nloc == 0u) { xcd_barrier_complete(bar, b.x, nloc, nx); b.st[0] = nloc; b.st[1] = nx; }
        const unsigned old = xb_add(&bar[XB_XSUB(b.x)], 1u);
        const unsigned gen = old / nloc;
        if (old + 1u == (gen + 1u) * nloc) {
            __builtin_amdgcn_fence(__ATOMIC_RELEASE, "agent");
            asm volatile("s_waitcnt vmcnt(0)" ::: "memory");
            const unsigned og = xb_add(&bar[XB_TOP], 1u);
            const unsigned tg = og / nx;
            if (og + 1u == (tg + 1u) * nx) xb_add(&bar[XB_TOPGEN], 1u);
            else XB_SPIN(xb_ld(&bar[XB_TOPGEN]) == tg, bar);
            __builtin_amdgcn_fence(__ATOMIC_ACQUIRE, "agent");
            xb_add(&bar[XB_XGEN(b.x)], 1u);
            asm volatile("s_waitcnt vmcnt(0)" ::: "memory");
        } else {
            XB_SPIN(xb_ld(&bar[XB_XGEN(b.x)]) == gen, bar);
            __builtin_amdgcn_fence(__ATOMIC_ACQUIRE, "agent");
            asm volatile("s_waitcnt vmcnt(0)" ::: "memory");
        }
    }
    __syncthreads();
}
#define GRID_SEAM(first) do { if (first) cg::this_grid().sync(); else { XcdBarrier xb_; xb_.bar = (unsigned*)(p.ws + WS_BAR); xb_.x = xb_xcc_id(); xb_.st = (volatile LAS unsigned*)(LAS unsigned char*)(lds + LDS_BYTES - 16); xcd_barrier(xb_); } } while (0)

template <int PHSEL, int MIX>
DI void run_phases(const Params& p, unsigned char* lds) {
#define PSEL(x) (PHSEL < 0 || PHSEL == (x))
    if (COOP) { volatile LAS unsigned* st_ = (volatile LAS unsigned*)(LAS unsigned char*)(lds + LDS_BYTES - 16); if (threadIdx.x < 2) st_[threadIdx.x] = 0u; __syncthreads(); xcd_barrier_post((unsigned*)(p.ws + WS_BAR)); }
#ifndef PROG
#define PROG 0x876543210ull
#define NPROG 9
#endif
    for (int pi = p.ph_lo; pi < p.ph_hi; ++pi) {
        const int ph = __builtin_amdgcn_readfirstlane((int)((PROG >> (4 * pi)) & 15ull));
#define PH_IDS int tid = threadIdx.x; OPQ(tid); const int w = __builtin_amdgcn_readfirstlane(tid >> 6), lane = tid & 63; const int gw = blockIdx.x * 8 + w, ngw = gridDim.x * 8; (void)gw; (void)ngw; (void)lane
        u16* proj = (u16*)(p.ws + WS_PROJ); u16* sproj = (u16*)(p.ws + WS_SPROJ);
        float* gates = (float*)(p.ws + WS_GATES); float* sgates = (float*)(p.ws + WS_SGATES);
        float* rstd = (float*)(p.ws + WS_RSTD); float* srstd = (float*)(p.ws + WS_SRSTD);
        u16* shi = (u16*)(p.ws + WS_SHI);
        u16* X = (u16*)(p.out + O_YP);
        float* ys = p.out + O_YS;
        if (PSEL(0) && ph == 0) {
            PH_IDS;
            convert_weights(p, (float*)lds, tid);
            build_wg(p, 0, (float*)lds, tid);
            __syncthreads();
            prep_rows<0>(p.x_prompt, nullptr, NTOK, X, 2048, true, rstd, gates, nullptr, (const float*)lds, gw, ngw, lane);
            prep_rows<0>(p.x_sample, nullptr, NSTOK, shi, 1024, true, srstd, sgates, ys, (const float*)lds, gw, ngw, lane);
        } else if (PSEL(4) && ph == 4) {
            PH_IDS;
            build_wg(p, 1, (float*)lds, tid);
            __syncthreads();
            prep_rows<1>(nullptr, X, NTOK, nullptr, 0, false, rstd, gates, nullptr, (const float*)lds, gw, ngw, lane);
            prep_rows<0>(ys, nullptr, NSTOK, shi, 1024, true, srstd, sgates, nullptr, (const float*)lds, gw, ngw, lane);
        } else if (PSEL(1) && (ph == 1 || ph == 5)) {
            PH_IDS;
            const int l = ph == 1 ? 0 : 1;
            const u16* wt = (const u16*)(p.ws + WS_WTIN) + (size_t)l * LDP * 1024;
            sample_gemm<0>(shi, 1024, wt, LDP, 1024, gw, ngw, lane, sproj, srstd, nullptr, nullptr);
            __syncthreads();
            pg8::Gemm g; g.A = X; g.Bt = wt; g.M = NTOK; g.N = LDP; g.K = 1024; g.lda = 2048;
            pg8::StaticOrder S; S.init(g.M, g.N, (int)gridDim.x, (int)blockIdx.x);
            pg8::EpiIn E; E.O = proj; E.rstd = rstd;
            pg8::gemm_phase<pg8::EpiIn>((LAS unsigned char*)lds, g, S, E, tid);
        } else if (PSEL(2) && (ph == 2 || ph == 6)) {
            mixer_phase<MIX>(p, ph == 2 ? 0 : 1, lds);
        } else if (PSEL(3) && (ph == 3 || ph == 7)) {
            PH_IDS;
            const int l = ph == 3 ? 0 : 1;
            const u16* wt = (const u16*)(p.ws + WS_WTOUT) + (size_t)l * 1024 * 2048;
            {
                const float* ssqb = (const float*)(p.ws + WS_SSQ);
                for (int r = gw; r < NTOK + NSTOK; r += ngw) {
                    u16* rowp = (r < NTOK ? proj + (size_t)r * LDP : sproj + (size_t)(r - NTOK) * LDP) + 1024 + lane * 8;
                    const float4 s4 = *(const float4*)(ssqb + (size_t)r * 4);
                    const float tot = (lane >> 5) ? s4.z + s4.w : s4.x + s4.y;
                    const float rs = rsqrtf(tot * (1.f / 256.f) + EPS);
                    float v[8]; unpack8(*(const uint4*)rowp, v);
#pragma unroll
                    for (int e = 0; e < 8; ++e) v[e] *= rs;
                    *(uint4*)rowp = pack8f(v);
                }
                GRID_SEAM(false);
            }
            {
                const int fr = lane & 15, fq = lane >> 4; float* red = (float*)lds;
                const float* resid = l == 0 ? p.x_sample : ys;
                for (int t = blockIdx.x; t < 512; t += gridDim.x) {
                    const int rt = t & 7, ct = t >> 3;
                    const u16* ap = sproj + (size_t)(rt * 16 + fr) * LDP + w * 256 + 8 * fq;
                    const u16* bp = wt + (size_t)(ct * 16 + fr) * 2048 + w * 256 + 8 * fq;
                    f32x4 acc = (f32x4){0.f, 0.f, 0.f, 0.f};
#pragma unroll
                    for (int k = 0; k < 256; k += 32) acc = MFMA16(as_frag(ldg16(ap + k)), as_frag(ldg16(bp + k)), acc);
                    *(f32x4*)(red + (w * 64 + lane) * 4) = acc;
                    __syncthreads();
                    if (w == 0) {
                        f32x4 tot = acc;
#pragma unroll
                        for (int ww = 1; ww < 8; ++ww) { const f32x4 o = *(const f32x4*)(red + (ww * 64 + lane) * 4); tot[0] += o[0]; tot[1] += o[1]; tot[2] += o[2]; tot[3] += o[3]; }
#pragma unroll
                        for (int j = 0; j < 4; ++j) { const size_t o = (size_t)(rt * 16 + 4 * fq + j) * 1024 + ct * 16 + fr; ys[o] = resid[o] + tot[j]; }
                    }
                    __syncthreads();
                }
            }
            pg8::Gemm g; g.A = proj; g.Bt = wt; g.M = NTOK; g.N = 1024; g.K = 2048; g.lda = LDP;
            pg8::StaticOrder S; S.init(g.M, g.N, (int)gridDim.x, (int)blockIdx.x);
            pg8::EpiOut E; E.Xhi = X; E.Xlo = X + 1024; E.xin = l == 0 ? p.x_prompt : nullptr; E.projdead = proj; E.last = (l == 1);
            pg8::gemm_phase<pg8::EpiOut>((LAS unsigned char*)lds, g, S, E, tid);
        } else if (PSEL(8) && ph == 8) {
            PH_IDS;
            final_norm(p, gw, ngw, lane);
        }
        if (pi + 1 < p.ph_hi) { GRID_SEAM(p.ph_hi > 64); }
    }
#undef PSEL
}
#if COOP
__global__ __launch_bounds__(512) void mega(Params p) {
    extern __shared__ __attribute__((aligned(16))) unsigned char lds[];
    run_phases<-1, -1>(p, lds);
}
#else
template <int PHSEL, int MIX>
__global__ __launch_bounds__(512) void phase_k(Params p) {
    extern __shared__ __attribute__((aligned(16))) unsigned char lds[];
    run_phases<PHSEL, MIX>(p, lds);
}
#endif

extern "C" void kernel_launch(void* const* d_in, const int* in_sizes, int n_in, void* d_out, int out_size, void* d_ws, size_t ws_size, hipStream_t stream) {
    static int grid = 0;
    if (grid == 0) {
        if (n_in != 23 || (size_t)out_size != O_END || ws_size < WS_END) { fprintf(stderr, "kernel_launch: unexpected shapes n_in %d out %d ws %zu (need %zu)\n", n_in, out_size, ws_size, (size_t)WS_END); grid = -1; return; }
        int dev = 0, cus = 0, per_cu = 0;
        (void)hipGetDevice(&dev); (void)hipDeviceGetAttribute(&cus, hipDeviceAttributeMultiprocessorCount, dev);
#if COOP
        if (hipFuncSetAttribute((const void*)mega, hipFuncAttributeMaxDynamicSharedMemorySize, LDS_BYTES) != hipSuccess) { fprintf(stderr, "hipFuncSetAttribute failed\n"); grid = -1; return; }
        (void)hipOccupancyMaxActiveBlocksPerMultiprocessor(&per_cu, (const void*)mega, 512, LDS_BYTES);
        (void)hipGetLastError();
#else
        hipError_t e = hipSuccess;
#define SETA(PH, MX) if (e == hipSuccess) e = hipFuncSetAttribute((const void*)phase_k<PH, MX>, hipFuncAttributeMaxDynamicSharedMemorySize, LDS_BYTES)
        SETA(0, -1); SETA(1, -1); SETA(2, 0); SETA(2, 1); SETA(2, 2); SETA(2, 3); SETA(3, -1); SETA(4, -1); SETA(8, -1);
#undef SETA
        if (e != hipSuccess) { fprintf(stderr, "hipFuncSetAttribute failed\n"); grid = -1; return; }
#endif
        if (per_cu < 1) per_cu = 1;
        grid = cus * per_cu; if (grid > 256) grid = 256;
    }
    if (grid < 0) return;
    Params p{};
    p.x_prompt = (const float*)d_in[0]; p.x_sample = (const float*)d_in[1];
    p.st_mc = (const float*)d_in[2]; p.st_mn = (const float*)d_in[3]; p.st_mm = (const float*)d_in[4]; p.st_ret = (const float*)d_in[5];
    p.st_ssd = (const float*)d_in[6]; p.st_conv = (const float*)d_in[7]; p.st_hg = (const float*)d_in[8];
    p.norm_w = (const float*)d_in[9]; p.w_in = (const float*)d_in[10]; p.gate_b = (const float*)d_in[11]; p.mnorm_w = (const float*)d_in[12];
    p.conv_w = (const float*)d_in[13]; p.conv_b = (const float*)d_in[14]; p.dt_bias = (const float*)d_in[15]; p.a_log = (const float*)d_in[16];
    p.d_skip = (const float*)d_in[17]; p.snorm_w = (const float*)d_in[18]; p.lbraw = (const float*)d_in[19]; p.hnorm_w = (const float*)d_in[20];
    p.w_out = (const float*)d_in[21]; p.fnorm_w = (const float*)d_in[22];
    p.out = (float*)d_out; p.ws = (unsigned char*)d_ws;
#if COOP
    p.ph_lo = 0; p.ph_hi = NPROG;
    if (hipMemsetAsync((char*)d_ws + WS_BAR, 0, 16384, stream) != hipSuccess) { fprintf(stderr, "hipMemsetAsync failed\n"); return; }
    void* args[] = {&p};
    hipError_t e = hipLaunchCooperativeKernel((const void*)mega, dim3(grid), dim3(512), args, LDS_BYTES, stream);
    if (e != hipSuccess) fprintf(stderr, "cooperative launch failed: %s (grid %d)\n", hipGetErrorString(e), grid);
#else
#ifndef MAXL
#define MAXL 99
#endif
    int nl_ = 0;
#define LAUNCH(PH, MX, ph_) do { if (nl_++ >= MAXL) break; p.ph_lo = (ph_); p.ph_hi = (ph_) + 1; hipLaunchKernelGGL((phase_k<PH, MX>), dim3(grid), dim3(512), LDS_BYTES, stream, p); } while (0)
    LAUNCH(0, -1, 0); LAUNCH(1, -1, 1);
    LAUNCH(2, 0, 2); LAUNCH(2, 1, 2); LAUNCH(2, 2, 2); LAUNCH(2, 3, 2);
    LAUNCH(3, -1, 3); LAUNCH(4, -1, 4); LAUNCH(1, -1, 5);
    LAUNCH(2, 0, 6); LAUNCH(2, 1, 6); LAUNCH(2, 2, 6); LAUNCH(2, 3, 6);
    LAUNCH(3, -1, 7); LAUNCH(8, -1, 8);
#undef LAUNCH
#endif
}
```

```cpp
#include <hip/hip_runtime.h>
#include <hip/hip_cooperative_groups.h>
#include <cstdio>
namespace cg = cooperative_groups;

#define DI __device__ __forceinline__
#define OPQ(x) asm volatile("" : "+v"(x))
#define LBAR() asm volatile("s_waitcnt lgkmcnt(0)\n\ts_barrier" ::: "memory")
#define OPQS(x) asm volatile("" : "+s"(x))
typedef unsigned short u16;
typedef short bf16x8 __attribute__((ext_vector_type(8)));
typedef short bf16x4 __attribute__((ext_vector_type(4)));
typedef float f32x4 __attribute__((ext_vector_type(4)));
typedef unsigned u32x4 __attribute__((ext_vector_type(4)));
#define LAS __attribute__((address_space(3)))

#ifndef COOP
#define COOP 1
#endif
#ifndef ONLYPH
#define ONLYPH -1
#endif
#ifndef ONLYMIX
#define ONLYMIX -1
#endif
#define MIXON(x) ((MIX < 0 || MIX == (x)) && (ONLYMIX < 0 || ONLYMIX == (x)))
#define PHON(x) (ONLYPH < 0 || ONLYPH == (x))

constexpr int D_MODEL = 1024, BATCH = 16, SEQ = 2048, DEC_BATCH = 8, DEC_SEQ = 16, PAST_LEN = 1024;
constexpr int NTOK = BATCH * SEQ;
constexpr int NSTOK = DEC_BATCH * DEC_SEQ;
constexpr int IN_COLS = 7184;
constexpr int LDP = 7168;
constexpr float EPS = 1e-6f;
constexpr int LDS_BYTES = 147456;
constexpr int NPHASE = 9;

constexpr size_t WS_PROJ = 0;
constexpr size_t WS_WTIN = WS_PROJ + (size_t)NTOK * LDP * 2;
constexpr size_t WS_WTOUT = WS_WTIN + (size_t)2 * LDP * 1024 * 2;
constexpr size_t WS_GATES = WS_WTOUT + (size_t)2 * 1024 * 2048 * 2;
constexpr size_t WS_RSTD = WS_GATES + (size_t)NTOK * 16 * 4;
constexpr size_t WS_SPROJ = WS_RSTD + (size_t)NTOK * 4;
constexpr size_t WS_SGATES = WS_SPROJ + (size_t)NSTOK * LDP * 2;
constexpr size_t WS_SRSTD = WS_SGATES + (size_t)NSTOK * 16 * 4;
constexpr size_t WS_SHI = WS_SRSTD + 512;
constexpr size_t WS_SSQ = WS_SHI + (size_t)NSTOK * 1024 * 2;
constexpr size_t WS_BAR = WS_SSQ + (size_t)(NTOK + NSTOK) * 4 * 4;
constexpr size_t WS_END = WS_BAR + 16384;

constexpr size_t O_YP = 0;
constexpr size_t O_YS = O_YP + (size_t)NTOK * 1024;
constexpr size_t O_PMC = O_YS + (size_t)NSTOK * 1024;
constexpr size_t O_PMN = O_PMC + (size_t)2 * 16 * 4 * 64 * 128;
constexpr size_t O_PMM = O_PMN + (size_t)2 * 16 * 4 * 64;
constexpr size_t O_PRET = O_PMM + (size_t)2 * 16 * 4;
constexpr size_t O_PSSD = O_PRET + (size_t)2 * 16 * 4 * 64 * 128;
constexpr size_t O_PCONV = O_PSSD + (size_t)2 * 16 * 8 * 128 * 64;
constexpr size_t O_PHG = O_PCONV + (size_t)2 * 16 * 3 * 1024;
constexpr size_t O_SMC = O_PHG + (size_t)2 * 16 * 4 * 128 * 128;
constexpr size_t O_SMN = O_SMC + (size_t)2 * 8 * 4 * 64 * 128;
constexpr size_t O_SMM = O_SMN + (size_t)2 * 8 * 4 * 64;
constexpr size_t O_SRET = O_SMM + (size_t)2 * 8 * 4;
constexpr size_t O_SSSD = O_SRET + (size_t)2 * 8 * 4 * 64 * 128;
constexpr size_t O_SCONV = O_SSSD + (size_t)2 * 8 * 8 * 128 * 64;
constexpr size_t O_SHG = O_SCONV + (size_t)2 * 8 * 3 * 1024;
constexpr size_t O_END = O_SHG + (size_t)2 * 8 * 4 * 128 * 128;

struct Params {
    const float* x_prompt; const float* x_sample;
    const float* st_mc; const float* st_mn; const float* st_mm; const float* st_ret; const float* st_ssd; const float* st_conv; const float* st_hg;
    const float* norm_w; const float* w_in; const float* gate_b; const float* mnorm_w; const float* conv_w; const float* conv_b;
    const float* dt_bias; const float* a_log; const float* d_skip; const float* snorm_w; const float* lbraw; const float* hnorm_w;
    const float* w_out; const float* fnorm_w;
    float* out; unsigned char* ws;
    int ph_lo, ph_hi;
};

DI float bf2f(u16 v) { return __uint_as_float(((unsigned)v) << 16); }
typedef __bf16 bf2_t __attribute__((ext_vector_type(2)));
typedef float f2_t __attribute__((ext_vector_type(2)));
DI unsigned pk2(float a, float b) { const f2_t v = {a, b}; const bf2_t r = __builtin_convertvector(v, bf2_t); return __builtin_bit_cast(unsigned, r); }
DI u16 f2bf(float a) { return (u16)(pk2(a, 0.f) & 0xffffu); }
DI float lo16(unsigned w) { return __uint_as_float(w << 16); }
DI float hi16(unsigned w) { return __uint_as_float(w & 0xffff0000u); }
DI void unpack8(const uint4 v, float* f) {
    f[0] = lo16(v.x); f[1] = hi16(v.x); f[2] = lo16(v.y); f[3] = hi16(v.y); f[4] = lo16(v.z); f[5] = hi16(v.z); f[6] = lo16(v.w); f[7] = hi16(v.w);
}
DI uint4 pack8f(const float* f) { uint4 r; r.x = pk2(f[0], f[1]); r.y = pk2(f[2], f[3]); r.z = pk2(f[4], f[5]); r.w = pk2(f[6], f[7]); return r; }
DI bf16x8 as_frag(uint4 v) { return __builtin_bit_cast(bf16x8, v); }
DI bf16x8 pack_acc2(const f32x4 a, const f32x4 b) { uint4 r; r.x = pk2(a[0], a[1]); r.y = pk2(a[2], a[3]); r.z = pk2(b[0], b[1]); r.w = pk2(b[2], b[3]); return __builtin_bit_cast(bf16x8, r); }
DI bf16x8 ldfrag(const u16* p) { return *(const bf16x8*)p; }
DI bf16x8 ldfrag2(const u16* p) { uint2 a = *(const uint2*)p; uint2 b = *(const uint2*)(p + 16); uint4 r; r.x = a.x; r.y = a.y; r.z = b.x; r.w = b.y; return __builtin_bit_cast(bf16x8, r); }
typedef short v4s_t __attribute__((ext_vector_type(4)));
DI bf16x8 ldfrag_tr(const u16* p, const int RS) {
    const v4s_t lo = __builtin_amdgcn_ds_read_tr16_b64_v4i16((LAS v4s_t*)p);
    const v4s_t hi = __builtin_amdgcn_ds_read_tr16_b64_v4i16((LAS v4s_t*)(p + 4 * RS));
    return __builtin_shufflevector(lo, hi, 0, 1, 2, 3, 4, 5, 6, 7);
}
DI v4s_t ld_tr4(const u16* p) { return __builtin_amdgcn_ds_read_tr16_b64_v4i16((LAS v4s_t*)p); }
#define MFMA16(a, b, c) __builtin_amdgcn_mfma_f32_16x16x32_bf16((a), (b), (c), 0, 0, 0)
DI float sigmoidf_(float x) { return __builtin_amdgcn_rcpf(1.f + __expf(-x)); }
DI float siluf_(float x) { return x * __builtin_amdgcn_rcpf(1.f + __expf(-x)); }
DI float softplusf_(float x) { return fmaxf(x, 0.f) + log1pf(__expf(-fabsf(x))); }
DI float logsigf_(float x) { return fminf(x, 0.f) - log1pf(__expf(-fabsf(x))); }
DI float wscan_sum(float x, int lane) {
#pragma unroll
    for (int o = 1; o < 64; o <<= 1) { float t = __shfl_up(x, o); if (lane >= o) x += t; }
    return x;
}
DI float wscan_max(float x, int lane) {
#pragma unroll
    for (int o = 1; o < 64; o <<= 1) { float t = __shfl_up(x, o); if (lane >= o) x = fmaxf(x, t); }
    return x;
}
template <int CTRL> DI float dppf(float x) { return __builtin_bit_cast(float, __builtin_amdgcn_update_dpp(0, __builtin_bit_cast(int, x), CTRL, 0xF, 0xF, true)); }
DI float red16(float x) { x += dppf<0xB1>(x); x += dppf<0x4E>(x); x += dppf<0x141>(x); x += dppf<0x140>(x); return x; }
DI float wsum(float x) { x = red16(x); x += __shfl_xor(x, 16); x += __shfl_xor(x, 32); return x; }
DI uint4 ldg16(const u16* p) { return *(const uint4*)p; }
DI uint4 ldsel(const u16* base, unsigned off, bool ok) { const uint4 v = *(const uint4*)(base + (size_t)off); return ok ? v : make_uint4(0u, 0u, 0u, 0u); }
DI uint4 zero4() { uint4 z; z.x = z.y = z.z = z.w = 0u; return z; }

DI int src_col(int n) {
    if (n < 512) return 512 + n;
    if (n < 1024) return 2568 + (n - 512);
    if (n < 1536) return 3592 + (n - 1024);
    if (n < 2048) return 6672 + (n - 1536);
    if (n < 2304) return 0 + (n - 2048);
    if (n < 2560) return 256 + (n - 2304);
    if (n < 3072) return 1024 + (n - 2560);
    if (n < 3584) return 1536 + (n - 3072);
    if (n < 3840) return 2056 + (n - 3584);
    if (n < 4096) return 2312 + (n - 3840);
    if (n < 4608) return 3080 + (n - 4096);
    if (n < 5632) return 4104 + (n - 4608);
    if (n < 6144) return 5136 + (n - 5632);
    if (n < 6656) return 5648 + (n - 6144);
    return 6160 + (n - 6656);
}

namespace pg8 {
constexpr int BM = 256, BK = 64, HALF = 128, HTB = HALF * BK * 2, NXCD = 8, WGM = 8;
DI int lds_byte(int r, int c) { const int st = (r >> 4) * 2 + (c >> 5), rr = r & 15, cc = c & 31, ob = rr * 64 + cc * 2; return st * 1024 + (ob ^ (((ob >> 9) & 1) << 5)); }
DI void stage_rc(int b, int& R, int& C) { const int st = b / 1024, sb = b % 1024, swz = sb ^ (((sb >> 9) & 1) << 5); R = (st >> 1) * 16 + swz / 64; C = (st & 1) * 32 + (swz % 64) / 2; }
DI int perm32(int rho) { const int n = rho >> 4, i = rho & 15; return 8 * (i >> 2) + 4 * n + (i & 3); }
struct Unit { int pm, pn; };
struct Gemm { const u16* A; const u16* Bt; int M, N, K, lda; };
struct StaticOrder {
    int nM, nN, nwg, G, c;
    DI void init(int M, int N, int G_, int c_) { nM = M / BM; nN = N / BM; nwg = nM * nN; G = G_; c = c_; }
    DI bool next(int i, Unit& u) const {
        const long L = (long)i * G + c; if (L >= nwg) return false;
        int wgid = (int)L; { const int q = nwg / NXCD, r = nwg % NXCD, xcd = wgid % NXCD, off = wgid / NXCD; wgid = (xcd < r ? xcd * (q + 1) : r * (q + 1) + (xcd - r) * q) + off; }
        const int nig = WGM * nN, gid = wgid / nig, fm = gid * WGM, gsz = (nM - fm) < WGM ? (nM - fm) : WGM;
        u.pm = fm + ((wgid % nig) % gsz); u.pn = (wgid % nig) / gsz; return true;
    }
};
template <class Epi>
DI void gemm_phase(LAS unsigned char* lds, const Gemm g, const StaticOrder& S, const Epi& E, const int tid) {
    const int wid = __builtin_amdgcn_readfirstlane(tid >> 6), lane = tid & 63, wr = wid >> 2, wc = wid & 3, fr = lane & 15, fq = lane >> 4;
    const int K = g.K, nt = K / BK, lda = g.lda;
    unsigned voffA[2], voffB[2];
#pragma unroll
    for (int i = 0; i < 2; ++i) { int R, C; stage_rc(tid * 16 + i * 8192, R, C); const int Rb = (R & ~31) + perm32(R & 31);
        voffA[i] = (unsigned)(R * lda + C) * 2u; voffB[i] = (unsigned)(Rb * K + C) * 2u; }
    const size_t kstep = (size_t)(BK * 2);
    const size_t hstepA = (size_t)HALF * lda * 2, hstepB = (size_t)HALF * K * 2;
    const size_t tstepA = 2 * hstepA, tstepB = 2 * hstepB;
    const unsigned ldsw = (unsigned)wid * 1024u;
    const int aoff = lds_byte(wr * 64 + fr, fq * 8), boff = lds_byte(wc * 32 + fr, fq * 8);
#define PG8_SA(b, h) (((b) * 2 + (h)) * HTB)
#define PG8_SB(b, h) ((4 + (b) * 2 + (h)) * HTB)
#define PG8_STAGE(bufoff, gbase, voff) do { _Pragma("unroll") for (int _i = 0; _i < 2; ++_i) \
        __builtin_amdgcn_global_load_lds((const unsigned*)((const char*)(gbase) + (voff)[_i]), (LAS unsigned*)(lds + (bufoff) + ldsw + _i * 8192), 16, 0, 0); } while (0)
#define PG8_LDA(dst, b, h) do { _Pragma("unroll") for (int m = 0; m < 4; ++m) _Pragma("unroll") for (int k = 0; k < 2; ++k) dst[m][k] = *(const LAS bf16x8*)(lds + PG8_SA(b, h) + aoff + m * 2048 + k * 1024); } while (0)
#define PG8_LDB(dst, b, h) do { _Pragma("unroll") for (int n = 0; n < 2; ++n) _Pragma("unroll") for (int k = 0; k < 2; ++k) dst[n][k] = *(const LAS bf16x8*)(lds + PG8_SB(b, h) + boff + n * 2048 + k * 1024); } while (0)
#define PG8_MMA(ai, bj, At, Bt) do { __builtin_amdgcn_s_setprio(1); _Pragma("unroll") for (int m = 0; m < 4; ++m) _Pragma("unroll") for (int n = 0; n < 2; ++n) _Pragma("unroll") for (int k = 0; k < 2; ++k) \
        acc[ai][bj][m][n] = __builtin_amdgcn_mfma_f32_16x16x32_bf16(Bt[n][k], At[m][k], acc[ai][bj][m][n], 0, 0, 0); __builtin_amdgcn_s_setprio(0); } while (0)
#define PG8_WAIT_V(n) asm volatile("s_waitcnt vmcnt(" #n ")" ::: "memory")
#define PG8_WAIT_L(n) asm volatile("s_waitcnt lgkmcnt(" #n ")" ::: "memory")
#define PG8_BAR __builtin_amdgcn_s_barrier()
#define PG8_SCHED __builtin_amdgcn_sched_barrier(0)
    Unit cur, nxt; int ui = 0;
    if (!S.next(0, cur)) return;
    f32x4 acc[2][2][4][2];
#pragma unroll
    for (int a = 0; a < 2; ++a)
#pragma unroll
        for (int b = 0; b < 2; ++b)
#pragma unroll
            for (int m = 0; m < 4; ++m)
#pragma unroll
                for (int n = 0; n < 2; ++n) acc[a][b][m][n] = (f32x4){0.f, 0.f, 0.f, 0.f};
    bf16x8 At[4][2], B0[2][2], B1[2][2];
    const char* cA = (const char*)g.A + (size_t)cur.pm * tstepA; const char* cB = (const char*)g.Bt + (size_t)cur.pn * tstepB;
    PG8_STAGE(PG8_SB(0, 0), cB, voffB); PG8_STAGE(PG8_SA(0, 0), cA, voffA); PG8_STAGE(PG8_SB(0, 1), cB + hstepB, voffB); PG8_STAGE(PG8_SA(0, 1), cA + hstepA, voffA);
    if (wr == 1) PG8_BAR;
    PG8_WAIT_V(4); PG8_BAR;
    PG8_STAGE(PG8_SB(1, 0), cB + kstep, voffB); PG8_STAGE(PG8_SA(1, 0), cA + kstep, voffA); PG8_STAGE(PG8_SB(1, 1), cB + hstepB + kstep, voffB);
    PG8_WAIT_V(6); PG8_BAR;
    for (;;) {
        const bool has_next = S.next(ui + 1, nxt);
        const char* nA = has_next ? (const char*)g.A + (size_t)nxt.pm * tstepA : cA; const char* nB = has_next ? (const char*)g.Bt + (size_t)nxt.pn * tstepB : cB;
        for (int t = 0; t < nt; t += 2) {
            const bool last = (t == nt - 2);
            const char* a1 = cA + (size_t)(t + 1) * kstep;
            const char* a2 = last ? nA : cA + (size_t)(t + 2) * kstep; const char* b2 = last ? nB : cB + (size_t)(t + 2) * kstep;
            const char* a3 = a2 + kstep; const char* b3 = b2 + kstep;
            PG8_LDB(B0, 0, 0); PG8_SCHED; PG8_LDA(At, 0, 0); PG8_STAGE(PG8_SA(1, 1), a1 + hstepA, voffA);
            PG8_WAIT_L(8); PG8_BAR; PG8_WAIT_L(0); PG8_MMA(0, 0, At, B0); PG8_BAR; PG8_SCHED;
            PG8_LDB(B1, 0, 1); PG8_STAGE(PG8_SB(0, 0), b2, voffB);
            PG8_BAR; PG8_WAIT_L(0); PG8_MMA(0, 1, At, B1); PG8_BAR;
            PG8_LDA(At, 0, 1); PG8_STAGE(PG8_SA(0, 0), a2, voffA);
            PG8_BAR; PG8_WAIT_L(0); PG8_MMA(1, 0, At, B0); PG8_BAR; PG8_SCHED;
            PG8_STAGE(PG8_SB(0, 1), b2 + hstepB, voffB);
            PG8_WAIT_V(6); PG8_BAR; PG8_MMA(1, 1, At, B1); PG8_BAR;
            PG8_LDB(B0, 1, 0); PG8_SCHED; PG8_LDA(At, 1, 0); PG8_STAGE(PG8_SA(0, 1), a2 + hstepA, voffA);
            PG8_WAIT_L(8); PG8_BAR; PG8_WAIT_L(0); PG8_MMA(0, 0, At, B0); PG8_BAR; PG8_SCHED;
            PG8_LDB(B1, 1, 1); PG8_STAGE(PG8_SB(1, 0), b3, voffB);
            PG8_BAR; PG8_WAIT_L(0); PG8_MMA(0, 1, At, B1); PG8_BAR;
            PG8_LDA(At, 1, 1); PG8_STAGE(PG8_SA(1, 0), a3, voffA);
            PG8_BAR; PG8_WAIT_L(0); PG8_MMA(1, 0, At, B0); PG8_BAR; PG8_SCHED;
            PG8_STAGE(PG8_SB(1, 1), b3 + hstepB, voffB);
            PG8_WAIT_V(6); PG8_BAR; PG8_MMA(1, 1, At, B1); PG8_BAR;
        }
        E(acc, cur, wr, wc, fr, fq);
        if (!has_next) break;
#pragma unroll
        for (int a = 0; a < 2; ++a)
#pragma unroll
            for (int b = 0; b < 2; ++b)
#pragma unroll
                for (int m = 0; m < 4; ++m)
#pragma unroll
                    for (int n = 0; n < 2; ++n) acc[a][b][m][n] = (f32x4){0.f, 0.f, 0.f, 0.f};
        cur = nxt; cA = nA; cB = nB; ++ui;
    }
    PG8_WAIT_V(0);
    if (wr == 0) PG8_BAR;
    PG8_BAR;
#undef PG8_SA
#undef PG8_SB
#undef PG8_STAGE
#undef PG8_LDA
#undef PG8_LDB
#undef PG8_MMA
#undef PG8_WAIT_V
#undef PG8_WAIT_L
#undef PG8_BAR
#undef PG8_SCHED
}
struct EpiIn {
    u16* O; const float* rstd;
    DI void operator()(const f32x4 (&acc)[2][2][4][2], const Unit& u, int wr, int wc, int fr, int fq) const {
        const int row0 = u.pm * BM + wr * 64 + fr, col0 = u.pn * BM + wc * 32 + 8 * fq;
#pragma unroll
        for (int ai = 0; ai < 2; ++ai)
#pragma unroll
            for (int m = 0; m < 4; ++m) {
                const int r = row0 + ai * HALF + m * 16; const float rs = rstd[r];
                u16* rowp = O + (size_t)r * LDP + col0;
#pragma unroll
                for (int bj = 0; bj < 2; ++bj) {
                    const f32x4 a0 = acc[ai][bj][m][0], a1 = acc[ai][bj][m][1];
                    uint4 v; v.x = pk2(a0[0] * rs, a0[1] * rs); v.y = pk2(a0[2] * rs, a0[3] * rs); v.z = pk2(a1[0] * rs, a1[1] * rs); v.w = pk2(a1[2] * rs, a1[3] * rs);
                    *(uint4*)(rowp + bj * HALF) = v;
                }
            }
    }
};
struct EpiOut {
    u16* Xhi; u16* Xlo; const float* xin; u16* projdead; bool last;
    DI void operator()(const f32x4 (&acc)[2][2][4][2], const Unit& u, int wr, int wc, int fr, int fq) const {
        const int row0 = u.pm * BM + wr * 64 + fr, col0 = u.pn * BM + wc * 32 + 8 * fq;
#pragma unroll
        for (int ai = 0; ai < 2; ++ai)
#pragma unroll
            for (int m = 0; m < 4; ++m) {
                const int r = row0 + ai * HALF + m * 16;
#pragma unroll
                for (int bj = 0; bj < 2; ++bj) {
                    const size_t o = (size_t)r * 2048 + col0 + bj * HALF; const size_t oi = (size_t)r * 1024 + col0 + bj * HALF;
                    float res[8];
                    if (xin) { const float4 x0 = *(const float4*)(xin + oi), x1 = *(const float4*)(xin + oi + 4);
                        res[0] = x0.x; res[1] = x0.y; res[2] = x0.z; res[3] = x0.w; res[4] = x1.x; res[5] = x1.y; res[6] = x1.z; res[7] = x1.w; }
                    else unpack8(*(const uint4*)(Xhi + o), res);
                    const f32x4 a0 = acc[ai][bj][m][0], a1 = acc[ai][bj][m][1];
                    float xn[8];
#pragma unroll
                    for (int e = 0; e < 4; ++e) { xn[e] = res[e] + a0[e]; xn[4 + e] = res[4 + e] + a1[e]; }
                    if (last) {
                        float* dp = (float*)(projdead + (size_t)r * LDP + 2048) + col0 + bj * HALF;
                        *(float4*)dp = make_float4(xn[0], xn[1], xn[2], xn[3]); *(float4*)(dp + 4) = make_float4(xn[4], xn[5], xn[6], xn[7]);
                    } else {
                        *(uint4*)(Xhi + o) = pack8f(xn);
                    }
                }
            }
    }
};
}

DI void convert_weights(const Params& p, float* sm, const int tid) {
    const int NT_IN = 112 * 16, NT_OUT = 16 * 32;
    const int total = 2 * (NT_IN + NT_OUT);
    for (int t = blockIdx.x; t < total; t += gridDim.x) {
        const int l = t / (NT_IN + NT_OUT); int tt = t % (NT_IN + NT_OUT);
        const float* W; u16* Wt; int Ksz, ldw, n0, k0, s0; const float* sc;
        if (tt < NT_IN) { const int nt_ = tt / 16, kt = tt % 16; n0 = nt_ * 64; k0 = kt * 64; W = p.w_in + (size_t)l * 1024 * IN_COLS; ldw = IN_COLS; s0 = src_col(n0);
            Wt = (u16*)(p.ws + WS_WTIN) + (size_t)l * LDP * 1024; Ksz = 1024; sc = p.norm_w + l * 1024; }
        else { tt -= NT_IN; const int nt_ = tt / 32, kt = tt % 32; n0 = nt_ * 64; k0 = kt * 64; W = p.w_out + (size_t)l * 2048 * 1024; ldw = 1024; s0 = n0;
            Wt = (u16*)(p.ws + WS_WTOUT) + (size_t)l * 1024 * 2048; Ksz = 2048; sc = nullptr; }
        {
            const int kr = tid >> 3, c8 = (tid & 7) * 8;
            const float* src = W + (size_t)(k0 + kr) * ldw + s0 + c8;
            const float s = sc ? sc[k0 + kr] : 1.f;
#pragma unroll
            for (int e = 0; e < 8; ++e) sm[kr * 65 + c8 + e] = src[e] * s;
        }
        __syncthreads();
        {
            const int nr = tid >> 3, k8 = (tid & 7) * 8; float f[8];
#pragma unroll
            for (int e = 0; e < 8; ++e) f[e] = sm[(k8 + e) * 65 + nr];
            *(uint4*)(Wt + (size_t)(n0 + nr) * Ksz + k0 + k8) = pack8f(f);
        }
        __syncthreads();
    }
}

template <int MODE>
DI void prep_rows(const float* xf, u16* xh, int nrows, u16* hi, int hstride, bool whi, float* rstd, float* gates, float* copyf, const float* wg  , int gw, int ngw, int lane) {
    for (int r = gw; r < nrows; r += ngw) {
        float x[16];
#pragma unroll
        for (int i = 0; i < 4; ++i) {
            const int k = i * 256 + lane * 4;
            if (MODE == 0) { const float4 v = *(const float4*)(xf + (size_t)r * 1024 + k); x[4 * i] = v.x; x[4 * i + 1] = v.y; x[4 * i + 2] = v.z; x[4 * i + 3] = v.w;
                if (copyf) *(float4*)(copyf + (size_t)r * 1024 + k) = v; }
            else { const uint2 h = *(const uint2*)(xh + (size_t)r * 2048 + k);
                x[4 * i] = lo16(h.x); x[4 * i + 1] = hi16(h.x); x[4 * i + 2] = lo16(h.y); x[4 * i + 3] = hi16(h.y); }
        }
        float ss = 0.f;
#pragma unroll
        for (int i = 0; i < 16; ++i) ss += x[i] * x[i];
        ss = wsum(ss);
        const float rs = rsqrtf(ss * (1.f / 1024.f) + EPS);
        if (whi) {
#pragma unroll
            for (int i = 0; i < 4; ++i) { uint2 v; v.x = pk2(x[4 * i], x[4 * i + 1]); v.y = pk2(x[4 * i + 2], x[4 * i + 3]); *(uint2*)(hi + (size_t)r * hstride + i * 256 + lane * 4) = v; }
        }
        float acc[16];
        {
            int ln = lane; OPQ(ln);
#pragma unroll
            for (int j = 0; j < 16; ++j) {
                float a = 0.f;
#pragma unroll
                for (int i = 0; i < 4; ++i) { const f32x4 w = *(const f32x4*)(wg + j * 1024 + i * 256 + ln * 4); a += x[4 * i] * w[0] + x[4 * i + 1] * w[1] + x[4 * i + 2] * w[2] + x[4 * i + 3] * w[3]; }
                acc[j] = a;
            }
        }
        float b8[8], b4[4], b2[2], b1;
        { const bool h = (lane & 1) != 0;
#pragma unroll
          for (int i = 0; i < 8; ++i) { const float snd = h ? acc[i] : acc[i + 8], kp = h ? acc[i + 8] : acc[i]; b8[i] = kp + __shfl_xor(snd, 1); } }
        { const bool h = (lane & 2) != 0;
#pragma unroll
          for (int i = 0; i < 4; ++i) { const float snd = h ? b8[i] : b8[i + 4], kp = h ? b8[i + 4] : b8[i]; b4[i] = kp + __shfl_xor(snd, 2); } }
        { const bool h = (lane & 4) != 0;
#pragma unroll
          for (int i = 0; i < 2; ++i) { const float snd = h ? b4[i] : b4[i + 2], kp = h ? b4[i + 2] : b4[i]; b2[i] = kp + __shfl_xor(snd, 4); } }
        { const bool h = (lane & 8) != 0; const float snd = h ? b2[0] : b2[1], kp = h ? b2[1] : b2[0]; b1 = kp + __shfl_xor(snd, 8); }
        b1 += __shfl_xor(b1, 16); b1 += __shfl_xor(b1, 32);
        const int jg = ((lane & 1) << 3) | ((lane & 2) << 1) | ((lane & 4) >> 1) | ((lane & 8) >> 3);
        if (lane < 16) gates[(size_t)r * 16 + jg] = b1 * rs;
        if (lane == 0) rstd[r] = rs;
    }
}
DI void build_wg(const Params& p, int l, float* wg, const int tid) {
    for (int idx = tid; idx < 16 * 1024; idx += 512) {
        const int k = idx >> 4, j = idx & 15;
        const int col = j < 8 ? 2048 + j : 5128 + (j - 8);
        wg[j * 1024 + k] = p.norm_w[l * 1024 + k] * p.w_in[((size_t)l * 1024 + k) * IN_COLS + col];
    }
}

template <int MODE>
DI void sample_gemm(const u16* A, int lda, const u16* Bt, int N, int K, int gw, int ngw, int lane, u16* sproj, const float* srstd, const float* resid, float* ys) {
    const int fr = lane & 15, fq = lane >> 4;
    const int ntasks = 8 * (N / 16);
    for (int t = gw; t < ntasks; t += ngw) {
        const int rt = t & 7, ct = t >> 3;
        const u16* ap = A + (size_t)(rt * 16 + fr) * lda + 8 * fq;
        const u16* bp = Bt + (size_t)(ct * 16 + fr) * K + 8 * fq;
        f32x4 acc = (f32x4){0.f, 0.f, 0.f, 0.f};
#pragma unroll 16
        for (int k = 0; k < K; k += 32) acc = MFMA16(as_frag(ldg16(ap + k)), as_frag(ldg16(bp + k)), acc);
#pragma unroll
        for (int j = 0; j < 4; ++j) {
            const int r = rt * 16 + 4 * fq + j, c = ct * 16 + fr;
            if (MODE == 0) sproj[(size_t)r * LDP + c] = f2bf(acc[j] * srstd[r]);
            else ys[(size_t)r * 1024 + c] = resid[(size_t)r * 1024 + c] + acc[j];
        }
    }
}

template <int MODE, int NV>
DI void chain_mr(unsigned char* sm, const int ht_o, const int hw, const int lane_o, u16* seq, const float* gates,
                 const int nch, const int pos0, const int h,
                 const float* initC, const float* initN, const float* initM, float* outC, float* outN, float* outM,
                 const float* normw, const float gbi, const float gbf) {
    constexpr int nvalid = NV;
    const int fr_o = lane_o & 15, fq_o = lane_o >> 4;
    const int fr = fr_o, fq = fq_o, ht = ht_o, lane = lane_o;
    u16* sQ = (u16*)sm; u16* sK = (u16*)(sm + 9216); u16* sKW = (u16*)(sm + 18432); u16* sV = (u16*)(sm + 27648); u16* sP = (u16*)(sm + 45056);
    u16* sH = (u16*)sm;
    float* fb = (float*)(sm + 54272);
    float* sCV = fb; float* sMV = fb + 64; float* sWI = fb + 128; float* sEMT = fb + 192; float* sDA = fb + 256; float* sDB = fb + 320; float* sN = fb + 384;
    float* sSQ = fb + 448; float* sSM = fb + 704;
    const int qoff = MODE == 0 ? 2048 + h * 64 : 3584 + h * 64;
    const int koff = MODE == 0 ? 2304 + h * 64 : 3840 + h * 64;
    const int voff = MODE == 0 ? h * 128 : 512 + h * 128;
    const int g1off = MODE == 0 ? 2560 + h * 128 : 4096 + h * 128;
    const int g2off = 3072 + h * 128;
    const float lg = log1pf(-exp2f(-5.f - (float)h));

    f32x4 Cacc[4][2];
#pragma unroll
    for (int m = 0; m < 4; ++m)
#pragma unroll
        for (int n = 0; n < 2; ++n)
#pragma unroll
            for (int j = 0; j < 4; ++j) { const int k = 16 * m + 4 * fq + j, v = 32 * hw + 16 * n + fr; Cacc[m][n][j] = initC ? initC[k * 128 + v] : 0.f; }
    if (MODE == 0 && ht < 64) sN[ht] = initN ? initN[ht] : 0.f;
    float mprev = (MODE == 0) ? (initM ? initM[0] : -1e30f) : 0.f;
    float frq[8];
    if (MODE == 1) {
#pragma unroll
        for (int e = 0; e < 8; ++e) { const int j = (lane & 3) * 8 + e; frq[e] = exp2f(-(float)j * (13.287712379549449f / 32.f)) * 0.15915494309189535f; }
    }
    const int qrow = ht >> 3, qcol = (ht & 7) * 8;
    uint4 pq[2], pk[2], pv[4], pg1[4], pg2[4]; float gi = 0.f, gf = 0.f;
#define MR_OFFQ(i) ((unsigned)((((i) * 32 + (ht >> 3)) < nvalid ? ((i) * 32 + (ht >> 3)) : 0) * LDP + qoff + (ht & 7) * 8))
#define MR_OKQ(i) (((i) * 32 + (ht >> 3)) < nvalid)
#define MR_OFFV(i) ((unsigned)((((i) * 16 + (ht >> 4)) < nvalid ? ((i) * 16 + (ht >> 4)) : 0) * LDP + voff + (ht & 15) * 8))
#define MR_OKV(i) (((i) * 16 + (ht >> 4)) < nvalid)
#define MR_LOAD(c) do { const u16* cb_ = seq + (size_t)(c) * 64 * LDP; \
        _Pragma("unroll") for (int i = 0; i < 2; ++i) { pq[i] = ldsel(cb_, MR_OFFQ(i), MR_OKQ(i)); pk[i] = ldsel(cb_ + (koff - qoff), MR_OFFQ(i), MR_OKQ(i)); } \
        _Pragma("unroll") for (int i = 0; i < 4; ++i) pv[i] = ldsel(cb_, MR_OFFV(i), MR_OKV(i)); \
        if (MODE == 0) { const float* gp = gates + (size_t)(c) * 64 * 16; const unsigned og_ = (unsigned)((lane < nvalid ? lane : 0) * 16 + h); gi = gp[og_]; gf = gp[og_ + 4]; } } while (0)
    MR_LOAD(0);
    __syncthreads();
    for (int c = 0; c < nch; ++c) {
        int fr = fr_o, fq = fq_o, ht = ht_o, lane = lane_o; OPQ(fr); OPQ(fq); OPQ(ht); OPQ(lane);
        const int qrow = ht >> 3, qcol = (ht & 7) * 8;
        float wk_l, wc, mnew = 0.f;
        if (MODE == 0) {
            const float ig = (lane < nvalid) ? gi + gbi : -1e30f;
            const float lf = (lane < nvalid) ? logsigf_(gf + gbf) : 0.f;
            const float b = wscan_sum(lf, lane);
            const float cval = ig - b;
            const float pm = wscan_max(cval, lane);
            const float Ml = fmaxf(mprev, pm);
            const float blast = __shfl(b, 63), M63 = __shfl(Ml, 63);
            wk_l = __expf(cval - M63); wc = __expf(mprev - M63); mnew = blast + M63;
            if (hw == 0) { sCV[lane] = cval; sMV[lane] = Ml; sWI[lane] = __expf(mprev - Ml); sEMT[lane] = __expf(-(b + Ml)); }
        } else {
            wk_l = (lane < nvalid) ? __expf((float)(nvalid - 1 - lane) * lg) : 0.f; wc = __expf((float)nvalid * lg);
            if (hw == 0) sWI[lane] = __expf((float)(lane + 1) * lg);
        }
#pragma unroll
        for (int i = 0; i < 2; ++i) {
            const int row = i * 32 + qrow;
            float kf[8];
            if (MODE == 1) {
                float qf[8], qp[8], kp[8];
                uint4 qv = pq[i], kv = pk[i], qo, ko;
                qo.x = __shfl_xor(qv.x, 4); qo.y = __shfl_xor(qv.y, 4); qo.z = __shfl_xor(qv.z, 4); qo.w = __shfl_xor(qv.w, 4);
                ko.x = __shfl_xor(kv.x, 4); ko.y = __shfl_xor(kv.y, 4); ko.z = __shfl_xor(kv.z, 4); ko.w = __shfl_xor(kv.w, 4);
                unpack8(qv, qf); unpack8(kv, kf); unpack8(qo, qp); unpack8(ko, kp);
                const float sgn = (lane & 4) ? 1.f : -1.f;
                const float pos = (float)(pos0 + c * 64 + row);
#pragma unroll
                for (int e = 0; e < 8; ++e) {
                    float t = pos * frq[e]; t = t - rintf(t);
                    const float cs = __builtin_amdgcn_cosf(t), sn = __builtin_amdgcn_sinf(t);
                    qf[e] = qf[e] * cs + sgn * qp[e] * sn; kf[e] = kf[e] * cs + sgn * kp[e] * sn;
                }
                *(uint4*)(sQ + row * 72 + qcol) = pack8f(qf); *(uint4*)(sK + row * 72 + qcol) = pack8f(kf);
            } else {
                *(uint4*)(sQ + row * 72 + qcol) = pq[i]; *(uint4*)(sK + row * 72 + qcol) = pk[i];
                unpack8(pk[i], kf);
            }
            const float wkr = __shfl(wk_l, row);
#pragma unroll
            for (int e = 0; e < 8; ++e) kf[e] *= wkr;
            *(uint4*)(sKW + row * 72 + qcol) = pack8f(kf);
            __builtin_amdgcn_sched_barrier(0);
        }
#pragma unroll
        for (int i = 0; i < 4; ++i) {
            const int id = i * 256 + ht, row = id >> 4, col = (id & 15) * 8;
            *(uint4*)(sV + row * 136 + col) = pv[i];
        }
        LBAR(); OPQ(fr); OPQ(fq); OPQ(ht); OPQ(lane);
        if (c + 1 < nch) MR_LOAD(c + 1);
        { const u16* cb_ = seq + (size_t)c * 64 * LDP;
#pragma unroll
        for (int i = 0; i < 4; ++i) { pg1[i] = ldsel(cb_ + (g1off - voff), MR_OFFV(i), MR_OKV(i)); if (MODE == 0) pg2[i] = ldsel(cb_ + (g2off - voff), MR_OFFV(i), MR_OKV(i)); } }
        f32x4 O[4][2];
#pragma unroll
        for (int m = 0; m < 4; ++m)
#pragma unroll
            for (int n = 0; n < 2; ++n) O[m][n] = (f32x4){0.f, 0.f, 0.f, 0.f};
#pragma unroll
        for (int t = 0; t < 2; ++t) {
            bf16x8 Bf[2];
#pragma unroll
            for (int n = 0; n < 2; ++n) Bf[n] = pack_acc2(Cacc[2 * t][n], Cacc[2 * t + 1][n]);
#pragma unroll
            for (int m = 0; m < 4; ++m) { const bf16x8 A = ldfrag2(sQ + (16 * m + fr) * 72 + 32 * t + 4 * fq);
#pragma unroll
                for (int n = 0; n < 2; ++n) O[m][n] = MFMA16(A, Bf[n], O[m][n]); }
        }
#pragma unroll
        for (int m = 0; m < 4; ++m) { const f32x4 w4 = *(const f32x4*)(sWI + 16 * m + 4 * fq);
#pragma unroll
            for (int n = 0; n < 2; ++n)
#pragma unroll
                for (int j = 0; j < 4; ++j) O[m][n][j] *= 0.125f * w4[j]; }
        {
            const f32x4 M4 = (MODE == 0) ? *(const f32x4*)(sMV + 16 * hw + 4 * fq) : (f32x4){0.f, 0.f, 0.f, 0.f};
            float rsum[4] = {0.f, 0.f, 0.f, 0.f};
#pragma unroll
            for (int n = 0; n < 4; ++n) {
                if (n <= hw) {
                    f32x4 S = (f32x4){0.f, 0.f, 0.f, 0.f};
#pragma unroll
                    for (int t = 0; t < 2; ++t) S = MFMA16(ldfrag(sQ + (16 * hw + fr) * 72 + 32 * t + 8 * fq), ldfrag(sK + (16 * n + fr) * 72 + 32 * t + 8 * fq), S);
                    const int s = 16 * n + fr; const float cs = (MODE == 0) ? sCV[s] : 0.f;
#pragma unroll
                    for (int j = 0; j < 4; ++j) {
                        const int l = 16 * hw + 4 * fq + j;
                        float w;
                        if (MODE == 0) w = (s <= l) ? 0.125f * __expf(cs - M4[j]) : 0.f; else w = (s <= l) ? 0.125f * __expf((float)(l - s) * lg) : 0.f;
                        const float pp = S[j] * w; rsum[j] += pp; sP[l * 72 + s] = f2bf(pp);
                    }
                } else {
#pragma unroll
                    for (int j = 0; j < 4; ++j) sP[(16 * hw + 4 * fq + j) * 72 + 16 * n + fr] = 0;
                }
            }
            if (MODE == 0) {
#pragma unroll
                for (int j = 0; j < 4; ++j) { const float r = red16(rsum[j]); if (fr == 0) sDA[16 * hw + 4 * fq + j] = r; }
            }
        }
        float nn = 0.f;
        if (MODE == 0) {
            const int l = ht >> 2, part = ht & 3; float a = 0.f, b2 = 0.f;
#pragma unroll
            for (int e = 0; e < 16; ++e) { a += bf2f(sQ[l * 72 + part * 16 + e]) * sN[part * 16 + e]; b2 += bf2f(sKW[(part * 16 + e) * 72 + l]); }
            a += __shfl_xor(a, 1); a += __shfl_xor(a, 2); b2 += __shfl_xor(b2, 1); b2 += __shfl_xor(b2, 2);
            if (part == 0) sDB[l] = 0.125f * a;
            nn = wc * sN[l] + b2;
        }
        LBAR(); OPQ(fr); OPQ(fq); OPQ(ht); OPQ(lane);
        if (MODE == 0 && (ht & 3) == 0) sN[ht >> 2] = nn;
#pragma unroll
        for (int m = 0; m < 4; ++m)
#pragma unroll
            for (int n = 0; n < 2; ++n)
#pragma unroll
                for (int j = 0; j < 4; ++j) Cacc[m][n][j] *= wc;
#pragma unroll
        for (int t = 0; t < 2; ++t) {
            bf16x8 Bv[2];
#pragma unroll
            for (int n = 0; n < 2; ++n) Bv[n] = ldfrag_tr(sV + (32 * t + 8 * fq + ((fr >> 2) & 3)) * 136 + 32 * hw + 16 * n + 4 * (fr & 3), 136);
#pragma unroll
            for (int m = 0; m < 4; ++m) { const bf16x8 Ap = ldfrag(sP + (16 * m + fr) * 72 + 32 * t + 8 * fq); const bf16x8 Ak = ldfrag_tr(sKW + (32 * t + 8 * fq + ((fr >> 2) & 3)) * 72 + 16 * m + 4 * (fr & 3), 72);
#pragma unroll
                for (int n = 0; n < 2; ++n) { O[m][n] = MFMA16(Ap, Bv[n], O[m][n]); Cacc[m][n] = MFMA16(Ak, Bv[n], Cacc[m][n]); } }
        }
#pragma unroll
        for (int m = 0; m < 4; ++m) {
            f32x4 dn = (f32x4){1.f, 1.f, 1.f, 1.f};
            if (MODE == 0) { const f32x4 da = *(const f32x4*)(sDA + 16 * m + 4 * fq), db = *(const f32x4*)(sDB + 16 * m + 4 * fq), wi = *(const f32x4*)(sWI + 16 * m + 4 * fq), em = *(const f32x4*)(sEMT + 16 * m + 4 * fq);
#pragma unroll
                for (int j = 0; j < 4; ++j) dn[j] = __builtin_amdgcn_rcpf(fmaxf(fabsf(da[j] + wi[j] * db[j]), em[j])); }
#pragma unroll
            for (int j = 0; j < 4; ++j) {
                const int l = 16 * m + 4 * fq + j;
                const float h0 = O[m][0][j] * dn[j], h1 = O[m][1][j] * dn[j];
                float sq = h0 * h0 + h1 * h1, su = h0 + h1;
                sq = red16(sq); if (MODE == 1) su = red16(su);
                if (fr == 0) { sSQ[hw * 64 + l] = sq; if (MODE == 1) sSM[hw * 64 + l] = su; }
                sH[l * 136 + 32 * hw + fr] = f2bf(h0); sH[l * 136 + 32 * hw + 16 + fr] = f2bf(h1);
            }
        }
        LBAR(); OPQ(fr); OPQ(fq); OPQ(ht); OPQ(lane);
#pragma unroll
        for (int i = 0; i < 4; ++i) {
            const int id = i * 256 + ht, row = id >> 4, col = (id & 15) * 8;
            if (row < nvalid) {
                const float ssq = sSQ[row] + sSQ[64 + row] + sSQ[128 + row] + sSQ[192 + row];
                float hv[8], g1[8], o[8]; unpack8(*(const uint4*)(sH + row * 136 + col), hv); unpack8(pg1[i], g1);
                if (MODE == 0) {
                    float g2[8]; unpack8(pg2[i], g2);
                    const float rs = rsqrtf(ssq * (1.f / 128.f) + EPS);
#pragma unroll
                    for (int e = 0; e < 8; ++e) o[e] = hv[e] * rs * normw[col + e] * sigmoidf_(g1[e]) * siluf_(g2[e]);
                } else {
                    const float mean = (sSM[row] + sSM[64 + row] + sSM[128 + row] + sSM[192 + row]) * (1.f / 128.f);
                    const float var = fmaxf(ssq * (1.f / 128.f) - mean * mean, 0.f);
                    const float rs = rsqrtf(var + EPS);
#pragma unroll
                    for (int e = 0; e < 8; ++e) o[e] = (hv[e] - mean) * rs * siluf_(g1[e]);
                }
                *(uint4*)(seq + (size_t)c * 64 * LDP + (size_t)MR_OFFV(i)) = pack8f(o);
            }
            __builtin_amdgcn_sched_barrier(0);
        }
        mprev = mnew;
        LBAR(); OPQ(fr); OPQ(fq); OPQ(ht); OPQ(lane);
    }
#undef MR_LOAD
#undef MR_OFFQ
#undef MR_OKQ
#undef MR_OFFV
#undef MR_OKV
    OPQS(outC); OPQS(outN); OPQS(outM);
#pragma unroll
    for (int m = 0; m < 4; ++m)
#pragma unroll
        for (int n = 0; n < 2; ++n)
#pragma unroll
            for (int j = 0; j < 4; ++j) { const int k = 16 * m + 4 * fq + j, v = 32 * hw + 16 * n + fr; outC[k * 128 + v] = Cacc[m][n][j]; }
    if (MODE == 0) { if (ht < 64) outN[ht] = sN[ht]; if (ht == 0) outM[0] = mprev; }
}

template <int NV>
DI void chain_hgrn(unsigned char* sm, const int tid_o, const int w, const int lane_o, u16* seq, const int nch, const int h,
                   const float* lbraw, const int layer, const float* initS, float* outS, const float* normw) {
    constexpr int nvalid = NV;
    const int fr_o = lane_o & 15, fq_o = lane_o >> 4;
    const int fr = fr_o, fq = fq_o, tid = tid_o;
    float* LFB = (float*)sm;
    u16* sQ = (u16*)(sm + 33792); u16* sK = (u16*)(sm + 51200); u16* sKW = (u16*)(sm + 68608); u16* sV = (u16*)(sm + 86016); u16* sP = (u16*)(sm + 103424);
    u16* sH = sQ;
    float* TOT = (float*)(sm + 112640); float* BLAST = (float*)(sm + 114688); float* DEC = (float*)(sm + 115200); float* SSQ = (float*)(sm + 115712);
    const int qoff = 5632 + h * 128, foff = 6144 + h * 128, ioff = 6656 + h * 128, goff = 1536 + h * 128;
    const int k0 = (tid & 15) * 8;
    float lbv[8];
#pragma unroll
    for (int e = 0; e < 8; ++e) { const int cidx = h * 128 + k0 + e; lbv[e] = (float)layer * sigmoidf_(lbraw[512 + cidx] - lbraw[cidx]); }
    f32x4 Sacc[8];
#pragma unroll
    for (int m = 0; m < 8; ++m)
#pragma unroll
        for (int j = 0; j < 4; ++j) Sacc[m][j] = initS ? initS[(16 * m + 4 * fq + j) * 128 + 16 * w + fr] : 0.f;
    uint4 phq[2], phf[2], phi[2], pg[2];
#define HG_OFF(i) ((unsigned)((((i) * 32 + (tid >> 4)) < nvalid ? ((i) * 32 + (tid >> 4)) : 0) * LDP + qoff + (tid & 15) * 8))
#define HG_OK(i) (((i) * 32 + (tid >> 4)) < nvalid)
#define HG_LOAD(c) do { const u16* cb_ = seq + (size_t)(c) * 64 * LDP; _Pragma("unroll") for (int i = 0; i < 2; ++i) { \
        phq[i] = ldsel(cb_, HG_OFF(i), HG_OK(i)); phf[i] = ldsel(cb_ + (foff - qoff), HG_OFF(i), HG_OK(i)); phi[i] = ldsel(cb_ + (ioff - qoff), HG_OFF(i), HG_OK(i)); } } while (0)
    HG_LOAD(0);
    __syncthreads();
    for (int c = 0; c < nch; ++c) {
        int fr = fr_o, fq = fq_o, tid = tid_o; OPQ(fr); OPQ(fq); OPQ(tid);
        const int k0 = (tid & 15) * 8;
        float qf[2][8], kk[2][8];
#pragma unroll
        for (int i = 0; i < 2; ++i) {
            const int row = (i * 512 + tid) >> 4;
            float hf[8], lf[8]; unpack8(phq[i], qf[i]); unpack8(phf[i], hf);
#pragma unroll
            for (int e = 0; e < 8; ++e) {
                const float sg = sigmoidf_(hf[e]);
                if (row < nvalid) { lf[e] = __logf(lbv[e] + (1.f - lbv[e]) * sg); kk[i][e] = (1.f - lbv[e]) * (1.f - sg); } else { lf[e] = 0.f; kk[i][e] = 0.f; }
            }
            *(f32x4*)(LFB + row * 132 + k0) = (f32x4){lf[0], lf[1], lf[2], lf[3]}; *(f32x4*)(LFB + row * 132 + k0 + 4) = (f32x4){lf[4], lf[5], lf[6], lf[7]};
            *(uint4*)(sV + row * 136 + k0) = phi[i];
        }
        LBAR(); OPQ(fr); OPQ(fq); OPQ(tid);
        {
            const int k = tid & 127, seg = tid >> 7; float loc[16], run = 0.f;
#pragma unroll
            for (int i = 0; i < 16; ++i) { run += LFB[(16 * seg + i) * 132 + k]; loc[i] = run; }
            TOT[seg * 128 + k] = run;
            LBAR(); OPQ(fr); OPQ(fq); OPQ(tid);
            float off = 0.f;
#pragma unroll
            for (int s2 = 0; s2 < 3; ++s2) if (s2 < seg) off += TOT[s2 * 128 + k];
#pragma unroll
            for (int i = 0; i < 16; ++i) LFB[(16 * seg + i) * 132 + k] = loc[i] + off;
            if (seg == 3) { const float bl = off + run; BLAST[k] = bl; DEC[k] = __expf(bl); }
        }
        LBAR(); OPQ(fr); OPQ(fq); OPQ(tid);
#pragma unroll
        for (int i = 0; i < 2; ++i) {
            const int row = (i * 512 + tid) >> 4;
            const f32x4 b0 = *(const f32x4*)(LFB + row * 132 + k0), b1 = *(const f32x4*)(LFB + row * 132 + k0 + 4);
            const f32x4 l0 = *(const f32x4*)(BLAST + k0), l1 = *(const f32x4*)(BLAST + k0 + 4);
            float qt[8], kt[8], kw[8];
#pragma unroll
            for (int e = 0; e < 8; ++e) {
                const float b = e < 4 ? b0[e & 3] : b1[e & 3], bl = e < 4 ? l0[e & 3] : l1[e & 3];
                qt[e] = qf[i][e] * __expf(b); kt[e] = kk[i][e] * __expf(fminf(-b, 80.f));
                kw[e] = kk[i][e] * __expf(bl - b);
            }
            *(uint4*)(sQ + row * 136 + k0) = pack8f(qt); *(uint4*)(sK + row * 136 + k0) = pack8f(kt); *(uint4*)(sKW + row * 136 + k0) = pack8f(kw);
        }
        LBAR(); OPQ(fr); OPQ(fq); OPQ(tid);
        if (c + 1 < nch) HG_LOAD(c + 1);
#pragma unroll
        for (int i = 0; i < 2; ++i) pg[i] = ldsel(seq + (size_t)c * 64 * LDP + goff - qoff, HG_OFF(i), HG_OK(i));
        f32x4 O[4];
#pragma unroll
        for (int m = 0; m < 4; ++m) O[m] = (f32x4){0.f, 0.f, 0.f, 0.f};
#pragma unroll
        for (int t = 0; t < 4; ++t) {
            const bf16x8 Bf = pack_acc2(Sacc[2 * t], Sacc[2 * t + 1]);
#pragma unroll
            for (int m = 0; m < 4; ++m) O[m] = MFMA16(ldfrag2(sQ + (16 * m + fr) * 136 + 32 * t + 4 * fq), Bf, O[m]);
        }
        {
            const int mt = w >> 1;
#pragma unroll
            for (int nn = 0; nn < 2; ++nn) {
                const int n = (w & 1) * 2 + nn;
                if (n <= mt) {
                    f32x4 S = (f32x4){0.f, 0.f, 0.f, 0.f};
#pragma unroll
                    for (int t = 0; t < 4; ++t) S = MFMA16(ldfrag(sQ + (16 * mt + fr) * 136 + 32 * t + 8 * fq), ldfrag(sK + (16 * n + fr) * 136 + 32 * t + 8 * fq), S);
#pragma unroll
                    for (int j = 0; j < 4; ++j) { const int l = 16 * mt + 4 * fq + j, s = 16 * n + fr; sP[l * 72 + s] = (s <= l) ? f2bf(S[j]) : (u16)0; }
                } else {
#pragma unroll
                    for (int j = 0; j < 4; ++j) sP[(16 * mt + 4 * fq + j) * 72 + 16 * n + fr] = 0;
                }
            }
        }
        LBAR(); OPQ(fr); OPQ(fq); OPQ(tid);
#pragma unroll
        for (int m = 0; m < 8; ++m) { const f32x4 d4 = *(const f32x4*)(DEC + 16 * m + 4 * fq);
#pragma unroll
            for (int j = 0; j < 4; ++j) Sacc[m][j] *= d4[j]; }
#pragma unroll
        for (int t = 0; t < 2; ++t) {
            const bf16x8 Bv = ldfrag_tr(sV + (32 * t + 8 * fq + ((fr >> 2) & 3)) * 136 + 16 * w + 4 * (fr & 3), 136);
#pragma unroll
            for (int m = 0; m < 4; ++m) O[m] = MFMA16(ldfrag(sP + (16 * m + fr) * 72 + 32 * t + 8 * fq), Bv, O[m]);
#pragma unroll
            for (int m = 0; m < 8; ++m) Sacc[m] = MFMA16(ldfrag_tr(sKW + (32 * t + 8 * fq + ((fr >> 2) & 3)) * 136 + 16 * m + 4 * (fr & 3), 136), Bv, Sacc[m]);
        }
#pragma unroll
        for (int m = 0; m < 4; ++m)
#pragma unroll
            for (int j = 0; j < 4; ++j) {
                const int l = 16 * m + 4 * fq + j; const float o = O[m][j] * 0.08838834764831845f;
                const float sq = red16(o * o);
                if (fr == 0) SSQ[w * 64 + l] = sq;
                sH[l * 136 + 16 * w + fr] = f2bf(o);
            }
        LBAR(); OPQ(fr); OPQ(fq); OPQ(tid);
#pragma unroll
        for (int i = 0; i < 2; ++i) {
            const int row = (i * 512 + tid) >> 4;
            if (row < nvalid) {
                float ssq = 0.f;
#pragma unroll
                for (int ww = 0; ww < 8; ++ww) ssq += SSQ[ww * 64 + row];
                const float rs = rsqrtf(ssq * (1.f / 128.f) + EPS);
                float hv[8], g[8], o[8]; unpack8(*(const uint4*)(sH + row * 136 + k0), hv); unpack8(pg[i], g);
#pragma unroll
                for (int e = 0; e < 8; ++e) o[e] = hv[e] * rs * normw[k0 + e] * siluf_(g[e]);
                *(uint4*)(seq + (size_t)c * 64 * LDP + goff - qoff + (size_t)HG_OFF(i)) = pack8f(o);
            }
            __builtin_amdgcn_sched_barrier(0);
        }
        LBAR(); OPQ(fr); OPQ(fq); OPQ(tid);
    }
#undef HG_LOAD
#undef HG_OFF
#undef HG_OK
    OPQS(outS);
#pragma unroll
    for (int m = 0; m < 8; ++m)
#pragma unroll
        for (int j = 0; j < 4; ++j) outS[(16 * m + 4 * fq + j) * 128 + 16 * w + fr] = Sacc[m][j];
}

template <int NV>
DI void block_ssd(unsigned char* sm, const int tid_o, const int w, const int lane_o, u16* seq, const float* gates, const int nch, const int g, const int hp,
                  const float* convw, const float* convb, const float* dtb, const float* alog, const float* dsk, const float* snw,
                  const float* initH, const float* initConv, float* outH, float* outConv, float* ssq) {
    constexpr int nvalid = NV;
    const int fr_o = lane_o & 15, fq_o = lane_o >> 4, hh = w >> 2, jw = w & 3, head = g * 4 + hp * 2 + hh;
    const int fr = fr_o, fq = fq_o, lane = lane_o, tid = tid_o;
    u16* sC = (u16*)sm; u16* sB = (u16*)(sm + 17408); u16* sX = (u16*)(sm + 34816);
    u16* sP = (u16*)(sm + 52224 + hh * 9216);
    u16* OB = (u16*)sm;
    float* TAB = (float*)(sm + 70656);
    float* BV = (float*)(sm + 78336); float* DTV = BV + 128; float* WV = BV + 256;
    const int rs8 = w;
    for (int idx = tid; idx < 5 * 384; idx += 512) {
        const int tap = idx / 384, lc = idx - tap * 384, c8 = lc >> 3, e = lc & 7;
        const int ch = (c8 < 16 ? g * 256 + hp * 128 + c8 * 8 : (c8 < 32 ? 512 + g * 128 + (c8 - 16) * 8 : 768 + g * 128 + (c8 - 32) * 8)) + e;
        TAB[idx] = tap < 4 ? convw[tap * 1024 + ch] : convb[ch];
    }
    f32x4 hacc[8];
#pragma unroll
    for (int m = 0; m < 8; ++m)
#pragma unroll
        for (int j = 0; j < 4; ++j) hacc[m][j] = initH ? initH[((size_t)head * 128 + 16 * m + 4 * fq + j) * 64 + 16 * jw + fr] : 0.f;
    const float dtbias = dtb[head], Aneg = -__expf(alog[head]), Dsk = dsk[head];
    uint4 pr[11]; float sdt = 0.f;
#define SSD_CP (lane < 48 ? lane : 47)
#define SSD_GCOL (SSD_CP < 16 ? 4608 + g * 256 + hp * 128 + SSD_CP * 8 : (SSD_CP < 32 ? 4608 + 512 + g * 128 + (SSD_CP - 16) * 8 : 4608 + 768 + g * 128 + (SSD_CP - 32) * 8))
#define SSD_OFFZ(i) ((unsigned)((((i) * 32 + (tid >> 4)) < nvalid ? ((i) * 32 + (tid >> 4)) : 0) * LDP + 1024 + g * 256 + hp * 128 + (tid & 15) * 8))
#define SSD_OKZ(i) (((i) * 32 + (tid >> 4)) < nvalid)
#define SSD_LOAD(c) do { const u16* cb_ = seq + (size_t)(c) * 64 * LDP; const unsigned gc_ = (unsigned)SSD_GCOL; _Pragma("unroll") for (int i = 0; i < 11; ++i) { const int row = 8 * rs8 - 3 + i; \
        const bool ok_ = row < nvalid && ((c) * 64 + row) >= 0; pr[i] = ldsel(cb_ + (ok_ ? row * LDP : 0), gc_, ok_); } \
        sdt = (lane < nvalid) ? gates[(size_t)(c) * 64 * 16 + (unsigned)((lane < nvalid ? lane : 0) * 16 + 8 + head)] : 0.f; } while (0)
    SSD_LOAD(0);
    __syncthreads();
    for (int c = 0; c < nch; ++c) {
        int fr = fr_o, fq = fq_o, lane = lane_o, tid = tid_o; OPQ(fr); OPQ(fq); OPQ(lane); OPQ(tid);
        const int cp = SSD_CP; const bool act = lane < 48; const int gcol = SSD_GCOL;
        {
            const bool useinit = (c == 0 && rs8 == 0 && initConv != nullptr);
            u16* dstp = cp < 16 ? sX + cp * 8 : (cp < 32 ? sB + (cp - 16) * 8 : sC + (cp - 32) * 8);
            uint2 ylo[8];
#pragma unroll 1
            for (int half = 0; half < 2; ++half) {
                f32x4 tw[5];
#pragma unroll
                for (int tp = 0; tp < 5; ++tp) tw[tp] = *(const f32x4*)(TAB + tp * 384 + cp * 8 + half * 4);
                f32x4 acc[8];
#pragma unroll
                for (int i = 0; i < 8; ++i) acc[i] = tw[4];
#pragma unroll
                for (int k = 0; k < 11; ++k) {
                    const unsigned w0 = half ? pr[k].z : pr[k].x, w1 = half ? pr[k].w : pr[k].y;
                    f32x4 cur = (f32x4){lo16(w0), hi16(w0), lo16(w1), hi16(w1)};
                    if (k < 3 && useinit) cur = *(const f32x4*)(initConv + k * 1024 + (gcol - 4608) + half * 4);
#pragma unroll
                    for (int i = 0; i < 8; ++i) {
                        if (k - i >= 0 && k - i <= 3) {
#pragma unroll
                            for (int e = 0; e < 4; ++e) acc[i][e] += tw[k - i][e] * cur[e];
                        }
                    }
                }
#pragma unroll
                for (int i = 0; i < 8; ++i) {
                    const int row = 8 * rs8 + i;
                    float y[4];
#pragma unroll
                    for (int e = 0; e < 4; ++e) y[e] = (row < nvalid) ? siluf_(acc[i][e]) : 0.f;
                    uint2 pk; pk.x = pk2(y[0], y[1]); pk.y = pk2(y[2], y[3]);
                    if (half == 0) ylo[i] = pk;
                    else if (act) { uint4 v; v.x = ylo[i].x; v.y = ylo[i].y; v.z = pk.x; v.w = pk.y; *(uint4*)(dstp + row * 136) = v; }
                }
            }
        }
        float blast;
        {
            const float dt = (lane < nvalid) ? softplusf_(sdt + dtbias) : 0.f;
            const float la = dt * Aneg;
            const float b = wscan_sum(la, lane);
            blast = __shfl(b, 63);
            if (jw == 0) { BV[hh * 64 + lane] = b; DTV[hh * 64 + lane] = dt; WV[hh * 64 + lane] = __expf(blast - b) * dt; }
        }
        LBAR(); OPQ(fr); OPQ(fq); OPQ(lane); OPQ(tid);
        f32x4 O[4];
#pragma unroll
        for (int m = 0; m < 4; ++m) O[m] = (f32x4){0.f, 0.f, 0.f, 0.f};
#pragma unroll
        for (int t = 0; t < 4; ++t) {
            const bf16x8 Bf = pack_acc2(hacc[2 * t], hacc[2 * t + 1]);
#pragma unroll
            for (int m = 0; m < 4; ++m) O[m] = MFMA16(ldfrag2(sC + (16 * m + fr) * 136 + 32 * t + 4 * fq), Bf, O[m]);
        }
#pragma unroll
        for (int m = 0; m < 4; ++m) { const f32x4 b4 = *(const f32x4*)(BV + hh * 64 + 16 * m + 4 * fq);
#pragma unroll
            for (int j = 0; j < 4; ++j) O[m][j] *= __expf(b4[j]); }
        {
            const int mt = jw;
            const f32x4 bl4 = *(const f32x4*)(BV + hh * 64 + 16 * mt + 4 * fq);
#pragma unroll
            for (int n = 0; n < 4; ++n) {
                if (n <= mt) {
                    f32x4 S = (f32x4){0.f, 0.f, 0.f, 0.f};
#pragma unroll
                    for (int t = 0; t < 4; ++t) S = MFMA16(ldfrag(sC + (16 * mt + fr) * 136 + 32 * t + 8 * fq), ldfrag(sB + (16 * n + fr) * 136 + 32 * t + 8 * fq), S);
                    const int s = 16 * n + fr; const float bs = BV[hh * 64 + s], ds = DTV[hh * 64 + s];
#pragma unroll
                    for (int j = 0; j < 4; ++j) { const int l = 16 * mt + 4 * fq + j; sP[l * 72 + s] = (s <= l) ? f2bf(S[j] * __expf(bl4[j] - bs) * ds) : (u16)0; }
                } else {
#pragma unroll
                    for (int j = 0; j < 4; ++j) sP[(16 * mt + 4 * fq + j) * 72 + 16 * n + fr] = 0;
                }
            }
        }
        LBAR(); OPQ(fr); OPQ(fq); OPQ(lane); OPQ(tid);
        {
            const float eb = __expf(blast);
#pragma unroll
            for (int m = 0; m < 8; ++m)
#pragma unroll
                for (int j = 0; j < 4; ++j) hacc[m][j] *= eb;
        }
#pragma unroll
        for (int t = 0; t < 2; ++t) {
            const f32x4 w0 = *(const f32x4*)(WV + hh * 64 + 32 * t + 8 * fq), w1 = *(const f32x4*)(WV + hh * 64 + 32 * t + 8 * fq + 4);
            const bf16x8 Bv = ldfrag_tr(sX + (32 * t + 8 * fq + ((fr >> 2) & 3)) * 136 + hh * 64 + 16 * jw + 4 * (fr & 3), 136);
            float x[8]; unpack8(__builtin_bit_cast(uint4, Bv), x);
#pragma unroll
            for (int e = 0; e < 4; ++e) { x[e] *= w0[e]; x[4 + e] *= w1[e]; }
            const bf16x8 Bw = as_frag(pack8f(x));
#pragma unroll
            for (int m = 0; m < 4; ++m) O[m] = MFMA16(ldfrag(sP + (16 * m + fr) * 72 + 32 * t + 8 * fq), Bv, O[m]);
#pragma unroll
            for (int m = 0; m < 8; ++m) hacc[m] = MFMA16(ldfrag_tr(sB + (32 * t + 8 * fq + ((fr >> 2) & 3)) * 136 + 16 * m + 4 * (fr & 3), 136), Bw, hacc[m]);
        }
#pragma unroll
        for (int m = 0; m < 4; ++m) {
            const int pcol = hh * 64 + 16 * jw + fr;
            const uint2 xr = __builtin_bit_cast(uint2, ld_tr4(sX + (16 * m + 4 * fq + ((fr >> 2) & 3)) * 136 + hh * 64 + 16 * jw + 4 * (fr & 3)));
            const float xs0 = lo16(xr.x), xs1 = hi16(xr.x), xs2 = lo16(xr.y), xs3 = hi16(xr.y);
            const int l0 = 16 * m + 4 * fq;
            OB[(l0 + 0) * 136 + pcol] = f2bf(O[m][0] + Dsk * xs0);
            OB[(l0 + 1) * 136 + pcol] = f2bf(O[m][1] + Dsk * xs1);
            OB[(l0 + 2) * 136 + pcol] = f2bf(O[m][2] + Dsk * xs2);
            OB[(l0 + 3) * 136 + pcol] = f2bf(O[m][3] + Dsk * xs3);
        }
        LBAR(); OPQ(fr); OPQ(fq); OPQ(lane); OPQ(tid);
        if (c + 1 < nch) SSD_LOAD(c + 1);
#pragma unroll
        for (int i = 0; i < 2; ++i) {
            const int id = i * 512 + tid, row = id >> 4, col = (id & 15) * 8;
            float yv[8], z[8], val[8]; unpack8(*(const uint4*)(OB + row * 136 + col), yv); unpack8(ldsel(seq + (size_t)c * 64 * LDP, SSD_OFFZ(i), SSD_OKZ(i)), z);
            float ss = 0.f;
#pragma unroll
            for (int e = 0; e < 8; ++e) { val[e] = yv[e] * siluf_(z[e]); ss += val[e] * val[e]; }
            ss = red16(ss);
            if (row < nvalid) {
                if ((tid & 15) == 0) ssq[(size_t)(c * 64 + row) * 4 + g * 2 + hp] = ss;
                float o[8];
#pragma unroll
                for (int e = 0; e < 8; ++e) o[e] = val[e] * snw[g * 256 + hp * 128 + col + e];
                *(uint4*)(seq + (size_t)c * 64 * LDP + (size_t)SSD_OFFZ(i)) = pack8f(o);
            }
            __builtin_amdgcn_sched_barrier(0);
        }
        LBAR(); OPQ(fr); OPQ(fq); OPQ(lane); OPQ(tid);
    }
#undef SSD_LOAD
#undef SSD_GCOL
#undef SSD_CP
#undef SSD_OFFZ
#undef SSD_OKZ
    OPQS(outH); OPQS(outConv);
#pragma unroll
    for (int m = 0; m < 8; ++m)
#pragma unroll
        for (int j = 0; j < 4; ++j) outH[((size_t)head * 128 + 16 * m + 4 * fq + j) * 64 + 16 * jw + fr] = hacc[m][j];
    if (hp == 0) {
        const int T = (nch - 1) * 64 + nvalid;
        for (int idx = tid; idx < 3 * 512; idx += 512) { const int rr = idx >> 9, ch = g * 512 + (idx & 511);
            outConv[rr * 1024 + ch] = bf2f(seq[(size_t)(T - 3 + rr) * LDP + 4608 + ch]); }
    }
}

template <int MIX>
DI void mixer_phase(const Params& p, int l_in, unsigned char* sm) {
    const int l = __builtin_amdgcn_readfirstlane(l_in);
    u16* proj = (u16*)(p.ws + WS_PROJ); u16* sproj = (u16*)(p.ws + WS_SPROJ);
    const float* gates = (const float*)(p.ws + WS_GATES); const float* sgates = (const float*)(p.ws + WS_SGATES);
    float* out = p.out;
    float* ssqb = (float*)(p.ws + WS_SSQ);
    for (int task = blockIdx.x; task < 288; task += gridDim.x) {
        int tid = threadIdx.x; OPQ(tid);
        const int w = __builtin_amdgcn_readfirstlane(tid >> 6), lane = tid & 63;
        const int tk = __builtin_amdgcn_readfirstlane(task);
        if (MIXON(0) && (tk < 32 || (tk >= 96 && tk < 160))) {
            const bool smp = tk < 32; const int t2 = smp ? tk : tk - 96; const int b = t2 >> 2, g = (t2 >> 1) & 1, hp = t2 & 1;
            u16* seq = smp ? sproj + (size_t)b * 16 * LDP : proj + (size_t)b * SEQ * LDP;
            const float* gt = smp ? sgates + (size_t)b * 16 * 16 : gates + (size_t)b * SEQ * 16;
            const int nb = smp ? DEC_BATCH : BATCH;
            float* oH = out + (smp ? O_SSSD : O_PSSD) + ((size_t)l * nb + b) * 8 * 128 * 64;
            float* oC = out + (smp ? O_SCONV : O_PCONV) + ((size_t)l * nb + b) * 3 * 1024;
            float* sq = ssqb + (smp ? (size_t)(NTOK + b * 16) * 4 : (size_t)b * SEQ * 4);
            if (smp) block_ssd<16>(sm, tid, w, lane, seq, gt, 1, g, hp,
                      p.conv_w + (size_t)l * 4 * 1024, p.conv_b + l * 1024, p.dt_bias + l * 8, p.a_log + l * 8, p.d_skip + l * 8, p.snorm_w + l * 512,
                      smp ? p.st_ssd + ((size_t)l * DEC_BATCH + b) * 8 * 128 * 64 : nullptr, smp ? p.st_conv + ((size_t)l * DEC_BATCH + b) * 3 * 1024 : nullptr, oH, oC, sq);
            else block_ssd<64>(sm, tid, w, lane, seq, gt, 32, g, hp,
                      p.conv_w + (size_t)l * 4 * 1024, p.conv_b + l * 1024, p.dt_bias + l * 8, p.a_log + l * 8, p.d_skip + l * 8, p.snorm_w + l * 512,
                      smp ? p.st_ssd + ((size_t)l * DEC_BATCH + b) * 8 * 128 * 64 : nullptr, smp ? p.st_conv + ((size_t)l * DEC_BATCH + b) * 3 * 1024 : nullptr, oH, oC, sq);
        } else if (MIXON(1) && ((tk >= 32 && tk < 64) || tk >= 224)) {
            const bool smp = tk < 64; const int t2 = smp ? tk - 32 : tk - 224; const int b = t2 >> 2, h = t2 & 3;
            u16* seq = smp ? sproj + (size_t)b * 16 * LDP : proj + (size_t)b * SEQ * LDP;
            const int nb = smp ? DEC_BATCH : BATCH;
            float* oS = out + (smp ? O_SHG : O_PHG) + (((size_t)l * nb + b) * 4 + h) * 128 * 128;
            if (smp) chain_hgrn<16>(sm, tid, w, lane, seq, 1, h, p.lbraw, l,
                       smp ? p.st_hg + (((size_t)l * DEC_BATCH + b) * 4 + h) * 128 * 128 : nullptr, oS, p.hnorm_w + l * 512 + h * 128);
            else chain_hgrn<64>(sm, tid, w, lane, seq, 32, h, p.lbraw, l,
                       smp ? p.st_hg + (((size_t)l * DEC_BATCH + b) * 4 + h) * 128 * 128 : nullptr, oS, p.hnorm_w + l * 512 + h * 128);
        } else if ((tk >= 64 && tk < 96) || (tk >= 160 && tk < 224)) {
            int t2; bool smp, ret;
            if (tk < 80) { smp = true; ret = false; t2 = tk - 64; }
            else if (tk < 96) { smp = true; ret = true; t2 = tk - 80; }
            else if (tk < 192) { smp = false; ret = false; t2 = tk - 160; }
            else { smp = false; ret = true; t2 = tk - 192; }
            const int chain = t2 * 2 + (w >> 2); const int b = chain >> 2, h = chain & 3;
            u16* seq = smp ? sproj + (size_t)b * 16 * LDP : proj + (size_t)b * SEQ * LDP;
            const float* gt = smp ? sgates + (size_t)b * 16 * 16 : gates + (size_t)b * SEQ * 16;
            const int nb = smp ? DEC_BATCH : BATCH;
            const size_t si = ((size_t)l * nb + b) * 4 + h;
            unsigned char* csm = sm + (w >> 2) * 65536;
            if (MIXON(2) && !ret) {
                if (smp) chain_mr<0, 16>(csm, tid & 255, w & 3, lane, seq, gt, 1, 0, h,
                            smp ? p.st_mc + si * 64 * 128 : nullptr, smp ? p.st_mn + si * 64 : nullptr, smp ? p.st_mm + si : nullptr,
                            out + (smp ? O_SMC : O_PMC) + si * 64 * 128, out + (smp ? O_SMN : O_PMN) + si * 64, out + (smp ? O_SMM : O_PMM) + si,
                            p.mnorm_w + l * 512 + h * 128, p.gate_b[l * 8 + h], p.gate_b[l * 8 + 4 + h]);
                else chain_mr<0, 64>(csm, tid & 255, w & 3, lane, seq, gt, 32, 0, h,
                            smp ? p.st_mc + si * 64 * 128 : nullptr, smp ? p.st_mn + si * 64 : nullptr, smp ? p.st_mm + si : nullptr,
                            out + (smp ? O_SMC : O_PMC) + si * 64 * 128, out + (smp ? O_SMN : O_PMN) + si * 64, out + (smp ? O_SMM : O_PMM) + si,
                            p.mnorm_w + l * 512 + h * 128, p.gate_b[l * 8 + h], p.gate_b[l * 8 + 4 + h]);
            } else if (MIXON(3) && ret) {
                if (smp) chain_mr<1, 16>(csm, tid & 255, w & 3, lane, seq, gt, 1, PAST_LEN, h,
                            smp ? p.st_ret + si * 64 * 128 : nullptr, nullptr, nullptr,
                            out + (smp ? O_SRET : O_PRET) + si * 64 * 128, nullptr, nullptr, nullptr, 0.f, 0.f);
                else chain_mr<1, 64>(csm, tid & 255, w & 3, lane, seq, gt, 32, 0, h,
                            smp ? p.st_ret + si * 64 * 128 : nullptr, nullptr, nullptr,
                            out + (smp ? O_SRET : O_PRET) + si * 64 * 128, nullptr, nullptr, nullptr, 0.f, 0.f);
            }
        }
        __syncthreads();
    }
}

DI void final_norm(const Params& p, int gw, int ngw, int lane) {
    const u16* X = (const u16*)(p.ws + WS_PROJ);
    const int NR = NTOK + NSTOK;
    float4 q0[4], q1[4], q2[4];
#define FN_LD(q, rr) do { _Pragma("unroll") for (int i = 0; i < 4; ++i) { \
        if ((rr) < NTOK) q[i] = *(const float4*)((const float*)(X + (size_t)(rr) * LDP + 2048) + i * 256 + lane * 4); \
        else if ((rr) < NR) q[i] = *(const float4*)(p.out + O_YS + (size_t)((rr) - NTOK) * 1024 + i * 256 + lane * 4); \
        else q[i] = make_float4(0.f, 0.f, 0.f, 0.f); } } while (0)
    float4 wv[4];
#pragma unroll
    for (int i = 0; i < 4; ++i) wv[i] = *(const float4*)(p.fnorm_w + i * 256 + lane * 4);
    FN_LD(q0, gw); FN_LD(q1, gw + ngw);
    for (int r = gw; r < NR; r += ngw) {
        FN_LD(q2, r + 2 * ngw);
        float ss = 0.f;
#pragma unroll
        for (int i = 0; i < 4; ++i) ss += q0[i].x * q0[i].x + q0[i].y * q0[i].y + q0[i].z * q0[i].z + q0[i].w * q0[i].w;
        ss = wsum(ss);
        const float rs = rsqrtf(ss * (1.f / 1024.f) + EPS);
        float* dst = (r < NTOK) ? p.out + O_YP + (size_t)r * 1024 : p.out + O_YS + (size_t)(r - NTOK) * 1024;
#pragma unroll
        for (int i = 0; i < 4; ++i) { const int k = i * 256 + lane * 4;
            float4 o; o.x = q0[i].x * rs * wv[i].x; o.y = q0[i].y * rs * wv[i].y; o.z = q0[i].z * rs * wv[i].z; o.w = q0[i].w * rs * wv[i].w;
            *(float4*)(dst + k) = o; }
#pragma unroll
        for (int i = 0; i < 4; ++i) { q0[i] = q1[i]; q1[i] = q2[i]; }
    }
#undef FN_LD
}


#define XB_TMO      128
#define XB_XCNT(j)  (256  + 64 * (j))
#define XB_XSUB(j)  (1280 + 64 * (j))
#define XB_XGEN(j)  (2304 + 64 * (j))
#define XB_TOP      3328
#define XB_TOPGEN   3392
#define XCD_BAR_WORDS 3456
#define XB_SPIN_CAP (1u << 18)
DI unsigned xb_ld(unsigned* p)              { return __hip_atomic_load(p, __ATOMIC_RELAXED, __HIP_MEMORY_SCOPE_AGENT); }
DI unsigned xb_add(unsigned* p, unsigned v) { return __hip_atomic_fetch_add(p, v, __ATOMIC_RELAXED, __HIP_MEMORY_SCOPE_AGENT); }
DI unsigned xb_xcc_id() { return (unsigned)__builtin_amdgcn_s_getreg((3 << 11) | 20) & 0xFu; }
#define XB_SPIN(cond, bar) do { unsigned _sp = 0; while (cond) { __builtin_amdgcn_s_sleep(1); \
    if ((++_sp & 255u) == 0u) { if (xb_ld(&(bar)[XB_TMO])) break; if (_sp > XB_SPIN_CAP) { atomicAdd(&(bar)[XB_TMO], 1u); break; } } } } while (0)
struct XcdBarrier { unsigned* bar; unsigned x; volatile LAS unsigned* st; };
DI void xcd_barrier_post(unsigned* bar) { if (threadIdx.x == 0) (void)xb_add(&bar[XB_XCNT(xb_xcc_id())], 1u); }
DI void xcd_barrier_complete(unsigned* bar, unsigned x, unsigned& nloc, unsigned& nx) {
    const unsigned G = gridDim.x * gridDim.y * gridDim.z;
    unsigned sum, cnt, mine, sp = 0u;
    for (;;) {
        sum = 0u; cnt = 0u; mine = 0u;
#pragma unroll
        for (unsigned j = 0; j < 16; ++j) { const unsigned c = xb_ld(&bar[XB_XCNT(j)]); sum += c; cnt += (c > 0u) ? 1u : 0u; mine = (j == x) ? c : mine; }
        if (sum == G) break;
        __builtin_amdgcn_s_sleep(1);
        if ((++sp & 255u) == 0u) { if (xb_ld(&bar[XB_TMO])) break; if (sp > XB_SPIN_CAP) { atomicAdd(&bar[XB_TMO], 1u); break; } }
    }
    nloc = mine > 0u ? mine : 1u; nx = cnt > 0u ? cnt : 1u;
}
DI void xcd_barrier(const XcdBarrier& b) {
    asm volatile("s_waitcnt vmcnt(0)" ::: "memory");
    __syncthreads();
    if (threadIdx.x == 0) {
        unsigned* bar = b.bar;
        __builtin_amdgcn_s_waitcnt(0);
        unsigned nloc = b.st[0], nx = b.st[1];
        if (nloc == 0u) { xcd_barrier_complete(bar, b.x, nloc, nx); b.st[0] = nloc; b.st[1] = nx; }
        const unsigned old = xb_add(&bar[XB_XSUB(b.x)], 1u);
        const unsigned gen = old / nloc;
        if (old + 1u == (gen + 1u) * nloc) {
            __builtin_amdgcn_fence(__ATOMIC_RELEASE, "agent");
            asm volatile("s_waitcnt vmcnt(0)" ::: "memory");
            const unsigned og = xb_add(&bar[XB_TOP], 1u);
            const unsigned tg = og / nx;
            if (og + 1u == (tg + 1u) * nx) xb_add(&bar[XB_TOPGEN], 1u);
            else XB_SPIN(xb_ld(&bar[XB_TOPGEN]) == tg, bar);
            __builtin_amdgcn_fence(__ATOMIC_ACQUIRE, "agent");
            xb_add(&bar[XB_XGEN(b.x)], 1u);
            asm volatile("s_waitcnt vmcnt(0)" ::: "memory");
        } else {
            XB_SPIN(xb_ld(&bar[XB_XGEN(b.x)]) == gen, bar);
            __builtin_amdgcn_fence(__ATOMIC_ACQUIRE, "agent");
            asm volatile("s_waitcnt vmcnt(0)" ::: "memory");
        }
    }
    __syncthreads();
}
#define GRID_SEAM(first) do { if (first) cg::this_grid().sync(); else { XcdBarrier xb_; xb_.bar = (unsigned*)(p.ws + WS_BAR); xb_.x = xb_xcc_id(); xb_.st = (volatile LAS unsigned*)(LAS unsigned char*)(lds + LDS_BYTES - 16); xcd_barrier(xb_); } } while (0)

template <int PHSEL, int MIX>
DI void run_phases(const Params& p, unsigned char* lds) {
#define PSEL(x) (PHSEL < 0 || PHSEL == (x))
    if (COOP) { volatile LAS unsigned* st_ = (volatile LAS unsigned*)(LAS unsigned char*)(lds + LDS_BYTES - 16); if (threadIdx.x < 2) st_[threadIdx.x] = 0u; __syncthreads(); xcd_barrier_post((unsigned*)(p.ws + WS_BAR)); }
#ifndef PROG
#define PROG 0x876543210ull
#define NPROG 9
#endif
    for (int pi = p.ph_lo; pi < p.ph_hi; ++pi) {
        const int ph = __builtin_amdgcn_readfirstlane((int)((PROG >> (4 * pi)) & 15ull));
#define PH_IDS int tid = threadIdx.x; OPQ(tid); const int w = __builtin_amdgcn_readfirstlane(tid >> 6), lane = tid & 63; const int gw = blockIdx.x * 8 + w, ngw = gridDim.x * 8; (void)gw; (void)ngw; (void)lane
        u16* proj = (u16*)(p.ws + WS_PROJ); u16* sproj = (u16*)(p.ws + WS_SPROJ);
        float* gates = (float*)(p.ws + WS_GATES); float* sgates = (float*)(p.ws + WS_SGATES);
        float* rstd = (float*)(p.ws + WS_RSTD); float* srstd = (float*)(p.ws + WS_SRSTD);
        u16* shi = (u16*)(p.ws + WS_SHI);
        u16* X = (u16*)(p.out + O_YP);
        float* ys = p.out + O_YS;
        if (PSEL(0) && ph == 0) {
            PH_IDS;
            convert_weights(p, (float*)lds, tid);
            build_wg(p, 0, (float*)lds, tid);
            __syncthreads();
            prep_rows<0>(p.x_prompt, nullptr, NTOK, X, 2048, true, rstd, gates, nullptr, (const float*)lds, gw, ngw, lane);
            prep_rows<0>(p.x_sample, nullptr, NSTOK, shi, 1024, true, srstd, sgates, ys, (const float*)lds, gw, ngw, lane);
        } else if (PSEL(4) && ph == 4) {
            PH_IDS;
            build_wg(p, 1, (float*)lds, tid);
            __syncthreads();
            prep_rows<1>(nullptr, X, NTOK, nullptr, 0, false, rstd, gates, nullptr, (const float*)lds, gw, ngw, lane);
            prep_rows<0>(ys, nullptr, NSTOK, shi, 1024, true, srstd, sgates, nullptr, (const float*)lds, gw, ngw, lane);
        } else if (PSEL(1) && (ph == 1 || ph == 5)) {
            PH_IDS;
            const int l = ph == 1 ? 0 : 1;
            const u16* wt = (const u16*)(p.ws + WS_WTIN) + (size_t)l * LDP * 1024;
            sample_gemm<0>(shi, 1024, wt, LDP, 1024, gw, ngw, lane, sproj, srstd, nullptr, nullptr);
            __syncthreads();
            pg8::Gemm g; g.A = X; g.Bt = wt; g.M = NTOK; g.N = LDP; g.K = 1024; g.lda = 2048;
            pg8::StaticOrder S; S.init(g.M, g.N, (int)gridDim.x, (int)blockIdx.x);
            pg8::EpiIn E; E.O = proj; E.rstd = rstd;
            pg8::gemm_phase<pg8::EpiIn>((LAS unsigned char*)lds, g, S, E, tid);
        } else if (PSEL(2) && (ph == 2 || ph == 6)) {
            mixer_phase<MIX>(p, ph == 2 ? 0 : 1, lds);
        } else if (PSEL(3) && (ph == 3 || ph == 7)) {
            PH_IDS;
            const int l = ph == 3 ? 0 : 1;
            const u16* wt = (const u16*)(p.ws + WS_WTOUT) + (size_t)l * 1024 * 2048;
            {
                const float* ssqb = (const float*)(p.ws + WS_SSQ);
#define PP_ROW(rr) ((rr) < NTOK ? proj + (size_t)(rr) * LDP : sproj + (size_t)((rr) - NTOK) * LDP)
                const int NR = NTOK + NSTOK;
                uint4 v0 = make_uint4(0u, 0u, 0u, 0u), v1 = v0; float4 s0 = make_float4(1.f, 1.f, 1.f, 1.f), s1 = s0;
                if (gw < NR) { v0 = *(const uint4*)(PP_ROW(gw) + 1024 + lane * 8); s0 = *(const float4*)(ssqb + (size_t)gw * 4); }
                for (int r = gw; r < NR; r += ngw) {
                    const int rn = r + ngw;
                    if (rn < NR) { v1 = *(const uint4*)(PP_ROW(rn) + 1024 + lane * 8); s1 = *(const float4*)(ssqb + (size_t)rn * 4); }
                    const float tot = (lane >> 5) ? s0.z + s0.w : s0.x + s0.y;
                    const float rs = rsqrtf(tot * (1.f / 256.f) + EPS);
                    float v[8]; unpack8(v0, v);
#pragma unroll
                    for (int e = 0; e < 8; ++e) v[e] *= rs;
                    *(uint4*)(PP_ROW(r) + 1024 + lane * 8) = pack8f(v);
                    v0 = v1; s0 = s1;
                }
#undef PP_ROW
                GRID_SEAM(false);
            }
            {
                const int fr = lane & 15, fq = lane >> 4; float* red = (float*)lds;
                const float* resid = l == 0 ? p.x_sample : ys;
                for (int t = blockIdx.x; t < 512; t += gridDim.x) {
                    const int rt = t & 7, ct = t >> 3;
                    const u16* ap = sproj + (size_t)(rt * 16 + fr) * LDP + w * 256 + 8 * fq;
                    const u16* bp = wt + (size_t)(ct * 16 + fr) * 2048 + w * 256 + 8 * fq;
                    f32x4 acc = (f32x4){0.f, 0.f, 0.f, 0.f};
#pragma unroll
                    for (int k = 0; k < 256; k += 32) acc = MFMA16(as_frag(ldg16(ap + k)), as_frag(ldg16(bp + k)), acc);
                    *(f32x4*)(red + (w * 64 + lane) * 4) = acc;
                    __syncthreads();
                    if (w == 0) {
                        f32x4 tot = acc;
#pragma unroll
                        for (int ww = 1; ww < 8; ++ww) { const f32x4 o = *(const f32x4*)(red + (ww * 64 + lane) * 4); tot[0] += o[0]; tot[1] += o[1]; tot[2] += o[2]; tot[3] += o[3]; }
#pragma unroll
                        for (int j = 0; j < 4; ++j) { const size_t o = (size_t)(rt * 16 + 4 * fq + j) * 1024 + ct * 16 + fr; ys[o] = resid[o] + tot[j]; }
                    }
                    __syncthreads();
                }
            }
            pg8::Gemm g; g.A = proj; g.Bt = wt; g.M = NTOK; g.N = 1024; g.K = 2048; g.lda = LDP;
            pg8::StaticOrder S; S.init(g.M, g.N, (int)gridDim.x, (int)blockIdx.x);
            pg8::EpiOut E; E.Xhi = X; E.Xlo = X + 1024; E.xin = l == 0 ? p.x_prompt : nullptr; E.projdead = proj; E.last = (l == 1);
            pg8::gemm_phase<pg8::EpiOut>((LAS unsigned char*)lds, g, S, E, tid);
        } else if (PSEL(8) && ph == 8) {
            PH_IDS;
            final_norm(p, gw, ngw, lane);
        }
        if (pi + 1 < p.ph_hi) { GRID_SEAM(p.ph_hi > 64); }
    }
#undef PSEL
}
#if COOP
__global__ __launch_bounds__(512) void mega(Params p) {
    extern __shared__ __attribute__((aligned(16))) unsigned char lds[];
    run_phases<-1, -1>(p, lds);
}
#else
template <int PHSEL, int MIX>
__global__ __launch_bounds__(512) void phase_k(Params p) {
    extern __shared__ __attribute__((aligned(16))) unsigned char lds[];
    run_phases<PHSEL, MIX>(p, lds);
}
#endif

extern "C" void kernel_launch(void* const* d_in, const int* in_sizes, int n_in, void* d_out, int out_size, void* d_ws, size_t ws_size, hipStream_t stream) {
    static int grid = 0;
    if (grid == 0) {
        if (n_in != 23 || (size_t)out_size != O_END || ws_size < WS_END) { fprintf(stderr, "kernel_launch: unexpected shapes n_in %d out %d ws %zu (need %zu)\n", n_in, out_size, ws_size, (size_t)WS_END); grid = -1; return; }
        int dev = 0, cus = 0, per_cu = 0;
        (void)hipGetDevice(&dev); (void)hipDeviceGetAttribute(&cus, hipDeviceAttributeMultiprocessorCount, dev);
#if COOP
        if (hipFuncSetAttribute((const void*)mega, hipFuncAttributeMaxDynamicSharedMemorySize, LDS_BYTES) != hipSuccess) { fprintf(stderr, "hipFuncSetAttribute failed\n"); grid = -1; return; }
        (void)hipOccupancyMaxActiveBlocksPerMultiprocessor(&per_cu, (const void*)mega, 512, LDS_BYTES);
        (void)hipGetLastError();
#else
        hipError_t e = hipSuccess;
#define SETA(PH, MX) if (e == hipSuccess) e = hipFuncSetAttribute((const void*)phase_k<PH, MX>, hipFuncAttributeMaxDynamicSharedMemorySize, LDS_BYTES)
        SETA(0, -1); SETA(1, -1); SETA(2, 0); SETA(2, 1); SETA(2, 2); SETA(2, 3); SETA(3, -1); SETA(4, -1); SETA(8, -1);
#undef SETA
        if (e != hipSuccess) { fprintf(stderr, "hipFuncSetAttribute failed\n"); grid = -1; return; }
#endif
        if (per_cu < 1) per_cu = 1;
        grid = cus * per_cu; if (grid > 256) grid = 256;
    }
    if (grid < 0) return;
    Params p{};
    p.x_prompt = (const float*)d_in[0]; p.x_sample = (const float*)d_in[1];
    p.st_mc = (const float*)d_in[2]; p.st_mn = (const float*)d_in[3]; p.st_mm = (const float*)d_in[4]; p.st_ret = (const float*)d_in[5];
    p.st_ssd = (const float*)d_in[6]; p.st_conv = (const float*)d_in[7]; p.st_hg = (const float*)d_in[8];
    p.norm_w = (const float*)d_in[9]; p.w_in = (const float*)d_in[10]; p.gate_b = (const float*)d_in[11]; p.mnorm_w = (const float*)d_in[12];
    p.conv_w = (const float*)d_in[13]; p.conv_b = (const float*)d_in[14]; p.dt_bias = (const float*)d_in[15]; p.a_log = (const float*)d_in[16];
    p.d_skip = (const float*)d_in[17]; p.snorm_w = (const float*)d_in[18]; p.lbraw = (const float*)d_in[19]; p.hnorm_w = (const float*)d_in[20];
    p.w_out = (const float*)d_in[21]; p.fnorm_w = (const float*)d_in[22];
    p.out = (float*)d_out; p.ws = (unsigned char*)d_ws;
#if COOP
    p.ph_lo = 0; p.ph_hi = NPROG;
    if (hipMemsetAsync((char*)d_ws + WS_BAR, 0, 16384, stream) != hipSuccess) { fprintf(stderr, "hipMemsetAsync failed\n"); return; }
    void* args[] = {&p};
    hipError_t e = hipLaunchCooperativeKernel((const void*)mega, dim3(grid), dim3(512), args, LDS_BYTES, stream);
    if (e != hipSuccess) fprintf(stderr, "cooperative launch failed: %s (grid %d)\n", hipGetErrorString(e), grid);
#else
#ifndef MAXL
#define MAXL 99
#endif
    int nl_ = 0;
#define LAUNCH(PH, MX, ph_) do { if (nl_++ >= MAXL) break; p.ph_lo = (ph_); p.ph_hi = (ph_) + 1; hipLaunchKernelGGL((phase_k<PH, MX>), dim3(grid), dim3(512), LDS_BYTES, stream, p); } while (0)
    LAUNCH(0, -1, 0); LAUNCH(1, -1, 1);
    LAUNCH(2, 0, 2); LAUNCH(2, 1, 2); LAUNCH(2, 2, 2); LAUNCH(2, 3, 2);
    LAUNCH(3, -1, 3); LAUNCH(4, -1, 4); LAUNCH(1, -1, 5);
    LAUNCH(2, 0, 6); LAUNCH(2, 1, 6); LAUNCH(2, 2, 6); LAUNCH(2, 3, 6);
    LAUNCH(3, -1, 7); LAUNCH(8, -1, 8);
#undef LAUNCH
#endif
}
```

```cpp
#include <hip/hip_runtime.h>
#include <hip/hip_cooperative_groups.h>
#include <cstdio>
namespace cg = cooperative_groups;

#define DI __device__ __forceinline__
#define OPQ(x) asm volatile("" : "+v"(x))
#define LBAR() asm volatile("s_waitcnt lgkmcnt(0)\n\ts_barrier" ::: "memory")
#define OPQS(x) asm volatile("" : "+s"(x))
typedef unsigned short u16;
typedef short bf16x8 __attribute__((ext_vector_type(8)));
typedef short bf16x4 __attribute__((ext_vector_type(4)));
typedef float f32x4 __attribute__((ext_vector_type(4)));
typedef unsigned u32x4 __attribute__((ext_vector_type(4)));
#define LAS __attribute__((address_space(3)))

#ifndef COOP
#define COOP 1
#endif
#ifndef ONLYPH
#define ONLYPH -1
#endif
#ifndef ONLYMIX
#define ONLYMIX -1
#endif
#define MIXON(x) ((MIX < 0 || MIX == (x)) && (ONLYMIX < 0 || ONLYMIX == (x)))
#define PHON(x) (ONLYPH < 0 || ONLYPH == (x))

constexpr int D_MODEL = 1024, BATCH = 16, SEQ = 2048, DEC_BATCH = 8, DEC_SEQ = 16, PAST_LEN = 1024;
constexpr int NTOK = BATCH * SEQ;
constexpr int NSTOK = DEC_BATCH * DEC_SEQ;
constexpr int IN_COLS = 7184;
constexpr int LDP = 7168;
constexpr float EPS = 1e-6f;
constexpr int LDS_BYTES = 147456;
constexpr int NPHASE = 9;

constexpr size_t WS_PROJ = 0;
constexpr size_t WS_WTIN = WS_PROJ + (size_t)NTOK * LDP * 2;
constexpr size_t WS_WTOUT = WS_WTIN + (size_t)2 * LDP * 1024 * 2;
constexpr size_t WS_GATES = WS_WTOUT + (size_t)2 * 1024 * 2048 * 2;
constexpr size_t WS_RSTD = WS_GATES + (size_t)NTOK * 16 * 4;
constexpr size_t WS_SPROJ = WS_RSTD + (size_t)NTOK * 4;
constexpr size_t WS_SGATES = WS_SPROJ + (size_t)NSTOK * LDP * 2;
constexpr size_t WS_SRSTD = WS_SGATES + (size_t)NSTOK * 16 * 4;
constexpr size_t WS_SHI = WS_SRSTD + 512;
constexpr size_t WS_SSQ = WS_SHI + (size_t)NSTOK * 1024 * 2;
constexpr size_t WS_BAR = WS_SSQ + (size_t)(NTOK + NSTOK) * 4 * 4;
constexpr size_t WS_END = WS_BAR + 16384;

constexpr size_t O_YP = 0;
constexpr size_t O_YS = O_YP + (size_t)NTOK * 1024;
constexpr size_t O_PMC = O_YS + (size_t)NSTOK * 1024;
constexpr size_t O_PMN = O_PMC + (size_t)2 * 16 * 4 * 64 * 128;
constexpr size_t O_PMM = O_PMN + (size_t)2 * 16 * 4 * 64;
constexpr size_t O_PRET = O_PMM + (size_t)2 * 16 * 4;
constexpr size_t O_PSSD = O_PRET + (size_t)2 * 16 * 4 * 64 * 128;
constexpr size_t O_PCONV = O_PSSD + (size_t)2 * 16 * 8 * 128 * 64;
constexpr size_t O_PHG = O_PCONV + (size_t)2 * 16 * 3 * 1024;
constexpr size_t O_SMC = O_PHG + (size_t)2 * 16 * 4 * 128 * 128;
constexpr size_t O_SMN = O_SMC + (size_t)2 * 8 * 4 * 64 * 128;
constexpr size_t O_SMM = O_SMN + (size_t)2 * 8 * 4 * 64;
constexpr size_t O_SRET = O_SMM + (size_t)2 * 8 * 4;
constexpr size_t O_SSSD = O_SRET + (size_t)2 * 8 * 4 * 64 * 128;
constexpr size_t O_SCONV = O_SSSD + (size_t)2 * 8 * 8 * 128 * 64;
constexpr size_t O_SHG = O_SCONV + (size_t)2 * 8 * 3 * 1024;
constexpr size_t O_END = O_SHG + (size_t)2 * 8 * 4 * 128 * 128;

struct Params {
    const float* x_prompt; const float* x_sample;
    const float* st_mc; const float* st_mn; const float* st_mm; const float* st_ret; const float* st_ssd; const float* st_conv; const float* st_hg;
    const float* norm_w; const float* w_in; const float* gate_b; const float* mnorm_w; const float* conv_w; const float* conv_b;
    const float* dt_bias; const float* a_log; const float* d_skip; const float* snorm_w; const float* lbraw; const float* hnorm_w;
    const float* w_out; const float* fnorm_w;
    float* out; unsigned char* ws;
    int ph_lo, ph_hi;
};

DI float bf2f(u16 v) { return __uint_as_float(((unsigned)v) << 16); }
typedef __bf16 bf2_t __attribute__((ext_vector_type(2)));
typedef float f2_t __attribute__((ext_vector_type(2)));
DI unsigned pk2(float a, float b) { const f2_t v = {a, b}; const bf2_t r = __builtin_convertvector(v, bf2_t); return __builtin_bit_cast(unsigned, r); }
DI u16 f2bf(float a) { return (u16)(pk2(a, 0.f) & 0xffffu); }
DI float lo16(unsigned w) { return __uint_as_float(w << 16); }
DI float hi16(unsigned w) { return __uint_as_float(w & 0xffff0000u); }
DI void unpack8(const uint4 v, float* f) {
    f[0] = lo16(v.x); f[1] = hi16(v.x); f[2] = lo16(v.y); f[3] = hi16(v.y); f[4] = lo16(v.z); f[5] = hi16(v.z); f[6] = lo16(v.w); f[7] = hi16(v.w);
}
DI uint4 pack8f(const float* f) { uint4 r; r.x = pk2(f[0], f[1]); r.y = pk2(f[2], f[3]); r.z = pk2(f[4], f[5]); r.w = pk2(f[6], f[7]); return r; }
DI bf16x8 as_frag(uint4 v) { return __builtin_bit_cast(bf16x8, v); }
DI bf16x8 pack_acc2(const f32x4 a, const f32x4 b) { uint4 r; r.x = pk2(a[0], a[1]); r.y = pk2(a[2], a[3]); r.z = pk2(b[0], b[1]); r.w = pk2(b[2], b[3]); return __builtin_bit_cast(bf16x8, r); }
DI bf16x8 ldfrag(const u16* p) { return *(const bf16x8*)p; }
DI bf16x8 ldfrag2(const u16* p) { uint2 a = *(const uint2*)p; uint2 b = *(const uint2*)(p + 16); uint4 r; r.x = a.x; r.y = a.y; r.z = b.x; r.w = b.y; return __builtin_bit_cast(bf16x8, r); }
typedef short v4s_t __attribute__((ext_vector_type(4)));
DI bf16x8 ldfrag_tr(const u16* p, const int RS) {
    const v4s_t lo = __builtin_amdgcn_ds_read_tr16_b64_v4i16((LAS v4s_t*)p);
    const v4s_t hi = __builtin_amdgcn_ds_read_tr16_b64_v4i16((LAS v4s_t*)(p + 4 * RS));
    return __builtin_shufflevector(lo, hi, 0, 1, 2, 3, 4, 5, 6, 7);
}
DI v4s_t ld_tr4(const u16* p) { return __builtin_amdgcn_ds_read_tr16_b64_v4i16((LAS v4s_t*)p); }
#define MFMA16(a, b, c) __builtin_amdgcn_mfma_f32_16x16x32_bf16((a), (b), (c), 0, 0, 0)
DI float sigmoidf_(float x) { return __builtin_amdgcn_rcpf(1.f + __expf(-x)); }
DI float siluf_(float x) { return x * __builtin_amdgcn_rcpf(1.f + __expf(-x)); }
DI float softplusf_(float x) { return fmaxf(x, 0.f) + log1pf(__expf(-fabsf(x))); }
DI float logsigf_(float x) { return fminf(x, 0.f) - log1pf(__expf(-fabsf(x))); }
DI float wscan_sum(float x, int lane) {
#pragma unroll
    for (int o = 1; o < 64; o <<= 1) { float t = __shfl_up(x, o); if (lane >= o) x += t; }
    return x;
}
DI float wscan_max(float x, int lane) {
#pragma unroll
    for (int o = 1; o < 64; o <<= 1) { float t = __shfl_up(x, o); if (lane >= o) x = fmaxf(x, t); }
    return x;
}
template <int CTRL> DI float dppf(float x) { return __builtin_bit_cast(float, __builtin_amdgcn_update_dpp(0, __builtin_bit_cast(int, x), CTRL, 0xF, 0xF, true)); }
DI float red16(float x) { x += dppf<0xB1>(x); x += dppf<0x4E>(x); x += dppf<0x141>(x); x += dppf<0x140>(x); return x; }
DI float wsum(float x) { x = red16(x); x += __shfl_xor(x, 16); x += __shfl_xor(x, 32); return x; }
DI uint4 ldg16(const u16* p) { return *(const uint4*)p; }
DI uint4 ldsel(const u16* base, unsigned off, bool ok) { const uint4 v = *(const uint4*)(base + (size_t)off); return ok ? v : make_uint4(0u, 0u, 0u, 0u); }
DI uint4 zero4() { uint4 z; z.x = z.y = z.z = z.w = 0u; return z; }

DI int src_col(int n) {
    if (n < 512) return 512 + n;
    if (n < 1024) return 2568 + (n - 512);
    if (n < 1536) return 3592 + (n - 1024);
    if (n < 2048) return 6672 + (n - 1536);
    if (n < 2304) return 0 + (n - 2048);
    if (n < 2560) return 256 + (n - 2304);
    if (n < 3072) return 1024 + (n - 2560);
    if (n < 3584) return 1536 + (n - 3072);
    if (n < 3840) return 2056 + (n - 3584);
    if (n < 4096) return 2312 + (n - 3840);
    if (n < 4608) return 3080 + (n - 4096);
    if (n < 5632) return 4104 + (n - 4608);
    if (n < 6144) return 5136 + (n - 5632);
    if (n < 6656) return 5648 + (n - 6144);
    return 6160 + (n - 6656);
}

namespace pg8 {
constexpr int BM = 256, BK = 64, HALF = 128, HTB = HALF * BK * 2, NXCD = 8, WGM = 8;
DI int lds_byte(int r, int c) { const int st = (r >> 4) * 2 + (c >> 5), rr = r & 15, cc = c & 31, ob = rr * 64 + cc * 2; return st * 1024 + (ob ^ (((ob >> 9) & 1) << 5)); }
DI void stage_rc(int b, int& R, int& C) { const int st = b / 1024, sb = b % 1024, swz = sb ^ (((sb >> 9) & 1) << 5); R = (st >> 1) * 16 + swz / 64; C = (st & 1) * 32 + (swz % 64) / 2; }
DI int perm32(int rho) { const int n = rho >> 4, i = rho & 15; return 8 * (i >> 2) + 4 * n + (i & 3); }
struct Unit { int pm, pn; };
struct Gemm { const u16* A; const u16* Bt; int M, N, K, lda; };
struct StaticOrder {
    int nM, nN, nwg, G, c;
    DI void init(int M, int N, int G_, int c_) { nM = M / BM; nN = N / BM; nwg = nM * nN; G = G_; c = c_; }
    DI bool next(int i, Unit& u) const {
        const long L = (long)i * G + c; if (L >= nwg) return false;
        int wgid = (int)L; { const int q = nwg / NXCD, r = nwg % NXCD, xcd = wgid % NXCD, off = wgid / NXCD; wgid = (xcd < r ? xcd * (q + 1) : r * (q + 1) + (xcd - r) * q) + off; }
        const int nig = WGM * nN, gid = wgid / nig, fm = gid * WGM, gsz = (nM - fm) < WGM ? (nM - fm) : WGM;
        u.pm = fm + ((wgid % nig) % gsz); u.pn = (wgid % nig) / gsz; return true;
    }
};
template <class Epi>
DI void gemm_phase(LAS unsigned char* lds, const Gemm g, const StaticOrder& S, const Epi& E, const int tid) {
    const int wid = __builtin_amdgcn_readfirstlane(tid >> 6), lane = tid & 63, wr = wid >> 2, wc = wid & 3, fr = lane & 15, fq = lane >> 4;
    const int K = g.K, nt = K / BK, lda = g.lda;
    unsigned voffA[2], voffB[2];
#pragma unroll
    for (int i = 0; i < 2; ++i) { int R, C; stage_rc(tid * 16 + i * 8192, R, C); const int Rb = (R & ~31) + perm32(R & 31);
        voffA[i] = (unsigned)(R * lda + C) * 2u; voffB[i] = (unsigned)(Rb * K + C) * 2u; }
    const size_t kstep = (size_t)(BK * 2);
    const size_t hstepA = (size_t)HALF * lda * 2, hstepB = (size_t)HALF * K * 2;
    const size_t tstepA = 2 * hstepA, tstepB = 2 * hstepB;
    const unsigned ldsw = (unsigned)wid * 1024u;
    const int aoff = lds_byte(wr * 64 + fr, fq * 8), boff = lds_byte(wc * 32 + fr, fq * 8);
#define PG8_SA(b, h) (((b) * 2 + (h)) * HTB)
#define PG8_SB(b, h) ((4 + (b) * 2 + (h)) * HTB)
#define PG8_STAGE(bufoff, gbase, voff) do { _Pragma("unroll") for (int _i = 0; _i < 2; ++_i) \
        __builtin_amdgcn_global_load_lds((const unsigned*)((const char*)(gbase) + (voff)[_i]), (LAS unsigned*)(lds + (bufoff) + ldsw + _i * 8192), 16, 0, 0); } while (0)
#define PG8_LDA(dst, b, h) do { _Pragma("unroll") for (int m = 0; m < 4; ++m) _Pragma("unroll") for (int k = 0; k < 2; ++k) dst[m][k] = *(const LAS bf16x8*)(lds + PG8_SA(b, h) + aoff + m * 2048 + k * 1024); } while (0)
#define PG8_LDB(dst, b, h) do { _Pragma("unroll") for (int n = 0; n < 2; ++n) _Pragma("unroll") for (int k = 0; k < 2; ++k) dst[n][k] = *(const LAS bf16x8*)(lds + PG8_SB(b, h) + boff + n * 2048 + k * 1024); } while (0)
#define PG8_MMA(ai, bj, At, Bt) do { __builtin_amdgcn_s_setprio(1); _Pragma("unroll") for (int m = 0; m < 4; ++m) _Pragma("unroll") for (int n = 0; n < 2; ++n) _Pragma("unroll") for (int k = 0; k < 2; ++k) \
        acc[ai][bj][m][n] = __builtin_amdgcn_mfma_f32_16x16x32_bf16(Bt[n][k], At[m][k], acc[ai][bj][m][n], 0, 0, 0); __builtin_amdgcn_s_setprio(0); } while (0)
#define PG8_WAIT_V(n) asm volatile("s_waitcnt vmcnt(" #n ")" ::: "memory")
#define PG8_WAIT_L(n) asm volatile("s_waitcnt lgkmcnt(" #n ")" ::: "memory")
#define PG8_BAR __builtin_amdgcn_s_barrier()
#define PG8_SCHED __builtin_amdgcn_sched_barrier(0)
    Unit cur, nxt; int ui = 0;
    if (!S.next(0, cur)) return;
    f32x4 acc[2][2][4][2];
#pragma unroll
    for (int a = 0; a < 2; ++a)
#pragma unroll
        for (int b = 0; b < 2; ++b)
#pragma unroll
            for (int m = 0; m < 4; ++m)
#pragma unroll
                for (int n = 0; n < 2; ++n) acc[a][b][m][n] = (f32x4){0.f, 0.f, 0.f, 0.f};
    bf16x8 At[4][2], B0[2][2], B1[2][2];
    const char* cA = (const char*)g.A + (size_t)cur.pm * tstepA; const char* cB = (const char*)g.Bt + (size_t)cur.pn * tstepB;
    PG8_STAGE(PG8_SB(0, 0), cB, voffB); PG8_STAGE(PG8_SA(0, 0), cA, voffA); PG8_STAGE(PG8_SB(0, 1), cB + hstepB, voffB); PG8_STAGE(PG8_SA(0, 1), cA + hstepA, voffA);
    if (wr == 1) PG8_BAR;
    PG8_WAIT_V(4); PG8_BAR;
    PG8_STAGE(PG8_SB(1, 0), cB + kstep, voffB); PG8_STAGE(PG8_SA(1, 0), cA + kstep, voffA); PG8_STAGE(PG8_SB(1, 1), cB + hstepB + kstep, voffB);
    PG8_WAIT_V(6); PG8_BAR;
    for (;;) {
        const bool has_next = S.next(ui + 1, nxt);
        const char* nA = has_next ? (const char*)g.A + (size_t)nxt.pm * tstepA : cA; const char* nB = has_next ? (const char*)g.Bt + (size_t)nxt.pn * tstepB : cB;
        for (int t = 0; t < nt; t += 2) {
            const bool last = (t == nt - 2);
            const char* a1 = cA + (size_t)(t + 1) * kstep;
            const char* a2 = last ? nA : cA + (size_t)(t + 2) * kstep; const char* b2 = last ? nB : cB + (size_t)(t + 2) * kstep;
            const char* a3 = a2 + kstep; const char* b3 = b2 + kstep;
            PG8_LDB(B0, 0, 0); PG8_SCHED; PG8_LDA(At, 0, 0); PG8_STAGE(PG8_SA(1, 1), a1 + hstepA, voffA);
            PG8_WAIT_L(8); PG8_BAR; PG8_WAIT_L(0); PG8_MMA(0, 0, At, B0); PG8_BAR; PG8_SCHED;
            PG8_LDB(B1, 0, 1); PG8_STAGE(PG8_SB(0, 0), b2, voffB);
            PG8_BAR; PG8_WAIT_L(0); PG8_MMA(0, 1, At, B1); PG8_BAR;
            PG8_LDA(At, 0, 1); PG8_STAGE(PG8_SA(0, 0), a2, voffA);
            PG8_BAR; PG8_WAIT_L(0); PG8_MMA(1, 0, At, B0); PG8_BAR; PG8_SCHED;
            PG8_STAGE(PG8_SB(0, 1), b2 + hstepB, voffB);
            PG8_WAIT_V(6); PG8_BAR; PG8_MMA(1, 1, At, B1); PG8_BAR;
            PG8_LDB(B0, 1, 0); PG8_SCHED; PG8_LDA(At, 1, 0); PG8_STAGE(PG8_SA(0, 1), a2 + hstepA, voffA);
            PG8_WAIT_L(8); PG8_BAR; PG8_WAIT_L(0); PG8_MMA(0, 0, At, B0); PG8_BAR; PG8_SCHED;
            PG8_LDB(B1, 1, 1); PG8_STAGE(PG8_SB(1, 0), b3, voffB);
            PG8_BAR; PG8_WAIT_L(0); PG8_MMA(0, 1, At, B1); PG8_BAR;
            PG8_LDA(At, 1, 1); PG8_STAGE(PG8_SA(1, 0), a3, voffA);
            PG8_BAR; PG8_WAIT_L(0); PG8_MMA(1, 0, At, B0); PG8_BAR; PG8_SCHED;
            PG8_STAGE(PG8_SB(1, 1), b3 + hstepB, voffB);
            PG8_WAIT_V(6); PG8_BAR; PG8_MMA(1, 1, At, B1); PG8_BAR;
        }
        E(acc, cur, wr, wc, fr, fq);
        if (!has_next) break;
#pragma unroll
        for (int a = 0; a < 2; ++a)
#pragma unroll
            for (int b = 0; b < 2; ++b)
#pragma unroll
                for (int m = 0; m < 4; ++m)
#pragma unroll
                    for (int n = 0; n < 2; ++n) acc[a][b][m][n] = (f32x4){0.f, 0.f, 0.f, 0.f};
        cur = nxt; cA = nA; cB = nB; ++ui;
    }
    PG8_WAIT_V(0);
    if (wr == 0) PG8_BAR;
    PG8_BAR;
#undef PG8_SA
#undef PG8_SB
#undef PG8_STAGE
#undef PG8_LDA
#undef PG8_LDB
#undef PG8_MMA
#undef PG8_WAIT_V
#undef PG8_WAIT_L
#undef PG8_BAR
#undef PG8_SCHED
}
template <bool RS>
struct EpiIn {
    u16* O; const float* rstd;
    DI void operator()(const f32x4 (&acc)[2][2][4][2], const Unit& u, int wr, int wc, int fr, int fq) const {
        const int row0 = u.pm * BM + wr * 64 + fr, col0 = u.pn * BM + wc * 32 + 8 * fq;
#pragma unroll
        for (int ai = 0; ai < 2; ++ai)
#pragma unroll
            for (int m = 0; m < 4; ++m) {
                const int r = row0 + ai * HALF + m * 16; const float rs = RS ? rstd[r] : 1.f;
                u16* rowp = O + (size_t)r * LDP + col0;
#pragma unroll
                for (int bj = 0; bj < 2; ++bj) {
                    const f32x4 a0 = acc[ai][bj][m][0], a1 = acc[ai][bj][m][1];
                    uint4 v; v.x = pk2(a0[0] * rs, a0[1] * rs); v.y = pk2(a0[2] * rs, a0[3] * rs); v.z = pk2(a1[0] * rs, a1[1] * rs); v.w = pk2(a1[2] * rs, a1[3] * rs);
                    *(uint4*)(rowp + bj * HALF) = v;
                }
            }
    }
};
struct EpiOut {
    u16* Xhi; u16* Xlo; const float* xin; u16* projdead; bool last;
    DI void operator()(const f32x4 (&acc)[2][2][4][2], const Unit& u, int wr, int wc, int fr, int fq) const {
        const int row0 = u.pm * BM + wr * 64 + fr, col0 = u.pn * BM + wc * 32 + 8 * fq;
#pragma unroll
        for (int ai = 0; ai < 2; ++ai)
#pragma unroll
            for (int m = 0; m < 4; ++m) {
                const int r = row0 + ai * HALF + m * 16;
#pragma unroll
                for (int bj = 0; bj < 2; ++bj) {
                    const size_t o = (size_t)r * 2048 + col0 + bj * HALF; const size_t oi = (size_t)r * 1024 + col0 + bj * HALF;
                    float res[8];
                    if (xin) { const float4 x0 = *(const float4*)(xin + oi), x1 = *(const float4*)(xin + oi + 4);
                        res[0] = x0.x; res[1] = x0.y; res[2] = x0.z; res[3] = x0.w; res[4] = x1.x; res[5] = x1.y; res[6] = x1.z; res[7] = x1.w; }
                    else unpack8(*(const uint4*)(Xhi + o), res);
                    const f32x4 a0 = acc[ai][bj][m][0], a1 = acc[ai][bj][m][1];
                    float xn[8];
#pragma unroll
                    for (int e = 0; e < 4; ++e) { xn[e] = res[e] + a0[e]; xn[4 + e] = res[4 + e] + a1[e]; }
                    if (last) {
                        float* dp = (float*)(projdead + (size_t)r * LDP + 2048) + col0 + bj * HALF;
                        *(float4*)dp = make_float4(xn[0], xn[1], xn[2], xn[3]); *(float4*)(dp + 4) = make_float4(xn[4], xn[5], xn[6], xn[7]);
                    } else {
                        *(uint4*)(Xhi + o) = pack8f(xn);
                    }
                }
            }
    }
};
}

DI void convert_weights(const Params& p, float* sm, const int tid) {
    const int NT_IN = 112 * 16, NT_OUT = 16 * 32;
    const int total = 2 * (NT_IN + NT_OUT);
    for (int t = blockIdx.x; t < total; t += gridDim.x) {
        const int l = t / (NT_IN + NT_OUT); int tt = t % (NT_IN + NT_OUT);
        const float* W; u16* Wt; int Ksz, ldw, n0, k0, s0; const float* sc;
        if (tt < NT_IN) { const int nt_ = tt / 16, kt = tt % 16; n0 = nt_ * 64; k0 = kt * 64; W = p.w_in + (size_t)l * 1024 * IN_COLS; ldw = IN_COLS; s0 = src_col(n0);
            Wt = (u16*)(p.ws + WS_WTIN) + (size_t)l * LDP * 1024; Ksz = 1024; sc = p.norm_w + l * 1024; }
        else { tt -= NT_IN; const int nt_ = tt / 32, kt = tt % 32; n0 = nt_ * 64; k0 = kt * 64; W = p.w_out + (size_t)l * 2048 * 1024; ldw = 1024; s0 = n0;
            Wt = (u16*)(p.ws + WS_WTOUT) + (size_t)l * 1024 * 2048; Ksz = 2048; sc = nullptr; }
        {
            const int kr = tid >> 3, c8 = (tid & 7) * 8;
            const float* src = W + (size_t)(k0 + kr) * ldw + s0 + c8;
            const float s = sc ? sc[k0 + kr] : 1.f;
#pragma unroll
            for (int e = 0; e < 8; ++e) sm[kr * 65 + c8 + e] = src[e] * s;
        }
        __syncthreads();
        {
            const int nr = tid >> 3, k8 = (tid & 7) * 8; float f[8];
#pragma unroll
            for (int e = 0; e < 8; ++e) f[e] = sm[(k8 + e) * 65 + nr];
            *(uint4*)(Wt + (size_t)(n0 + nr) * Ksz + k0 + k8) = pack8f(f);
        }
        __syncthreads();
    }
}

template <int MODE>
DI void prep_rows(const float* xf, u16* xh, int nrows, u16* hi, int hstride, bool whi, bool hnorm, float* rstd, float* gates, float* copyf, const float* wg  , int gw, int ngw, int lane) {
    for (int r = gw; r < nrows; r += ngw) {
        float x[16];
#pragma unroll
        for (int i = 0; i < 4; ++i) {
            const int k = i * 256 + lane * 4;
            if (MODE == 0) { const float4 v = *(const float4*)(xf + (size_t)r * 1024 + k); x[4 * i] = v.x; x[4 * i + 1] = v.y; x[4 * i + 2] = v.z; x[4 * i + 3] = v.w;
                if (copyf) *(float4*)(copyf + (size_t)r * 1024 + k) = v; }
            else { const uint2 h = *(const uint2*)(xh + (size_t)r * 2048 + k);
                x[4 * i] = lo16(h.x); x[4 * i + 1] = hi16(h.x); x[4 * i + 2] = lo16(h.y); x[4 * i + 3] = hi16(h.y); }
        }
        float ss = 0.f;
#pragma unroll
        for (int i = 0; i < 16; ++i) ss += x[i] * x[i];
        ss = wsum(ss);
        const float rs = rsqrtf(ss * (1.f / 1024.f) + EPS);
        if (whi) {
            { const float hs = hnorm ? rs : 1.f;
#pragma unroll
            for (int i = 0; i < 4; ++i) { uint2 v; v.x = pk2(x[4 * i] * hs, x[4 * i + 1] * hs); v.y = pk2(x[4 * i + 2] * hs, x[4 * i + 3] * hs); *(uint2*)(hi + (size_t)r * hstride + i * 256 + lane * 4) = v; } }
        }
        float acc[16];
        {
            int ln = lane; OPQ(ln);
#pragma unroll
            for (int j = 0; j < 16; ++j) {
                float a = 0.f;
#pragma unroll
                for (int i = 0; i < 4; ++i) { const f32x4 w = *(const f32x4*)(wg + j * 1024 + i * 256 + ln * 4); a += x[4 * i] * w[0] + x[4 * i + 1] * w[1] + x[4 * i + 2] * w[2] + x[4 * i + 3] * w[3]; }
                acc[j] = a;
            }
        }
        float b8[8], b4[4], b2[2], b1;
        { const bool h = (lane & 1) != 0;
#pragma unroll
          for (int i = 0; i < 8; ++i) { const float snd = h ? acc[i] : acc[i + 8], kp = h ? acc[i + 8] : acc[i]; b8[i] = kp + __shfl_xor(snd, 1); } }
        { const bool h = (lane & 2) != 0;
#pragma unroll
          for (int i = 0; i < 4; ++i) { const float snd = h ? b8[i] : b8[i + 4], kp = h ? b8[i + 4] : b8[i]; b4[i] = kp + __shfl_xor(snd, 2); } }
        { const bool h = (lane & 4) != 0;
#pragma unroll
          for (int i = 0; i < 2; ++i) { const float snd = h ? b4[i] : b4[i + 2], kp = h ? b4[i + 2] : b4[i]; b2[i] = kp + __shfl_xor(snd, 4); } }
        { const bool h = (lane & 8) != 0; const float snd = h ? b2[0] : b2[1], kp = h ? b2[1] : b2[0]; b1 = kp + __shfl_xor(snd, 8); }
        b1 += __shfl_xor(b1, 16); b1 += __shfl_xor(b1, 32);
        const int jg = ((lane & 1) << 3) | ((lane & 2) << 1) | ((lane & 4) >> 1) | ((lane & 8) >> 3);
        if (lane < 16) gates[(size_t)r * 16 + jg] = b1 * rs;
        if (lane == 0) rstd[r] = rs;
    }
}
DI void build_wg(const Params& p, int l, float* wg, const int tid) {
    for (int idx = tid; idx < 16 * 1024; idx += 512) {
        const int k = idx >> 4, j = idx & 15;
        const int col = j < 8 ? 2048 + j : 5128 + (j - 8);
        wg[j * 1024 + k] = p.norm_w[l * 1024 + k] * p.w_in[((size_t)l * 1024 + k) * IN_COLS + col];
    }
}

template <int MODE>
DI void sample_gemm(const u16* A, int lda, const u16* Bt, int N, int K, int gw, int ngw, int lane, u16* sproj, const float* srstd, const float* resid, float* ys) {
    const int fr = lane & 15, fq = lane >> 4;
    const int ntasks = 8 * (N / 16);
    for (int t = gw; t < ntasks; t += ngw) {
        const int rt = t & 7, ct = t >> 3;
        const u16* ap = A + (size_t)(rt * 16 + fr) * lda + 8 * fq;
        const u16* bp = Bt + (size_t)(ct * 16 + fr) * K + 8 * fq;
        f32x4 acc = (f32x4){0.f, 0.f, 0.f, 0.f};
#pragma unroll 16
        for (int k = 0; k < K; k += 32) acc = MFMA16(as_frag(ldg16(ap + k)), as_frag(ldg16(bp + k)), acc);
#pragma unroll
        for (int j = 0; j < 4; ++j) {
            const int r = rt * 16 + 4 * fq + j, c = ct * 16 + fr;
            if (MODE == 0) sproj[(size_t)r * LDP + c] = f2bf(acc[j] * srstd[r]);
            else ys[(size_t)r * 1024 + c] = resid[(size_t)r * 1024 + c] + acc[j];
        }
    }
}

template <int MODE, int NV>
DI void chain_mr(unsigned char* sm, const int ht_o, const int hw, const int lane_o, u16* seq, const float* gates,
                 const int nch, const int pos0, const int h,
                 const float* initC, const float* initN, const float* initM, float* outC, float* outN, float* outM,
                 const float* normw, const float gbi, const float gbf) {
    constexpr int nvalid = NV;
    const int fr_o = lane_o & 15, fq_o = lane_o >> 4;
    const int fr = fr_o, fq = fq_o, ht = ht_o, lane = lane_o;
    u16* sQ = (u16*)sm; u16* sK = (u16*)(sm + 9216); u16* sKW = (u16*)(sm + 18432); u16* sV = (u16*)(sm + 27648); u16* sP = (u16*)(sm + 45056);
    u16* sH = (u16*)sm;
    float* fb = (float*)(sm + 54272);
    float* sCV = fb; float* sMV = fb + 64; float* sWI = fb + 128; float* sEMT = fb + 192; float* sDA = fb + 256; float* sDB = fb + 320; float* sN = fb + 384;
    float* sSQ = fb + 448; float* sSM = fb + 704;
    const int qoff = MODE == 0 ? 2048 + h * 64 : 3584 + h * 64;
    const int koff = MODE == 0 ? 2304 + h * 64 : 3840 + h * 64;
    const int voff = MODE == 0 ? h * 128 : 512 + h * 128;
    const int g1off = MODE == 0 ? 2560 + h * 128 : 4096 + h * 128;
    const int g2off = 3072 + h * 128;
    const float lg = log1pf(-exp2f(-5.f - (float)h));

    f32x4 Cacc[4][2];
#pragma unroll
    for (int m = 0; m < 4; ++m)
#pragma unroll
        for (int n = 0; n < 2; ++n)
#pragma unroll
            for (int j = 0; j < 4; ++j) { const int k = 16 * m + 4 * fq + j, v = 32 * hw + 16 * n + fr; Cacc[m][n][j] = initC ? initC[k * 128 + v] : 0.f; }
    if (MODE == 0 && ht < 64) sN[ht] = initN ? initN[ht] : 0.f;
    float mprev = (MODE == 0) ? (initM ? initM[0] : -1e30f) : 0.f;
    float frq[8];
    if (MODE == 1) {
#pragma unroll
        for (int e = 0; e < 8; ++e) { const int j = (lane & 3) * 8 + e; frq[e] = exp2f(-(float)j * (13.287712379549449f / 32.f)) * 0.15915494309189535f; }
    }
    const int qrow = ht >> 3, qcol = (ht & 7) * 8;
    uint4 pq[2], pk[2], pv[4], pg1[4], pg2[4]; float gi = 0.f, gf = 0.f;
#define MR_OFFQ(i) ((unsigned)((((i) * 32 + (ht >> 3)) < nvalid ? ((i) * 32 + (ht >> 3)) : 0) * LDP + qoff + (ht & 7) * 8))
#define MR_OKQ(i) (((i) * 32 + (ht >> 3)) < nvalid)
#define MR_OFFV(i) ((unsigned)((((i) * 16 + (ht >> 4)) < nvalid ? ((i) * 16 + (ht >> 4)) : 0) * LDP + voff + (ht & 15) * 8))
#define MR_OKV(i) (((i) * 16 + (ht >> 4)) < nvalid)
#define MR_LOAD(c) do { const u16* cb_ = seq + (size_t)(c) * 64 * LDP; \
        _Pragma("unroll") for (int i = 0; i < 2; ++i) { pq[i] = ldsel(cb_, MR_OFFQ(i), MR_OKQ(i)); pk[i] = ldsel(cb_ + (koff - qoff), MR_OFFQ(i), MR_OKQ(i)); } \
        _Pragma("unroll") for (int i = 0; i < 4; ++i) pv[i] = ldsel(cb_, MR_OFFV(i), MR_OKV(i)); \
        if (MODE == 0) { const float* gp = gates + (size_t)(c) * 64 * 16; const unsigned og_ = (unsigned)((lane < nvalid ? lane : 0) * 16 + h); gi = gp[og_]; gf = gp[og_ + 4]; } } while (0)
    MR_LOAD(0);
    __syncthreads();
    for (int c = 0; c < nch; ++c) {
        int fr = fr_o, fq = fq_o, ht = ht_o, lane = lane_o; OPQ(fr); OPQ(fq); OPQ(ht); OPQ(lane);
        const int qrow = ht >> 3, qcol = (ht & 7) * 8;
        float wk_l, wc, mnew = 0.f;
        if (MODE == 0) {
            const float ig = (lane < nvalid) ? gi + gbi : -1e30f;
            const float lf = (lane < nvalid) ? logsigf_(gf + gbf) : 0.f;
            const float b = wscan_sum(lf, lane);
            const float cval = ig - b;
            const float pm = wscan_max(cval, lane);
            const float Ml = fmaxf(mprev, pm);
            const float blast = __shfl(b, 63), M63 = __shfl(Ml, 63);
            wk_l = __expf(cval - M63); wc = __expf(mprev - M63); mnew = blast + M63;
            if (hw == 0) { sCV[lane] = cval; sMV[lane] = Ml; sWI[lane] = __expf(mprev - Ml); sEMT[lane] = __expf(-(b + Ml)); }
        } else {
            wk_l = (lane < nvalid) ? __expf((float)(nvalid - 1 - lane) * lg) : 0.f; wc = __expf((float)nvalid * lg);
            if (hw == 0) sWI[lane] = __expf((float)(lane + 1) * lg);
        }
#pragma unroll
        for (int i = 0; i < 2; ++i) {
            const int row = i * 32 + qrow;
            float kf[8];
            if (MODE == 1) {
                float qf[8], qp[8], kp[8];
                uint4 qv = pq[i], kv = pk[i], qo, ko;
                qo.x = __shfl_xor(qv.x, 4); qo.y = __shfl_xor(qv.y, 4); qo.z = __shfl_xor(qv.z, 4); qo.w = __shfl_xor(qv.w, 4);
                ko.x = __shfl_xor(kv.x, 4); ko.y = __shfl_xor(kv.y, 4); ko.z = __shfl_xor(kv.z, 4); ko.w = __shfl_xor(kv.w, 4);
                unpack8(qv, qf); unpack8(kv, kf); unpack8(qo, qp); unpack8(ko, kp);
                const float sgn = (lane & 4) ? 1.f : -1.f;
                const float pos = (float)(pos0 + c * 64 + row);
#pragma unroll
                for (int e = 0; e < 8; ++e) {
                    float t = pos * frq[e]; t = t - rintf(t);
                    const float cs = __builtin_amdgcn_cosf(t), sn = __builtin_amdgcn_sinf(t);
                    qf[e] = qf[e] * cs + sgn * qp[e] * sn; kf[e] = kf[e] * cs + sgn * kp[e] * sn;
                }
                *(uint4*)(sQ + row * 72 + qcol) = pack8f(qf); *(uint4*)(sK + row * 72 + qcol) = pack8f(kf);
            } else {
                *(uint4*)(sQ + row * 72 + qcol) = pq[i]; *(uint4*)(sK + row * 72 + qcol) = pk[i];
                unpack8(pk[i], kf);
            }
            const float wkr = __shfl(wk_l, row);
#pragma unroll
            for (int e = 0; e < 8; ++e) kf[e] *= wkr;
            *(uint4*)(sKW + row * 72 + qcol) = pack8f(kf);
            __builtin_amdgcn_sched_barrier(0);
        }
#pragma unroll
        for (int i = 0; i < 4; ++i) {
            const int id = i * 256 + ht, row = id >> 4, col = (id & 15) * 8;
            *(uint4*)(sV + row * 136 + col) = pv[i];
        }
        LBAR(); OPQ(fr); OPQ(fq); OPQ(ht); OPQ(lane);
        if (c + 1 < nch) MR_LOAD(c + 1);
        { const u16* cb_ = seq + (size_t)c * 64 * LDP;
#pragma unroll
        for (int i = 0; i < 4; ++i) { pg1[i] = ldsel(cb_ + (g1off - voff), MR_OFFV(i), MR_OKV(i)); if (MODE == 0) pg2[i] = ldsel(cb_ + (g2off - voff), MR_OFFV(i), MR_OKV(i)); } }
        f32x4 O[4][2];
#pragma unroll
        for (int m = 0; m < 4; ++m)
#pragma unroll
            for (int n = 0; n < 2; ++n) O[m][n] = (f32x4){0.f, 0.f, 0.f, 0.f};
#pragma unroll
        for (int t = 0; t < 2; ++t) {
            bf16x8 Bf[2];
#pragma unroll
            for (int n = 0; n < 2; ++n) Bf[n] = pack_acc2(Cacc[2 * t][n], Cacc[2 * t + 1][n]);
#pragma unroll
            for (int m = 0; m < 4; ++m) { const bf16x8 A = ldfrag2(sQ + (16 * m + fr) * 72 + 32 * t + 4 * fq);
#pragma unroll
                for (int n = 0; n < 2; ++n) O[m][n] = MFMA16(A, Bf[n], O[m][n]); }
        }
#pragma unroll
        for (int m = 0; m < 4; ++m) { const f32x4 w4 = *(const f32x4*)(sWI + 16 * m + 4 * fq);
#pragma unroll
            for (int n = 0; n < 2; ++n)
#pragma unroll
                for (int j = 0; j < 4; ++j) O[m][n][j] *= 0.125f * w4[j]; }
        {
            const f32x4 M4 = (MODE == 0) ? *(const f32x4*)(sMV + 16 * hw + 4 * fq) : (f32x4){0.f, 0.f, 0.f, 0.f};
            float rsum[4] = {0.f, 0.f, 0.f, 0.f};
#pragma unroll
            for (int n = 0; n < 4; ++n) {
                if (n <= hw) {
                    f32x4 S = (f32x4){0.f, 0.f, 0.f, 0.f};
#pragma unroll
                    for (int t = 0; t < 2; ++t) S = MFMA16(ldfrag(sQ + (16 * hw + fr) * 72 + 32 * t + 8 * fq), ldfrag(sK + (16 * n + fr) * 72 + 32 * t + 8 * fq), S);
                    const int s = 16 * n + fr; const float cs = (MODE == 0) ? sCV[s] : 0.f;
#pragma unroll
                    for (int j = 0; j < 4; ++j) {
                        const int l = 16 * hw + 4 * fq + j;
                        float w;
                        if (MODE == 0) w = (s <= l) ? 0.125f * __expf(cs - M4[j]) : 0.f; else w = (s <= l) ? 0.125f * __expf((float)(l - s) * lg) : 0.f;
                        const float pp = S[j] * w; rsum[j] += pp; sP[l * 72 + s] = f2bf(pp);
                    }
                } else {
#pragma unroll
                    for (int j = 0; j < 4; ++j) sP[(16 * hw + 4 * fq + j) * 72 + 16 * n + fr] = 0;
                }
            }
            if (MODE == 0) {
#pragma unroll
                for (int j = 0; j < 4; ++j) { const float r = red16(rsum[j]); if (fr == 0) sDA[16 * hw + 4 * fq + j] = r; }
            }
        }
        float nn = 0.f;
        if (MODE == 0) {
            const int l = ht >> 2, part = ht & 3; float a = 0.f, b2 = 0.f;
#pragma unroll
            for (int e = 0; e < 16; ++e) { a += bf2f(sQ[l * 72 + part * 16 + e]) * sN[part * 16 + e]; b2 += bf2f(sKW[(part * 16 + e) * 72 + l]); }
            a += __shfl_xor(a, 1); a += __shfl_xor(a, 2); b2 += __shfl_xor(b2, 1); b2 += __shfl_xor(b2, 2);
            if (part == 0) sDB[l] = 0.125f * a;
            nn = wc * sN[l] + b2;
        }
        LBAR(); OPQ(fr); OPQ(fq); OPQ(ht); OPQ(lane);
        if (MODE == 0 && (ht & 3) == 0) sN[ht >> 2] = nn;
#pragma unroll
        for (int m = 0; m < 4; ++m)
#pragma unroll
            for (int n = 0; n < 2; ++n)
#pragma unroll
                for (int j = 0; j < 4; ++j) Cacc[m][n][j] *= wc;
#pragma unroll
        for (int t = 0; t < 2; ++t) {
            bf16x8 Bv[2];
#pragma unroll
            for (int n = 0; n < 2; ++n) Bv[n] = ldfrag_tr(sV + (32 * t + 8 * fq + ((fr >> 2) & 3)) * 136 + 32 * hw + 16 * n + 4 * (fr & 3), 136);
#pragma unroll
            for (int m = 0; m < 4; ++m) { const bf16x8 Ap = ldfrag(sP + (16 * m + fr) * 72 + 32 * t + 8 * fq); const bf16x8 Ak = ldfrag_tr(sKW + (32 * t + 8 * fq + ((fr >> 2) & 3)) * 72 + 16 * m + 4 * (fr & 3), 72);
#pragma unroll
                for (int n = 0; n < 2; ++n) { O[m][n] = MFMA16(Ap, Bv[n], O[m][n]); Cacc[m][n] = MFMA16(Ak, Bv[n], Cacc[m][n]); } }
        }
#pragma unroll
        for (int m = 0; m < 4; ++m) {
            f32x4 dn = (f32x4){1.f, 1.f, 1.f, 1.f};
            if (MODE == 0) { const f32x4 da = *(const f32x4*)(sDA + 16 * m + 4 * fq), db = *(const f32x4*)(sDB + 16 * m + 4 * fq), wi = *(const f32x4*)(sWI + 16 * m + 4 * fq), em = *(const f32x4*)(sEMT + 16 * m + 4 * fq);
#pragma unroll
                for (int j = 0; j < 4; ++j) dn[j] = __builtin_amdgcn_rcpf(fmaxf(fabsf(da[j] + wi[j] * db[j]), em[j])); }
#pragma unroll
            for (int j = 0; j < 4; ++j) {
                const int l = 16 * m + 4 * fq + j;
                const float h0 = O[m][0][j] * dn[j], h1 = O[m][1][j] * dn[j];
                float sq = h0 * h0 + h1 * h1, su = h0 + h1;
                sq = red16(sq); if (MODE == 1) su = red16(su);
                if (fr == 0) { sSQ[hw * 64 + l] = sq; if (MODE == 1) sSM[hw * 64 + l] = su; }
                sH[l * 136 + 32 * hw + fr] = f2bf(h0); sH[l * 136 + 32 * hw + 16 + fr] = f2bf(h1);
            }
        }
        LBAR(); OPQ(fr); OPQ(fq); OPQ(ht); OPQ(lane);
#pragma unroll
        for (int i = 0; i < 4; ++i) {
            const int id = i * 256 + ht, row = id >> 4, col = (id & 15) * 8;
            if (row < nvalid) {
                const float ssq = sSQ[row] + sSQ[64 + row] + sSQ[128 + row] + sSQ[192 + row];
                float hv[8], g1[8], o[8]; unpack8(*(const uint4*)(sH + row * 136 + col), hv); unpack8(pg1[i], g1);
                if (MODE == 0) {
                    float g2[8]; unpack8(pg2[i], g2);
                    const float rs = rsqrtf(ssq * (1.f / 128.f) + EPS);
#pragma unroll
                    for (int e = 0; e < 8; ++e) o[e] = hv[e] * rs * normw[col + e] * sigmoidf_(g1[e]) * siluf_(g2[e]);
                } else {
                    const float mean = (sSM[row] + sSM[64 + row] + sSM[128 + row] + sSM[192 + row]) * (1.f / 128.f);
                    const float var = fmaxf(ssq * (1.f / 128.f) - mean * mean, 0.f);
                    const float rs = rsqrtf(var + EPS);
#pragma unroll
                    for (int e = 0; e < 8; ++e) o[e] = (hv[e] - mean) * rs * siluf_(g1[e]);
                }
                *(uint4*)(seq + (size_t)c * 64 * LDP + (size_t)MR_OFFV(i)) = pack8f(o);
            }
            __builtin_amdgcn_sched_barrier(0);
        }
        mprev = mnew;
        LBAR(); OPQ(fr); OPQ(fq); OPQ(ht); OPQ(lane);
    }
#undef MR_LOAD
#undef MR_OFFQ
#undef MR_OKQ
#undef MR_OFFV
#undef MR_OKV
    OPQS(outC); OPQS(outN); OPQS(outM);
#pragma unroll
    for (int m = 0; m < 4; ++m)
#pragma unroll
        for (int n = 0; n < 2; ++n)
#pragma unroll
            for (int j = 0; j < 4; ++j) { const int k = 16 * m + 4 * fq + j, v = 32 * hw + 16 * n + fr; outC[k * 128 + v] = Cacc[m][n][j]; }
    if (MODE == 0) { if (ht < 64) outN[ht] = sN[ht]; if (ht == 0) outM[0] = mprev; }
}

template <int NV>
DI void chain_hgrn(unsigned char* sm, const int tid_o, const int w, const int lane_o, u16* seq, const int nch, const int h,
                   const float* lbraw, const int layer, const float* initS, float* outS, const float* normw) {
    constexpr int nvalid = NV;
    const int fr_o = lane_o & 15, fq_o = lane_o >> 4;
    const int fr = fr_o, fq = fq_o, tid = tid_o;
    float* LFB = (float*)sm;
    u16* sQ = (u16*)(sm + 33792); u16* sK = (u16*)(sm + 51200); u16* sKW = (u16*)(sm + 68608); u16* sV = (u16*)(sm + 86016); u16* sP = (u16*)(sm + 103424);
    u16* sH = sQ;
    float* TOT = (float*)(sm + 112640); float* BLAST = (float*)(sm + 114688); float* DEC = (float*)(sm + 115200); float* SSQ = (float*)(sm + 115712);
    const int qoff = 5632 + h * 128, foff = 6144 + h * 128, ioff = 6656 + h * 128, goff = 1536 + h * 128;
    const int k0 = (tid & 15) * 8;
    float lbv[8];
#pragma unroll
    for (int e = 0; e < 8; ++e) { const int cidx = h * 128 + k0 + e; lbv[e] = (float)layer * sigmoidf_(lbraw[512 + cidx] - lbraw[cidx]); }
    f32x4 Sacc[8];
#pragma unroll
    for (int m = 0; m < 8; ++m)
#pragma unroll
        for (int j = 0; j < 4; ++j) Sacc[m][j] = initS ? initS[(16 * m + 4 * fq + j) * 128 + 16 * w + fr] : 0.f;
    uint4 phq[2], phf[2], phi[2], pg[2];
#define HG_OFF(i) ((unsigned)((((i) * 32 + (tid >> 4)) < nvalid ? ((i) * 32 + (tid >> 4)) : 0) * LDP + qoff + (tid & 15) * 8))
#define HG_OK(i) (((i) * 32 + (tid >> 4)) < nvalid)
#define HG_LOAD(c) do { const u16* cb_ = seq + (size_t)(c) * 64 * LDP; _Pragma("unroll") for (int i = 0; i < 2; ++i) { \
        phq[i] = ldsel(cb_, HG_OFF(i), HG_OK(i)); phf[i] = ldsel(cb_ + (foff - qoff), HG_OFF(i), HG_OK(i)); phi[i] = ldsel(cb_ + (ioff - qoff), HG_OFF(i), HG_OK(i)); } } while (0)
    HG_LOAD(0);
    __syncthreads();
    for (int c = 0; c < nch; ++c) {
        int fr = fr_o, fq = fq_o, tid = tid_o; OPQ(fr); OPQ(fq); OPQ(tid);
        const int k0 = (tid & 15) * 8;
        float qf[2][8], kk[2][8];
#pragma unroll
        for (int i = 0; i < 2; ++i) {
            const int row = (i * 512 + tid) >> 4;
            float hf[8], lf[8]; unpack8(phq[i], qf[i]); unpack8(phf[i], hf);
#pragma unroll
            for (int e = 0; e < 8; ++e) {
                const float sg = sigmoidf_(hf[e]);
                if (row < nvalid) { lf[e] = __logf(lbv[e] + (1.f - lbv[e]) * sg); kk[i][e] = (1.f - lbv[e]) * (1.f - sg); } else { lf[e] = 0.f; kk[i][e] = 0.f; }
            }
            *(f32x4*)(LFB + row * 132 + k0) = (f32x4){lf[0], lf[1], lf[2], lf[3]}; *(f32x4*)(LFB + row * 132 + k0 + 4) = (f32x4){lf[4], lf[5], lf[6], lf[7]};
            *(uint4*)(sV + row * 136 + k0) = phi[i];
        }
        LBAR(); OPQ(fr); OPQ(fq); OPQ(tid);
        {
            const int k = tid & 127, seg = tid >> 7; float loc[16], run = 0.f;
#pragma unroll
            for (int i = 0; i < 16; ++i) { run += LFB[(16 * seg + i) * 132 + k]; loc[i] = run; }
            TOT[seg * 128 + k] = run;
            LBAR(); OPQ(fr); OPQ(fq); OPQ(tid);
            float off = 0.f;
#pragma unroll
            for (int s2 = 0; s2 < 3; ++s2) if (s2 < seg) off += TOT[s2 * 128 + k];
#pragma unroll
            for (int i = 0; i < 16; ++i) LFB[(16 * seg + i) * 132 + k] = loc[i] + off;
            if (seg == 3) { const float bl = off + run; BLAST[k] = bl; DEC[k] = __expf(bl); }
        }
        LBAR(); OPQ(fr); OPQ(fq); OPQ(tid);
#pragma unroll
        for (int i = 0; i < 2; ++i) {
            const int row = (i * 512 + tid) >> 4;
            const f32x4 b0 = *(const f32x4*)(LFB + row * 132 + k0), b1 = *(const f32x4*)(LFB + row * 132 + k0 + 4);
            const f32x4 l0 = *(const f32x4*)(BLAST + k0), l1 = *(const f32x4*)(BLAST + k0 + 4);
            float qt[8], kt[8], kw[8];
#pragma unroll
            for (int e = 0; e < 8; ++e) {
                const float b = e < 4 ? b0[e & 3] : b1[e & 3], bl = e < 4 ? l0[e & 3] : l1[e & 3];
                qt[e] = qf[i][e] * __expf(b); kt[e] = kk[i][e] * __expf(fminf(-b, 80.f));
                kw[e] = kk[i][e] * __expf(bl - b);
            }
            *(uint4*)(sQ + row * 136 + k0) = pack8f(qt); *(uint4*)(sK + row * 136 + k0) = pack8f(kt); *(uint4*)(sKW + row * 136 + k0) = pack8f(kw);
        }
        LBAR(); OPQ(fr); OPQ(fq); OPQ(tid);
        if (c + 1 < nch) HG_LOAD(c + 1);
#pragma unroll
        for (int i = 0; i < 2; ++i) pg[i] = ldsel(seq + (size_t)c * 64 * LDP + goff - qoff, HG_OFF(i), HG_OK(i));
        f32x4 O[4];
#pragma unroll
        for (int m = 0; m < 4; ++m) O[m] = (f32x4){0.f, 0.f, 0.f, 0.f};
#pragma unroll
        for (int t = 0; t < 4; ++t) {
            const bf16x8 Bf = pack_acc2(Sacc[2 * t], Sacc[2 * t + 1]);
#pragma unroll
            for (int m = 0; m < 4; ++m) O[m] = MFMA16(ldfrag2(sQ + (16 * m + fr) * 136 + 32 * t + 4 * fq), Bf, O[m]);
        }
        {
            const int mt = w >> 1;
#pragma unroll
            for (int nn = 0; nn < 2; ++nn) {
                const int n = (w & 1) * 2 + nn;
                if (n <= mt) {
                    f32x4 S = (f32x4){0.f, 0.f, 0.f, 0.f};
#pragma unroll
                    for (int t = 0; t < 4; ++t) S = MFMA16(ldfrag(sQ + (16 * mt + fr) * 136 + 32 * t + 8 * fq), ldfrag(sK + (16 * n + fr) * 136 + 32 * t + 8 * fq), S);
#pragma unroll
                    for (int j = 0; j < 4; ++j) { const int l = 16 * mt + 4 * fq + j, s = 16 * n + fr; sP[l * 72 + s] = (s <= l) ? f2bf(S[j]) : (u16)0; }
                } else {
#pragma unroll
                    for (int j = 0; j < 4; ++j) sP[(16 * mt + 4 * fq + j) * 72 + 16 * n + fr] = 0;
                }
            }
        }
        LBAR(); OPQ(fr); OPQ(fq); OPQ(tid);
#pragma unroll
        for (int m = 0; m < 8; ++m) { const f32x4 d4 = *(const f32x4*)(DEC + 16 * m + 4 * fq);
#pragma unroll
            for (int j = 0; j < 4; ++j) Sacc[m][j] *= d4[j]; }
#pragma unroll
        for (int t = 0; t < 2; ++t) {
            const bf16x8 Bv = ldfrag_tr(sV + (32 * t + 8 * fq + ((fr >> 2) & 3)) * 136 + 16 * w + 4 * (fr & 3), 136);
#pragma unroll
            for (int m = 0; m < 4; ++m) O[m] = MFMA16(ldfrag(sP + (16 * m + fr) * 72 + 32 * t + 8 * fq), Bv, O[m]);
#pragma unroll
            for (int m = 0; m < 8; ++m) Sacc[m] = MFMA16(ldfrag_tr(sKW + (32 * t + 8 * fq + ((fr >> 2) & 3)) * 136 + 16 * m + 4 * (fr & 3), 136), Bv, Sacc[m]);
        }
#pragma unroll
        for (int m = 0; m < 4; ++m)
#pragma unroll
            for (int j = 0; j < 4; ++j) {
                const int l = 16 * m + 4 * fq + j; const float o = O[m][j] * 0.08838834764831845f;
                const float sq = red16(o * o);
                if (fr == 0) SSQ[w * 64 + l] = sq;
                sH[l * 136 + 16 * w + fr] = f2bf(o);
            }
        LBAR(); OPQ(fr); OPQ(fq); OPQ(tid);
#pragma unroll
        for (int i = 0; i < 2; ++i) {
            const int row = (i * 512 + tid) >> 4;
            if (row < nvalid) {
                float ssq = 0.f;
#pragma unroll
                for (int ww = 0; ww < 8; ++ww) ssq += SSQ[ww * 64 + row];
                const float rs = rsqrtf(ssq * (1.f / 128.f) + EPS);
                float hv[8], g[8], o[8]; unpack8(*(const uint4*)(sH + row * 136 + k0), hv); unpack8(pg[i], g);
#pragma unroll
                for (int e = 0; e < 8; ++e) o[e] = hv[e] * rs * normw[k0 + e] * siluf_(g[e]);
                *(uint4*)(seq + (size_t)c * 64 * LDP + goff - qoff + (size_t)HG_OFF(i)) = pack8f(o);
            }
            __builtin_amdgcn_sched_barrier(0);
        }
        LBAR(); OPQ(fr); OPQ(fq); OPQ(tid);
    }
#undef HG_LOAD
#undef HG_OFF
#undef HG_OK
    OPQS(outS);
#pragma unroll
    for (int m = 0; m < 8; ++m)
#pragma unroll
        for (int j = 0; j < 4; ++j) outS[(16 * m + 4 * fq + j) * 128 + 16 * w + fr] = Sacc[m][j];
}

template <int NV>
DI void block_ssd(unsigned char* sm, const int tid_o, const int w, const int lane_o, u16* seq, const float* gates, const int nch, const int g, const int hp,
                  const float* convw, const float* convb, const float* dtb, const float* alog, const float* dsk, const float* snw,
                  const float* initH, const float* initConv, float* outH, float* outConv, float* ssq) {
    constexpr int nvalid = NV;
    const int fr_o = lane_o & 15, fq_o = lane_o >> 4, hh = w >> 2, jw = w & 3, head = g * 4 + hp * 2 + hh;
    const int fr = fr_o, fq = fq_o, lane = lane_o, tid = tid_o;
    u16* sC = (u16*)sm; u16* sB = (u16*)(sm + 17408); u16* sX = (u16*)(sm + 34816);
    u16* sP = (u16*)(sm + 52224 + hh * 9216);
    u16* OB = (u16*)sm;
    float* TAB = (float*)(sm + 70656);
    float* BV = (float*)(sm + 78336); float* DTV = BV + 128; float* WV = BV + 256;
    const int rs8 = w;
    for (int idx = tid; idx < 5 * 384; idx += 512) {
        const int tap = idx / 384, lc = idx - tap * 384, c8 = lc >> 3, e = lc & 7;
        const int ch = (c8 < 16 ? g * 256 + hp * 128 + c8 * 8 : (c8 < 32 ? 512 + g * 128 + (c8 - 16) * 8 : 768 + g * 128 + (c8 - 32) * 8)) + e;
        TAB[idx] = tap < 4 ? convw[tap * 1024 + ch] : convb[ch];
    }
    f32x4 hacc[8];
#pragma unroll
    for (int m = 0; m < 8; ++m)
#pragma unroll
        for (int j = 0; j < 4; ++j) hacc[m][j] = initH ? initH[((size_t)head * 128 + 16 * m + 4 * fq + j) * 64 + 16 * jw + fr] : 0.f;
    const float dtbias = dtb[head], Aneg = -__expf(alog[head]), Dsk = dsk[head];
    uint4 pr[11]; float sdt = 0.f;
#define SSD_CP (lane < 48 ? lane : 47)
#define SSD_GCOL (SSD_CP < 16 ? 4608 + g * 256 + hp * 128 + SSD_CP * 8 : (SSD_CP < 32 ? 4608 + 512 + g * 128 + (SSD_CP - 16) * 8 : 4608 + 768 + g * 128 + (SSD_CP - 32) * 8))
#define SSD_OFFZ(i) ((unsigned)((((i) * 32 + (tid >> 4)) < nvalid ? ((i) * 32 + (tid >> 4)) : 0) * LDP + 1024 + g * 256 + hp * 128 + (tid & 15) * 8))
#define SSD_OKZ(i) (((i) * 32 + (tid >> 4)) < nvalid)
#define SSD_LOAD(c) do { const u16* cb_ = seq + (size_t)(c) * 64 * LDP; const unsigned gc_ = (unsigned)SSD_GCOL; _Pragma("unroll") for (int i = 0; i < 11; ++i) { const int row = 8 * rs8 - 3 + i; \
        const bool ok_ = row < nvalid && ((c) * 64 + row) >= 0; pr[i] = ldsel(cb_ + (ok_ ? row * LDP : 0), gc_, ok_); } \
        sdt = (lane < nvalid) ? gates[(size_t)(c) * 64 * 16 + (unsigned)((lane < nvalid ? lane : 0) * 16 + 8 + head)] : 0.f; } while (0)
    SSD_LOAD(0);
    __syncthreads();
    for (int c = 0; c < nch; ++c) {
        int fr = fr_o, fq = fq_o, lane = lane_o, tid = tid_o; OPQ(fr); OPQ(fq); OPQ(lane); OPQ(tid);
        const int cp = SSD_CP; const bool act = lane < 48; const int gcol = SSD_GCOL;
        {
            const bool useinit = (c == 0 && rs8 == 0 && initConv != nullptr);
            u16* dstp = cp < 16 ? sX + cp * 8 : (cp < 32 ? sB + (cp - 16) * 8 : sC + (cp - 32) * 8);
            uint2 ylo[8];
#pragma unroll 1
            for (int half = 0; half < 2; ++half) {
                f32x4 tw[5];
#pragma unroll
                for (int tp = 0; tp < 5; ++tp) tw[tp] = *(const f32x4*)(TAB + tp * 384 + cp * 8 + half * 4);
                f32x4 acc[8];
#pragma unroll
                for (int i = 0; i < 8; ++i) acc[i] = tw[4];
#pragma unroll
                for (int k = 0; k < 11; ++k) {
                    const unsigned w0 = half ? pr[k].z : pr[k].x, w1 = half ? pr[k].w : pr[k].y;
                    f32x4 cur = (f32x4){lo16(w0), hi16(w0), lo16(w1), hi16(w1)};
                    if (k < 3 && useinit) cur = *(const f32x4*)(initConv + k * 1024 + (gcol - 4608) + half * 4);
#pragma unroll
                    for (int i = 0; i < 8; ++i) {
                        if (k - i >= 0 && k - i <= 3) {
#pragma unroll
                            for (int e = 0; e < 4; ++e) acc[i][e] += tw[k - i][e] * cur[e];
                        }
                    }
                }
#pragma unroll
                for (int i = 0; i < 8; ++i) {
                    const int row = 8 * rs8 + i;
                    float y[4];
#pragma unroll
                    for (int e = 0; e < 4; ++e) y[e] = (row < nvalid) ? siluf_(acc[i][e]) : 0.f;
                    uint2 pk; pk.x = pk2(y[0], y[1]); pk.y = pk2(y[2], y[3]);
                    if (half == 0) ylo[i] = pk;
                    else if (act) { uint4 v; v.x = ylo[i].x; v.y = ylo[i].y; v.z = pk.x; v.w = pk.y; *(uint4*)(dstp + row * 136) = v; }
                }
            }
        }
        float blast;
        {
            const float dt = (lane < nvalid) ? softplusf_(sdt + dtbias) : 0.f;
            const float la = dt * Aneg;
            const float b = wscan_sum(la, lane);
            blast = __shfl(b, 63);
            if (jw == 0) { BV[hh * 64 + lane] = b; DTV[hh * 64 + lane] = dt; WV[hh * 64 + lane] = __expf(blast - b) * dt; }
        }
        LBAR(); OPQ(fr); OPQ(fq); OPQ(lane); OPQ(tid);
        f32x4 O[4];
#pragma unroll
        for (int m = 0; m < 4; ++m) O[m] = (f32x4){0.f, 0.f, 0.f, 0.f};
#pragma unroll
        for (int t = 0; t < 4; ++t) {
            const bf16x8 Bf = pack_acc2(hacc[2 * t], hacc[2 * t + 1]);
#pragma unroll
            for (int m = 0; m < 4; ++m) O[m] = MFMA16(ldfrag2(sC + (16 * m + fr) * 136 + 32 * t + 4 * fq), Bf, O[m]);
        }
#pragma unroll
        for (int m = 0; m < 4; ++m) { const f32x4 b4 = *(const f32x4*)(BV + hh * 64 + 16 * m + 4 * fq);
#pragma unroll
            for (int j = 0; j < 4; ++j) O[m][j] *= __expf(b4[j]); }
        {
            const int mt = jw;
            const f32x4 bl4 = *(const f32x4*)(BV + hh * 64 + 16 * mt + 4 * fq);
#pragma unroll
            for (int n = 0; n < 4; ++n) {
                if (n <= mt) {
                    f32x4 S = (f32x4){0.f, 0.f, 0.f, 0.f};
#pragma unroll
                    for (int t = 0; t < 4; ++t) S = MFMA16(ldfrag(sC + (16 * mt + fr) * 136 + 32 * t + 8 * fq), ldfrag(sB + (16 * n + fr) * 136 + 32 * t + 8 * fq), S);
                    const int s = 16 * n + fr; const float bs = BV[hh * 64 + s], ds = DTV[hh * 64 + s];
#pragma unroll
                    for (int j = 0; j < 4; ++j) { const int l = 16 * mt + 4 * fq + j; sP[l * 72 + s] = (s <= l) ? f2bf(S[j] * __expf(bl4[j] - bs) * ds) : (u16)0; }
                } else {
#pragma unroll
                    for (int j = 0; j < 4; ++j) sP[(16 * mt + 4 * fq + j) * 72 + 16 * n + fr] = 0;
                }
            }
        }
        LBAR(); OPQ(fr); OPQ(fq); OPQ(lane); OPQ(tid);
        {
            const float eb = __expf(blast);
#pragma unroll
            for (int m = 0; m < 8; ++m)
#pragma unroll
                for (int j = 0; j < 4; ++j) hacc[m][j] *= eb;
        }
#pragma unroll
        for (int t = 0; t < 2; ++t) {
            const f32x4 w0 = *(const f32x4*)(WV + hh * 64 + 32 * t + 8 * fq), w1 = *(const f32x4*)(WV + hh * 64 + 32 * t + 8 * fq + 4);
            const bf16x8 Bv = ldfrag_tr(sX + (32 * t + 8 * fq + ((fr >> 2) & 3)) * 136 + hh * 64 + 16 * jw + 4 * (fr & 3), 136);
            float x[8]; unpack8(__builtin_bit_cast(uint4, Bv), x);
#pragma unroll
            for (int e = 0; e < 4; ++e) { x[e] *= w0[e]; x[4 + e] *= w1[e]; }
            const bf16x8 Bw = as_frag(pack8f(x));
#pragma unroll
            for (int m = 0; m < 4; ++m) O[m] = MFMA16(ldfrag(sP + (16 * m + fr) * 72 + 32 * t + 8 * fq), Bv, O[m]);
#pragma unroll
            for (int m = 0; m < 8; ++m) hacc[m] = MFMA16(ldfrag_tr(sB + (32 * t + 8 * fq + ((fr >> 2) & 3)) * 136 + 16 * m + 4 * (fr & 3), 136), Bw, hacc[m]);
        }
#pragma unroll
        for (int m = 0; m < 4; ++m) {
            const int pcol = hh * 64 + 16 * jw + fr;
            const uint2 xr = __builtin_bit_cast(uint2, ld_tr4(sX + (16 * m + 4 * fq + ((fr >> 2) & 3)) * 136 + hh * 64 + 16 * jw + 4 * (fr & 3)));
            const float xs0 = lo16(xr.x), xs1 = hi16(xr.x), xs2 = lo16(xr.y), xs3 = hi16(xr.y);
            const int l0 = 16 * m + 4 * fq;
            OB[(l0 + 0) * 136 + pcol] = f2bf(O[m][0] + Dsk * xs0);
            OB[(l0 + 1) * 136 + pcol] = f2bf(O[m][1] + Dsk * xs1);
            OB[(l0 + 2) * 136 + pcol] = f2bf(O[m][2] + Dsk * xs2);
            OB[(l0 + 3) * 136 + pcol] = f2bf(O[m][3] + Dsk * xs3);
        }
        LBAR(); OPQ(fr); OPQ(fq); OPQ(lane); OPQ(tid);
        if (c + 1 < nch) SSD_LOAD(c + 1);
#pragma unroll
        for (int i = 0; i < 2; ++i) {
            const int id = i * 512 + tid, row = id >> 4, col = (id & 15) * 8;
            float yv[8], z[8], val[8]; unpack8(*(const uint4*)(OB + row * 136 + col), yv); unpack8(ldsel(seq + (size_t)c * 64 * LDP, SSD_OFFZ(i), SSD_OKZ(i)), z);
            float ss = 0.f;
#pragma unroll
            for (int e = 0; e < 8; ++e) { val[e] = yv[e] * siluf_(z[e]); ss += val[e] * val[e]; }
            ss = red16(ss);
            if (row < nvalid) {
                if ((tid & 15) == 0) ssq[(size_t)(c * 64 + row) * 4 + g * 2 + hp] = ss;
                float o[8];
#pragma unroll
                for (int e = 0; e < 8; ++e) o[e] = val[e] * snw[g * 256 + hp * 128 + col + e];
                *(uint4*)(seq + (size_t)c * 64 * LDP + (size_t)SSD_OFFZ(i)) = pack8f(o);
            }
            __builtin_amdgcn_sched_barrier(0);
        }
        LBAR(); OPQ(fr); OPQ(fq); OPQ(lane); OPQ(tid);
    }
#undef SSD_LOAD
#undef SSD_GCOL
#undef SSD_CP
#undef SSD_OFFZ
#undef SSD_OKZ
    OPQS(outH); OPQS(outConv);
#pragma unroll
    for (int m = 0; m < 8; ++m)
#pragma unroll
        for (int j = 0; j < 4; ++j) outH[((size_t)head * 128 + 16 * m + 4 * fq + j) * 64 + 16 * jw + fr] = hacc[m][j];
    if (hp == 0) {
        const int T = (nch - 1) * 64 + nvalid;
        for (int idx = tid; idx < 3 * 512; idx += 512) { const int rr = idx >> 9, ch = g * 512 + (idx & 511);
            outConv[rr * 1024 + ch] = bf2f(seq[(size_t)(T - 3 + rr) * LDP + 4608 + ch]); }
    }
}

template <int MIX>
DI void mixer_phase(const Params& p, int l_in, unsigned char* sm) {
    const int l = __builtin_amdgcn_readfirstlane(l_in);
    u16* proj = (u16*)(p.ws + WS_PROJ); u16* sproj = (u16*)(p.ws + WS_SPROJ);
    const float* gates = (const float*)(p.ws + WS_GATES); const float* sgates = (const float*)(p.ws + WS_SGATES);
    float* out = p.out;
    float* ssqb = (float*)(p.ws + WS_SSQ);
    for (int task = blockIdx.x; task < 288; task += gridDim.x) {
        int tid = threadIdx.x; OPQ(tid);
        const int w = __builtin_amdgcn_readfirstlane(tid >> 6), lane = tid & 63;
        const int tk = __builtin_amdgcn_readfirstlane(task);
        if (MIXON(0) && (tk < 32 || (tk >= 96 && tk < 160))) {
            const bool smp = tk < 32; const int t2 = smp ? tk : tk - 96; const int b = t2 >> 2, g = (t2 >> 1) & 1, hp = t2 & 1;
            u16* seq = smp ? sproj + (size_t)b * 16 * LDP : proj + (size_t)b * SEQ * LDP;
            const float* gt = smp ? sgates + (size_t)b * 16 * 16 : gates + (size_t)b * SEQ * 16;
            const int nb = smp ? DEC_BATCH : BATCH;
            float* oH = out + (smp ? O_SSSD : O_PSSD) + ((size_t)l * nb + b) * 8 * 128 * 64;
            float* oC = out + (smp ? O_SCONV : O_PCONV) + ((size_t)l * nb + b) * 3 * 1024;
            float* sq = ssqb + (smp ? (size_t)(NTOK + b * 16) * 4 : (size_t)b * SEQ * 4);
            if (smp) block_ssd<16>(sm, tid, w, lane, seq, gt, 1, g, hp,
                      p.conv_w + (size_t)l * 4 * 1024, p.conv_b + l * 1024, p.dt_bias + l * 8, p.a_log + l * 8, p.d_skip + l * 8, p.snorm_w + l * 512,
                      smp ? p.st_ssd + ((size_t)l * DEC_BATCH + b) * 8 * 128 * 64 : nullptr, smp ? p.st_conv + ((size_t)l * DEC_BATCH + b) * 3 * 1024 : nullptr, oH, oC, sq);
            else block_ssd<64>(sm, tid, w, lane, seq, gt, 32, g, hp,
                      p.conv_w + (size_t)l * 4 * 1024, p.conv_b + l * 1024, p.dt_bias + l * 8, p.a_log + l * 8, p.d_skip + l * 8, p.snorm_w + l * 512,
                      smp ? p.st_ssd + ((size_t)l * DEC_BATCH + b) * 8 * 128 * 64 : nullptr, smp ? p.st_conv + ((size_t)l * DEC_BATCH + b) * 3 * 1024 : nullptr, oH, oC, sq);
        } else if (MIXON(1) && ((tk >= 32 && tk < 64) || tk >= 224)) {
            const bool smp = tk < 64; const int t2 = smp ? tk - 32 : tk - 224; const int b = t2 >> 2, h = t2 & 3;
            u16* seq = smp ? sproj + (size_t)b * 16 * LDP : proj + (size_t)b * SEQ * LDP;
            const int nb = smp ? DEC_BATCH : BATCH;
            float* oS = out + (smp ? O_SHG : O_PHG) + (((size_t)l * nb + b) * 4 + h) * 128 * 128;
            if (smp) chain_hgrn<16>(sm, tid, w, lane, seq, 1, h, p.lbraw, l,
                       smp ? p.st_hg + (((size_t)l * DEC_BATCH + b) * 4 + h) * 128 * 128 : nullptr, oS, p.hnorm_w + l * 512 + h * 128);
            else chain_hgrn<64>(sm, tid, w, lane, seq, 32, h, p.lbraw, l,
                       smp ? p.st_hg + (((size_t)l * DEC_BATCH + b) * 4 + h) * 128 * 128 : nullptr, oS, p.hnorm_w + l * 512 + h * 128);
        } else if ((tk >= 64 && tk < 96) || (tk >= 160 && tk < 224)) {
            int t2; bool smp, ret;
            if (tk < 80) { smp = true; ret = false; t2 = tk - 64; }
            else if (tk < 96) { smp = true; ret = true; t2 = tk - 80; }
            else if (tk < 192) { smp = false; ret = false; t2 = tk - 160; }
            else { smp = false; ret = true; t2 = tk - 192; }
            const int chain = t2 * 2 + (w >> 2); const int b = chain >> 2, h = chain & 3;
            u16* seq = smp ? sproj + (size_t)b * 16 * LDP : proj + (size_t)b * SEQ * LDP;
            const float* gt = smp ? sgates + (size_t)b * 16 * 16 : gates + (size_t)b * SEQ * 16;
            const int nb = smp ? DEC_BATCH : BATCH;
            const size_t si = ((size_t)l * nb + b) * 4 + h;
            unsigned char* csm = sm + (w >> 2) * 65536;
            if (MIXON(2) && !ret) {
                if (smp) chain_mr<0, 16>(csm, tid & 255, w & 3, lane, seq, gt, 1, 0, h,
                            smp ? p.st_mc + si * 64 * 128 : nullptr, smp ? p.st_mn + si * 64 : nullptr, smp ? p.st_mm + si : nullptr,
                            out + (smp ? O_SMC : O_PMC) + si * 64 * 128, out + (smp ? O_SMN : O_PMN) + si * 64, out + (smp ? O_SMM : O_PMM) + si,
                            p.mnorm_w + l * 512 + h * 128, p.gate_b[l * 8 + h], p.gate_b[l * 8 + 4 + h]);
                else chain_mr<0, 64>(csm, tid & 255, w & 3, lane, seq, gt, 32, 0, h,
                            smp ? p.st_mc + si * 64 * 128 : nullptr, smp ? p.st_mn + si * 64 : nullptr, smp ? p.st_mm + si : nullptr,
                            out + (smp ? O_SMC : O_PMC) + si * 64 * 128, out + (smp ? O_SMN : O_PMN) + si * 64, out + (smp ? O_SMM : O_PMM) + si,
                            p.mnorm_w + l * 512 + h * 128, p.gate_b[l * 8 + h], p.gate_b[l * 8 + 4 + h]);
            } else if (MIXON(3) && ret) {
                if (smp) chain_mr<1, 16>(csm, tid & 255, w & 3, lane, seq, gt, 1, PAST_LEN, h,
                            smp ? p.st_ret + si * 64 * 128 : nullptr, nullptr, nullptr,
                            out + (smp ? O_SRET : O_PRET) + si * 64 * 128, nullptr, nullptr, nullptr, 0.f, 0.f);
                else chain_mr<1, 64>(csm, tid & 255, w & 3, lane, seq, gt, 32, 0, h,
                            smp ? p.st_ret + si * 64 * 128 : nullptr, nullptr, nullptr,
                            out + (smp ? O_SRET : O_PRET) + si * 64 * 128, nullptr, nullptr, nullptr, 0.f, 0.f);
            }
        }
        __syncthreads();
    }
}

DI void final_norm(const Params& p, int gw, int ngw, int lane) {
    const u16* X = (const u16*)(p.ws + WS_PROJ);
    const int NR = NTOK + NSTOK;
    float4 q0[4], q1[4], q2[4];
#define FN_LD(q, rr) do { _Pragma("unroll") for (int i = 0; i < 4; ++i) { \
        if ((rr) < NTOK) q[i] = *(const float4*)((const float*)(X + (size_t)(rr) * LDP + 2048) + i * 256 + lane * 4); \
        else if ((rr) < NR) q[i] = *(const float4*)(p.out + O_YS + (size_t)((rr) - NTOK) * 1024 + i * 256 + lane * 4); \
        else q[i] = make_float4(0.f, 0.f, 0.f, 0.f); } } while (0)
    float4 wv[4];
#pragma unroll
    for (int i = 0; i < 4; ++i) wv[i] = *(const float4*)(p.fnorm_w + i * 256 + lane * 4);
    FN_LD(q0, gw); FN_LD(q1, gw + ngw);
    for (int r = gw; r < NR; r += ngw) {
        FN_LD(q2, r + 2 * ngw);
        float ss = 0.f;
#pragma unroll
        for (int i = 0; i < 4; ++i) ss += q0[i].x * q0[i].x + q0[i].y * q0[i].y + q0[i].z * q0[i].z + q0[i].w * q0[i].w;
        ss = wsum(ss);
        const float rs = rsqrtf(ss * (1.f / 1024.f) + EPS);
        float* dst = (r < NTOK) ? p.out + O_YP + (size_t)r * 1024 : p.out + O_YS + (size_t)(r - NTOK) * 1024;
#pragma unroll
        for (int i = 0; i < 4; ++i) { const int k = i * 256 + lane * 4;
            float4 o; o.x = q0[i].x * rs * wv[i].x; o.y = q0[i].y * rs * wv[i].y; o.z = q0[i].z * rs * wv[i].z; o.w = q0[i].w * rs * wv[i].w;
            *(float4*)(dst + k) = o; }
#pragma unroll
        for (int i = 0; i < 4; ++i) { q0[i] = q1[i]; q1[i] = q2[i]; }
    }
#undef FN_LD
}


#define XB_TMO      128
#define XB_XCNT(j)  (256  + 64 * (j))
#define XB_XSUB(j)  (1280 + 64 * (j))
#define XB_XGEN(j)  (2304 + 64 * (j))
#define XB_TOP      3328
#define XB_TOPGEN   3392
#define XCD_BAR_WORDS 3456
#define XB_SPIN_CAP (1u << 18)
DI unsigned xb_ld(unsigned* p)              { return __hip_atomic_load(p, __ATOMIC_RELAXED, __HIP_MEMORY_SCOPE_AGENT); }
DI unsigned xb_add(unsigned* p, unsigned v) { return __hip_atomic_fetch_add(p, v, __ATOMIC_RELAXED, __HIP_MEMORY_SCOPE_AGENT); }
DI unsigned xb_xcc_id() { return (unsigned)__builtin_amdgcn_s_getreg((3 << 11) | 20) & 0xFu; }
#define XB_SPIN(cond, bar) do { unsigned _sp = 0; while (cond) { __builtin_amdgcn_s_sleep(1); \
    if ((++_sp & 255u) == 0u) { if (xb_ld(&(bar)[XB_TMO])) break; if (_sp > XB_SPIN_CAP) { atomicAdd(&(bar)[XB_TMO], 1u); break; } } } } while (0)
struct XcdBarrier { unsigned* bar; unsigned x; volatile LAS unsigned* st; };
DI void xcd_barrier_post(unsigned* bar) { if (threadIdx.x == 0) (void)xb_add(&bar[XB_XCNT(xb_xcc_id())], 1u); }
DI void xcd_barrier_complete(unsigned* bar, unsigned x, unsigned& nloc, unsigned& nx) {
    const unsigned G = gridDim.x * gridDim.y * gridDim.z;
    unsigned sum, cnt, mine, sp = 0u;
    for (;;) {
        sum = 0u; cnt = 0u; mine = 0u;
#pragma unroll
        for (unsigned j = 0; j < 16; ++j) { const unsigned c = xb_ld(&bar[XB_XCNT(j)]); sum += c; cnt += (c > 0u) ? 1u : 0u; mine = (j == x) ? c : mine; }
        if (sum == G) break;
        __builtin_amdgcn_s_sleep(1);
        if ((++sp & 255u) == 0u) { if (xb_ld(&bar[XB_TMO])) break; if (sp > XB_SPIN_CAP) { atomicAdd(&bar[XB_TMO], 1u); break; } }
    }
    nloc = mine > 0u ? mine : 1u; nx = cnt > 0u ? cnt : 1u;
}
DI void xcd_barrier(const XcdBarrier& b) {
    asm volatile("s_waitcnt vmcnt(0)" ::: "memory");
    __syncthreads();
    if (threadIdx.x == 0) {
        unsigned* bar = b.bar;
        __builtin_amdgcn_s_waitcnt(0);
        unsigned nloc = b.st[0], nx = b.st[1];
        if (nloc == 0u) { xcd_barrier_complete(bar, b.x, nloc, nx); b.st[0] = nloc; b.st[1] = nx; }
        const unsigned old = xb_add(&bar[XB_XSUB(b.x)], 1u);
        const unsigned gen = old / nloc;
        if (old + 1u == (gen + 1u) * nloc) {
            __builtin_amdgcn_fence(__ATOMIC_RELEASE, "agent");
            asm volatile("s_waitcnt vmcnt(0)" ::: "memory");
            const unsigned og = xb_add(&bar[XB_TOP], 1u);
            const unsigned tg = og / nx;
            if (og + 1u == (tg + 1u) * nx) xb_add(&bar[XB_TOPGEN], 1u);
            else XB_SPIN(xb_ld(&bar[XB_TOPGEN]) == tg, bar);
            __builtin_amdgcn_fence(__ATOMIC_ACQUIRE, "agent");
            xb_add(&bar[XB_XGEN(b.x)], 1u);
            asm volatile("s_waitcnt vmcnt(0)" ::: "memory");
        } else {
            XB_SPIN(xb_ld(&bar[XB_XGEN(b.x)]) == gen, bar);
            __builtin_amdgcn_fence(__ATOMIC_ACQUIRE, "agent");
            asm volatile("s_waitcnt vmcnt(0)" ::: "memory");
        }
    }
    __syncthreads();
}
#define GRID_SEAM(first) do { if (first) cg::this_grid().sync(); else { XcdBarrier xb_; xb_.bar = (unsigned*)(p.ws + WS_BAR); xb_.x = xb_xcc_id(); xb_.st = (volatile LAS unsigned*)(LAS unsigned char*)(lds + LDS_BYTES - 16); xcd_barrier(xb_); } } while (0)

template <int PHSEL, int MIX>
DI void run_phases(const Params& p, unsigned char* lds) {
#define PSEL(x) (PHSEL < 0 || PHSEL == (x))
    if (COOP) { volatile LAS unsigned* st_ = (volatile LAS unsigned*)(LAS unsigned char*)(lds + LDS_BYTES - 16); if (threadIdx.x < 2) st_[threadIdx.x] = 0u; __syncthreads(); xcd_barrier_post((unsigned*)(p.ws + WS_BAR)); }
#ifndef PROG
#define PROG 0x876543210ull
#define NPROG 9
#endif
    for (int pi = p.ph_lo; pi < p.ph_hi; ++pi) {
        const int ph = __builtin_amdgcn_readfirstlane((int)((PROG >> (4 * pi)) & 15ull));
#define PH_IDS int tid = threadIdx.x; OPQ(tid); const int w = __builtin_amdgcn_readfirstlane(tid >> 6), lane = tid & 63; const int gw = blockIdx.x * 8 + w, ngw = gridDim.x * 8; (void)gw; (void)ngw; (void)lane
        u16* proj = (u16*)(p.ws + WS_PROJ); u16* sproj = (u16*)(p.ws + WS_SPROJ);
        float* gates = (float*)(p.ws + WS_GATES); float* sgates = (float*)(p.ws + WS_SGATES);
        float* rstd = (float*)(p.ws + WS_RSTD); float* srstd = (float*)(p.ws + WS_SRSTD);
        u16* shi = (u16*)(p.ws + WS_SHI);
        u16* X = (u16*)(p.out + O_YP);
        float* ys = p.out + O_YS;
        if (PSEL(0) && ph == 0) {
            PH_IDS;
            convert_weights(p, (float*)lds, tid);
            build_wg(p, 0, (float*)lds, tid);
            __syncthreads();
            prep_rows<0>(p.x_prompt, nullptr, NTOK, X, 2048, true, true, rstd, gates, nullptr, (const float*)lds, gw, ngw, lane);
            prep_rows<0>(p.x_sample, nullptr, NSTOK, shi, 1024, true, false, srstd, sgates, ys, (const float*)lds, gw, ngw, lane);
        } else if (PSEL(4) && ph == 4) {
            PH_IDS;
            build_wg(p, 1, (float*)lds, tid);
            __syncthreads();
            prep_rows<1>(nullptr, X, NTOK, nullptr, 0, false, false, rstd, gates, nullptr, (const float*)lds, gw, ngw, lane);
            prep_rows<0>(ys, nullptr, NSTOK, shi, 1024, true, false, srstd, sgates, nullptr, (const float*)lds, gw, ngw, lane);
        } else if (PSEL(1) && (ph == 1 || ph == 5)) {
            PH_IDS;
            const int l = ph == 1 ? 0 : 1;
            const u16* wt = (const u16*)(p.ws + WS_WTIN) + (size_t)l * LDP * 1024;
            sample_gemm<0>(shi, 1024, wt, LDP, 1024, gw, ngw, lane, sproj, srstd, nullptr, nullptr);
            __syncthreads();
            pg8::Gemm g; g.A = X; g.Bt = wt; g.M = NTOK; g.N = LDP; g.K = 1024; g.lda = 2048;
            pg8::StaticOrder S; S.init(g.M, g.N, (int)gridDim.x, (int)blockIdx.x);
            if (l == 0) { pg8::EpiIn<false> E; E.O = proj; E.rstd = rstd; pg8::gemm_phase<pg8::EpiIn<false>>((LAS unsigned char*)lds, g, S, E, tid); }
            else { pg8::EpiIn<true> E; E.O = proj; E.rstd = rstd; pg8::gemm_phase<pg8::EpiIn<true>>((LAS unsigned char*)lds, g, S, E, tid); }
        } else if (PSEL(2) && (ph == 2 || ph == 6)) {
            mixer_phase<MIX>(p, ph == 2 ? 0 : 1, lds);
        } else if (PSEL(3) && (ph == 3 || ph == 7)) {
            PH_IDS;
            const int l = ph == 3 ? 0 : 1;
            const u16* wt = (const u16*)(p.ws + WS_WTOUT) + (size_t)l * 1024 * 2048;
            {
                const float* ssqb = (const float*)(p.ws + WS_SSQ);
#define PP_ROW(rr) ((rr) < NTOK ? proj + (size_t)(rr) * LDP : sproj + (size_t)((rr) - NTOK) * LDP)
                const int NR = NTOK + NSTOK;
                uint4 v0 = make_uint4(0u, 0u, 0u, 0u), v1 = v0; float4 s0 = make_float4(1.f, 1.f, 1.f, 1.f), s1 = s0;
                if (gw < NR) { v0 = *(const uint4*)(PP_ROW(gw) + 1024 + lane * 8); s0 = *(const float4*)(ssqb + (size_t)gw * 4); }
                for (int r = gw; r < NR; r += ngw) {
                    const int rn = r + ngw;
                    if (rn < NR) { v1 = *(const uint4*)(PP_ROW(rn) + 1024 + lane * 8); s1 = *(const float4*)(ssqb + (size_t)rn * 4); }
                    const float tot = (lane >> 5) ? s0.z + s0.w : s0.x + s0.y;
                    const float rs = rsqrtf(tot * (1.f / 256.f) + EPS);
                    float v[8]; unpack8(v0, v);
#pragma unroll
                    for (int e = 0; e < 8; ++e) v[e] *= rs;
                    *(uint4*)(PP_ROW(r) + 1024 + lane * 8) = pack8f(v);
                    v0 = v1; s0 = s1;
                }
#undef PP_ROW
                GRID_SEAM(false);
            }
            {
                const int fr = lane & 15, fq = lane >> 4; float* red = (float*)lds;
                const float* resid = l == 0 ? p.x_sample : ys;
                for (int t = blockIdx.x; t < 512; t += gridDim.x) {
                    const int rt = t & 7, ct = t >> 3;
                    const u16* ap = sproj + (size_t)(rt * 16 + fr) * LDP + w * 256 + 8 * fq;
                    const u16* bp = wt + (size_t)(ct * 16 + fr) * 2048 + w * 256 + 8 * fq;
                    f32x4 acc = (f32x4){0.f, 0.f, 0.f, 0.f};
#pragma unroll
                    for (int k = 0; k < 256; k += 32) acc = MFMA16(as_frag(ldg16(ap + k)), as_frag(ldg16(bp + k)), acc);
                    *(f32x4*)(red + (w * 64 + lane) * 4) = acc;
                    __syncthreads();
                    if (w == 0) {
                        f32x4 tot = acc;
#pragma unroll
                        for (int ww = 1; ww < 8; ++ww) { const f32x4 o = *(const f32x4*)(red + (ww * 64 + lane) * 4); tot[0] += o[0]; tot[1] += o[1]; tot[2] += o[2]; tot[3] += o[3]; }
#pragma unroll
                        for (int j = 0; j < 4; ++j) { const size_t o = (size_t)(rt * 16 + 4 * fq + j) * 1024 + ct * 16 + fr; ys[o] = resid[o] + tot[j]; }
                    }
                    __syncthreads();
                }
            }
            pg8::Gemm g; g.A = proj; g.Bt = wt; g.M = NTOK; g.N = 1024; g.K = 2048; g.lda = LDP;
            pg8::StaticOrder S; S.init(g.M, g.N, (int)gridDim.x, (int)blockIdx.x);
            pg8::EpiOut E; E.Xhi = X; E.Xlo = X + 1024; E.xin = l == 0 ? p.x_prompt : nullptr; E.projdead = proj; E.last = (l == 1);
            pg8::gemm_phase<pg8::EpiOut>((LAS unsigned char*)lds, g, S, E, tid);
        } else if (PSEL(8) && ph == 8) {
            PH_IDS;
            final_norm(p, gw, ngw, lane);
        }
        if (pi + 1 < p.ph_hi) { GRID_SEAM(p.ph_hi > 64); }
    }
#undef PSEL
}
#if COOP
__global__ __launch_bounds__(512) void mega(Params p) {
    extern __shared__ __attribute__((aligned(16))) unsigned char lds[];
    run_phases<-1, -1>(p, lds);
}
#else
template <int PHSEL, int MIX>
__global__ __launch_bounds__(512) void phase_k(Params p) {
    extern __shared__ __attribute__((aligned(16))) unsigned char lds[];
    run_phases<PHSEL, MIX>(p, lds);
}
#endif

extern "C" void kernel_launch(void* const* d_in, const int* in_sizes, int n_in, void* d_out, int out_size, void* d_ws, size_t ws_size, hipStream_t stream) {
    static int grid = 0;
    if (grid == 0) {
        if (n_in != 23 || (size_t)out_size != O_END || ws_size < WS_END) { fprintf(stderr, "kernel_launch: unexpected shapes n_in %d out %d ws %zu (need %zu)\n", n_in, out_size, ws_size, (size_t)WS_END); grid = -1; return; }
        int dev = 0, cus = 0, per_cu = 0;
        (void)hipGetDevice(&dev); (void)hipDeviceGetAttribute(&cus, hipDeviceAttributeMultiprocessorCount, dev);
#if COOP
        if (hipFuncSetAttribute((const void*)mega, hipFuncAttributeMaxDynamicSharedMemorySize, LDS_BYTES) != hipSuccess) { fprintf(stderr, "hipFuncSetAttribute failed\n"); grid = -1; return; }
        (void)hipOccupancyMaxActiveBlocksPerMultiprocessor(&per_cu, (const void*)mega, 512, LDS_BYTES);
        (void)hipGetLastError();
#else
        hipError_t e = hipSuccess;
#define SETA(PH, MX) if (e == hipSuccess) e = hipFuncSetAttribute((const void*)phase_k<PH, MX>, hipFuncAttributeMaxDynamicSharedMemorySize, LDS_BYTES)
        SETA(0, -1); SETA(1, -1); SETA(2, 0); SETA(2, 1); SETA(2, 2); SETA(2, 3); SETA(3, -1); SETA(4, -1); SETA(8, -1);
#undef SETA
        if (e != hipSuccess) { fprintf(stderr, "hipFuncSetAttribute failed\n"); grid = -1; return; }
#endif
        if (per_cu < 1) per_cu = 1;
        grid = cus * per_cu; if (grid > 256) grid = 256;
    }
    if (grid < 0) return;
    Params p{};
    p.x_prompt = (const float*)d_in[0]; p.x_sample = (const float*)d_in[1];
    p.st_mc = (const float*)d_in[2]; p.st_mn = (const float*)d_in[3]; p.st_mm = (const float*)d_in[4]; p.st_ret = (const float*)d_in[5];
    p.st_ssd = (const float*)d_in[6]; p.st_conv = (const float*)d_in[7]; p.st_hg = (const float*)d_in[8];
    p.norm_w = (const float*)d_in[9]; p.w_in = (const float*)d_in[10]; p.gate_b = (const float*)d_in[11]; p.mnorm_w = (const float*)d_in[12];
    p.conv_w = (const float*)d_in[13]; p.conv_b = (const float*)d_in[14]; p.dt_bias = (const float*)d_in[15]; p.a_log = (const float*)d_in[16];
    p.d_skip = (const float*)d_in[17]; p.snorm_w = (const float*)d_in[18]; p.lbraw = (const float*)d_in[19]; p.hnorm_w = (const float*)d_in[20];
    p.w_out = (const float*)d_in[21]; p.fnorm_w = (const float*)d_in[22];
    p.out = (float*)d_out; p.ws = (unsigned char*)d_ws;
#if COOP
    p.ph_lo = 0; p.ph_hi = NPROG;
    if (hipMemsetAsync((char*)d_ws + WS_BAR, 0, 16384, stream) != hipSuccess) { fprintf(stderr, "hipMemsetAsync failed\n"); return; }
    void* args[] = {&p};
    hipError_t e = hipLaunchCooperativeKernel((const void*)mega, dim3(grid), dim3(512), args, LDS_BYTES, stream);
    if (e != hipSuccess) fprintf(stderr, "cooperative launch failed: %s (grid %d)\n", hipGetErrorString(e), grid);
#else
#ifndef MAXL
#define MAXL 99
#endif
    int nl_ = 0;
#define LAUNCH(PH, MX, ph_) do { if (nl_++ >= MAXL) break; p.ph_lo = (ph_); p.ph_hi = (ph_) + 1; hipLaunchKernelGGL((phase_k<PH, MX>), dim3(grid), dim3(512), LDS_BYTES, stream, p); } while (0)
    LAUNCH(0, -1, 0); LAUNCH(1, -1, 1);
    LAUNCH(2, 0, 2); LAUNCH(2, 1, 2); LAUNCH(2, 2, 2); LAUNCH(2, 3, 2);
    LAUNCH(3, -1, 3); LAUNCH(4, -1, 4); LAUNCH(1, -1, 5);
    LAUNCH(2, 0, 6); LAUNCH(2, 1, 6); LAUNCH(2, 2, 6); LAUNCH(2, 3, 6);
    LAUNCH(3, -1, 7); LAUNCH(8, -1, 8);
#undef LAUNCH
#endif
}
```
